# Optimizing an MI355X kernel written in HIP

```python
import math
import jax
import jax.numpy as jnp
from jax import lax
import numpy as np

D_MODEL = 1024
BATCH = 2
SEQ = 8192
DEPTH = 2

GRID_W = 64
CTX_LEN = 256
HEAD_DIM = 64
N_MOD = 6
NORM_EPS = 1e-6
ROPE_BASE = 10000.0
BLOCK = 128

HY_GROUPS = 4
HY_WIDTH = HY_GROUPS * HEAD_DIM
HY_ORDER = 2
HY_BANDS = 16
HY_EMB_DIM = 1 + 2 * HY_BANDS
HY_FILTER_WIDTH = 64
HY_SHORT_CONV = 3
HY_DECAY_MIN = 3.07
HY_DECAY_MAX = 15.35

WA_Q_HEADS = 8
WA_KV_HEADS = 2
WA_GROUP = WA_Q_HEADS // WA_KV_HEADS
WINDOW = 128

DA_HEADS = 4
DA_QK_DIM = 32
DA_V_DIM = 2 * DA_QK_DIM
DA_LAMBDA_BASE = 0.8
DA_LAMBDA_AMP = 0.6
DA_LAMBDA_RATE = 0.3

HY_COLS = (HY_ORDER + 1) * HY_WIDTH
WA_Q_COLS = WA_Q_HEADS * HEAD_DIM
WA_KV_COLS = WA_KV_HEADS * HEAD_DIM
WA_COLS = WA_Q_COLS + 2 * WA_KV_COLS
DA_QK_COLS = DA_HEADS * 2 * DA_QK_DIM
DA_COLS = 2 * DA_QK_COLS + DA_HEADS * DA_V_DIM
IN_COLS = HY_COLS + WA_COLS + DA_COLS
MIX_WIDTH = HY_WIDTH + WA_Q_COLS + DA_HEADS * DA_V_DIM

PEER_HEADS = 8
N_KEYS = 128
N_EXPERTS = N_KEYS * N_KEYS
PEER_TOPK = 16
PEER_QDIM = 256
TOKEN_CHUNK = 128

kernel_name = 'hybrid_hyena_swa_diffattn_peer_dit'


def rmsnorm(x, g):
    xf = x.astype(jnp.float32)
    y = xf * lax.rsqrt(jnp.mean(xf * xf, axis=-1, keepdims=True) + NORM_EPS)
    return (y * g.astype(jnp.float32)).astype(x.dtype)


def modulate(h, shift, scale):
    return h * (1.0 + scale) + shift


def axial_rope_tables(n_tokens, dim):
    n_rows = n_tokens // GRID_W
    row = jnp.broadcast_to(jnp.arange(n_rows)[:, None], (n_rows, GRID_W)).reshape(-1).astype(jnp.float32)
    col = jnp.broadcast_to(jnp.arange(GRID_W)[None, :], (n_rows, GRID_W)).reshape(-1).astype(jnp.float32)
    axis_dim = dim // 2
    inv_freq = ROPE_BASE ** (-jnp.arange(0, axis_dim, 2, dtype=jnp.float32) / axis_dim)
    ang_r = row[:, None] * inv_freq
    ang_c = col[:, None] * inv_freq
    return (jnp.cos(ang_r), jnp.sin(ang_r), jnp.cos(ang_c), jnp.sin(ang_c))


def _rotate_half(x, cos, sin):
    m = x.shape[-1] // 2
    x1, x2 = x[..., :m], x[..., m:]
    cos = cos[None, :, None, :]
    sin = sin[None, :, None, :]
    return jnp.concatenate([x1 * cos - x2 * sin, x2 * cos + x1 * sin], axis=-1)


def apply_axial_rope(x, tables):
    cr, sr, cc, sc = tables
    half = x.shape[-1] // 2
    xf = x.astype(jnp.float32)
    out = jnp.concatenate([_rotate_half(xf[..., :half], cr, sr), _rotate_half(xf[..., half:], cc, sc)], axis=-1)
    return out.astype(x.dtype)


def short_conv(u, w, b):
    n = u.shape[1]
    pad = HY_SHORT_CONV // 2
    up = jnp.pad(u, ((0, 0), (pad, pad), (0, 0)))
    out = b
    for j in range(HY_SHORT_CONV):
        out = out + up[:, j:j + n] * w[j]
    return out


def hyena_filters(n, lp):
    f32 = jnp.float32
    t = jnp.linspace(0.0, 1.0, n, dtype=f32)[:, None]
    bands = jnp.linspace(1e-4, HY_BANDS - 1, HY_BANDS, dtype=f32)
    phase = (2.0 * math.pi / n) * jnp.arange(n, dtype=f32)[:, None] * bands
    feat = jnp.concatenate([t, jnp.cos(phase), -jnp.sin(phase)], axis=-1)
    freq = lp['hy_freq'].astype(f32)
    z = jnp.sin(freq * (feat @ lp['hy_w1'].astype(f32) + lp['hy_b1'].astype(f32)))
    z = jnp.sin(freq * (z @ lp['hy_w2'].astype(f32) + lp['hy_b2'].astype(f32)))
    h = (z @ lp['hy_w3'].astype(f32)).reshape(n, HY_ORDER, 2, HY_WIDTH)
    window = jnp.exp(-t[:, :, None, None] * jnp.abs(lp['hy_decay'].astype(f32)))
    return h * window


def two_sided_spectrum(h):
    fwd = h[:, :, 0]
    bwd = h[:0:-1, :, 1]
    full = jnp.concatenate([fwd, jnp.zeros_like(fwd[:1]), bwd], axis=0)
    return jnp.fft.rfft(full, axis=0)


def hyena_mixer(u, lp):
    n = u.shape[1]
    parts = jnp.split(short_conv(u, lp['hy_conv_w'], lp['hy_conv_b']).astype(jnp.float32), HY_ORDER + 1, axis=-1)
    z = parts[-1]
    spec = two_sided_spectrum(hyena_filters(n, lp))
    bias = lp['hy_bias'].astype(jnp.float32)
    for o in range(HY_ORDER):
        zf = jnp.fft.rfft(z, n=2 * n, axis=1)
        conv = jnp.fft.irfft(zf * spec[None, :, o], n=2 * n, axis=1)[:, :n]
        z = parts[o] * (conv + bias[o] * z)
    return z.astype(u.dtype)


def window_gqa_latent(q, k, v, kc, vc, sink):
    B, S = q.shape[:2]
    nb = S // BLOCK
    scale = HEAD_DIM ** -0.5
    qb = q.reshape(B, nb, BLOCK, WA_KV_HEADS, WA_GROUP, HEAD_DIM)

    def band(t):
        tp = jnp.pad(t, ((0, 0), (BLOCK, BLOCK), (0, 0), (0, 0))).reshape(B, nb + 2, BLOCK, WA_KV_HEADS, HEAD_DIM)
        return jnp.concatenate([tp[:, :-2], tp[:, 1:-1], tp[:, 2:]], axis=2)

    kw, vw = band(k), band(v)
    qpos = jnp.arange(nb)[:, None] * BLOCK + jnp.arange(BLOCK)[None, :]
    kpos = jnp.arange(nb)[:, None] * BLOCK - BLOCK + jnp.arange(3 * BLOCK)[None, :]
    valid = ((jnp.abs(qpos[:, :, None] - kpos[:, None, :]) <= WINDOW)
             & (kpos[:, None, :] >= 0) & (kpos[:, None, :] < S))
    s_loc = jnp.einsum('bnqhgd,bnkhd->bnhgqk', qb, kw).astype(jnp.float32) * scale
    s_loc = jnp.where(valid[None, :, None, None], s_loc, -jnp.inf)
    s_ctx = jnp.einsum('bnqhgd,bchd->bnhgqc', qb, kc).astype(jnp.float32) * scale
    s_sink = jnp.broadcast_to(sink.astype(jnp.float32).reshape(WA_KV_HEADS, WA_GROUP)[None, None, :, :, None, None],
                              s_ctx.shape[:-1] + (1,))
    p = jax.nn.softmax(jnp.concatenate([s_loc, s_ctx, s_sink], axis=-1), axis=-1)
    n_loc = 3 * BLOCK
    n_ctx = kc.shape[1]
    out = (jnp.einsum('bnhgqk,bnkhd->bnqhgd', p[..., :n_loc].astype(v.dtype), vw)
           + jnp.einsum('bnhgqc,bchd->bnqhgd', p[..., n_loc:n_loc + n_ctx].astype(v.dtype), vc))
    return out.reshape(B, S, WA_Q_COLS)


def gqa_context(qc, kc, vc, sink):
    B, C = qc.shape[:2]
    q = qc.reshape(B, C, WA_KV_HEADS, WA_GROUP, HEAD_DIM)
    s = jnp.einsum('bqhgd,bkhd->bhgqk', q, kc).astype(jnp.float32) * HEAD_DIM ** -0.5
    s_sink = jnp.broadcast_to(sink.astype(jnp.float32).reshape(WA_KV_HEADS, WA_GROUP)[None, :, :, None, None],
                              s.shape[:-1] + (1,))
    p = jax.nn.softmax(jnp.concatenate([s, s_sink], axis=-1), axis=-1)[..., :C]
    return jnp.einsum('bhgqk,bkhd->bqhgd', p.astype(vc.dtype), vc).reshape(B, C, WA_Q_COLS)


def diff_lambda(lp, lam_init):
    f32 = jnp.float32
    return (jnp.exp(jnp.sum(lp['da_lq1'].astype(f32) * lp['da_lk1'].astype(f32)))
            - jnp.exp(jnp.sum(lp['da_lq2'].astype(f32) * lp['da_lk2'].astype(f32))) + lam_init)


def diff_attend(qb, k, v, lam):
    s = jnp.einsum('bqhmd,bkhmd->bhmqk', qb, k).astype(jnp.float32) * DA_QK_DIM ** -0.5
    p = jax.nn.softmax(s, axis=-1)
    a = p[:, :, 0] - lam * p[:, :, 1]
    return jnp.einsum('bhqk,bkhd->bqhd', a, v.astype(jnp.float32))


def diff_latent(q, k, v, kc, vc, lam):
    B, S = q.shape[:2]
    nb = S // BLOCK
    k_all = jnp.concatenate([k, kc], axis=1)
    v_all = jnp.concatenate([v, vc], axis=1)
    qblocks = jnp.moveaxis(q.reshape(B, nb, BLOCK, DA_HEADS, 2, DA_QK_DIM), 1, 0)
    out = lax.map(lambda qb: diff_attend(qb, k_all, v_all, lam), qblocks)
    return jnp.moveaxis(out, 0, 1).reshape(B, S, DA_HEADS, DA_V_DIM)


def diff_out(o, g, lam_init):
    B, L = o.shape[:2]
    return (rmsnorm(o, g) * (1.0 - lam_init)).reshape(B, L, DA_HEADS * DA_V_DIM)


def merge_heads(y_hy, y_wa, y_da, w_out, dtype):
    y = jnp.concatenate([y_hy.astype(dtype), y_wa.astype(dtype), y_da.astype(dtype)], axis=-1)
    return y @ w_out


def token_mixer(h, hc, lp, rope_wa, rope_da, lam_init, need_ctx_out):
    B, S, _ = h.shape
    C = hc.shape[1]
    cuts = (HY_COLS, HY_COLS + WA_COLS)
    hy, wa, da = jnp.split(h @ lp['w_in'], cuts, axis=-1)
    pc = hc @ lp['w_in']
    wa_c = pc[..., HY_COLS:HY_COLS + WA_COLS]
    da_c = pc[..., HY_COLS + WA_COLS:]
    y_hy = hyena_mixer(hy, lp)
    q, k, v = jnp.split(wa, (WA_Q_COLS, WA_Q_COLS + WA_KV_COLS), axis=-1)
    q = apply_axial_rope(q.reshape(B, S, WA_Q_HEADS, HEAD_DIM), rope_wa)
    k = apply_axial_rope(k.reshape(B, S, WA_KV_HEADS, HEAD_DIM), rope_wa)
    v = v.reshape(B, S, WA_KV_HEADS, HEAD_DIM)
    kc = wa_c[..., WA_Q_COLS:WA_Q_COLS + WA_KV_COLS].reshape(B, C, WA_KV_HEADS, HEAD_DIM)
    vc = wa_c[..., WA_Q_COLS + WA_KV_COLS:].reshape(B, C, WA_KV_HEADS, HEAD_DIM)
    y_wa = window_gqa_latent(q, k, v, kc, vc, lp['wa_sink'])
    lam = diff_lambda(lp, lam_init)
    q2, k2, v2 = jnp.split(da, (DA_QK_COLS, 2 * DA_QK_COLS), axis=-1)
    q2 = apply_axial_rope(q2.reshape(B, S, DA_HEADS * 2, DA_QK_DIM), rope_da).reshape(B, S, DA_HEADS, 2, DA_QK_DIM)
    k2 = apply_axial_rope(k2.reshape(B, S, DA_HEADS * 2, DA_QK_DIM), rope_da).reshape(B, S, DA_HEADS, 2, DA_QK_DIM)
    v2 = v2.reshape(B, S, DA_HEADS, DA_V_DIM)
    k2c = da_c[..., DA_QK_COLS:2 * DA_QK_COLS].reshape(B, C, DA_HEADS, 2, DA_QK_DIM)
    v2c = da_c[..., 2 * DA_QK_COLS:].reshape(B, C, DA_HEADS, DA_V_DIM)
    y_da = diff_out(diff_latent(q2, k2, v2, k2c, v2c, lam), lp['da_norm_g'], lam_init)
    y = merge_heads(y_hy, y_wa, y_da, lp['w_out'], h.dtype)
    if not need_ctx_out:
        return y, None
    yc_hy = hyena_mixer(pc[..., :HY_COLS], lp)
    qc = wa_c[..., :WA_Q_COLS].reshape(B, C, WA_Q_HEADS, HEAD_DIM)
    yc_wa = gqa_context(qc, kc, vc, lp['wa_sink'])
    q2c = da_c[..., :DA_QK_COLS].reshape(B, C, DA_HEADS, 2, DA_QK_DIM)
    yc_da = diff_out(diff_attend(q2c, k2c, v2c, lam), lp['da_norm_g'], lam_init)
    yc = merge_heads(yc_hy, yc_wa, yc_da, lp['w_out'], hc.dtype)
    return y, yc


def peer_ffn(h, wq, keys, u, v):
    T, D = h.shape
    half = PEER_QDIM // 2
    chunks = h.reshape(T // TOKEN_CHUNK, TOKEN_CHUNK, D)

    def one_chunk(xc):
        q = (xc @ wq).reshape(TOKEN_CHUNK, PEER_HEADS, 2, half)
        s = jnp.einsum('thpd,hpkd->thpk', q, keys).astype(jnp.float32)
        s_top, i_top = lax.top_k(s, PEER_TOPK)
        cand_s = (s_top[:, :, 0, :, None] + s_top[:, :, 1, None, :]).reshape(TOKEN_CHUNK, PEER_HEADS, PEER_TOPK * PEER_TOPK)
        cand_i = (i_top[:, :, 0, :, None] * N_KEYS + i_top[:, :, 1, None, :]).reshape(TOKEN_CHUNK, PEER_HEADS, PEER_TOPK * PEER_TOPK)
        best_s, best_j = lax.top_k(cand_s, PEER_TOPK)
        idx = jnp.take_along_axis(cand_i, best_j, axis=-1)
        gate = jax.nn.softmax(best_s, axis=-1)
        act = jax.nn.gelu(jnp.einsum('thkd,td->thk', u[idx], xc).astype(jnp.float32), approximate=False)
        return jnp.einsum('thk,thkd->td', (gate * act).astype(v.dtype), v[idx])

    return lax.map(one_chunk, chunks).reshape(T, D)


def setup_inputs(seed: int = 0) -> dict:
    key = jax.random.key(seed)
    ks = jax.random.split(key, 32)
    f32 = jnp.float32
    D = D_MODEL
    L = DEPTH
    FW = HY_FILTER_WIDTH

    def nrm(k, shape, s):
        return jax.random.normal(k, shape, f32) * s

    decay0 = jnp.broadcast_to(jnp.linspace(HY_DECAY_MIN, HY_DECAY_MAX, HY_WIDTH, dtype=f32), (L, HY_ORDER, 2, HY_WIDTH))
    return {
        'x': nrm(ks[0], (BATCH, SEQ, D), 1.0),
        'c': nrm(ks[1], (BATCH, D), 1.0),
        'ctx': nrm(ks[2], (BATCH, CTX_LEN, D), 1.0),
        'c_ctx': nrm(ks[3], (D,), 1.0),
        'w_mod': nrm(ks[4], (L, D, N_MOD * D), D ** -0.5),
        'b_mod': nrm(ks[5], (L, N_MOD * D), 0.02),
        'norm1_g': 1.0 + nrm(ks[6], (L, D), 0.02),
        'w_in': nrm(ks[7], (L, D, IN_COLS), D ** -0.5),
        'hy_conv_w': nrm(ks[8], (L, HY_SHORT_CONV, HY_COLS), HY_SHORT_CONV ** -0.5),
        'hy_conv_b': nrm(ks[9], (L, HY_COLS), 0.02),
        'hy_w1': nrm(ks[10], (L, HY_EMB_DIM, FW), HY_EMB_DIM ** -0.5),
        'hy_b1': nrm(ks[11], (L, FW), 0.02),
        'hy_freq': 1.0 + nrm(ks[12], (L, FW), 0.02),
        'hy_w2': nrm(ks[13], (L, FW, FW), FW ** -0.5),
        'hy_b2': nrm(ks[14], (L, FW), 0.02),
        'hy_w3': nrm(ks[15], (L, FW, HY_ORDER * 2 * HY_WIDTH), 0.05 * FW ** -0.5),
        'hy_decay': decay0 * (1.0 + nrm(ks[16], (L, HY_ORDER, 2, HY_WIDTH), 0.05)),
        'hy_bias': nrm(ks[17], (L, HY_ORDER, HY_WIDTH), 1.0),
        'wa_sink': nrm(ks[18], (L, WA_Q_HEADS), 1.0),
        'da_lq1': nrm(ks[19], (L, DA_QK_DIM), 0.1),
        'da_lk1': nrm(ks[20], (L, DA_QK_DIM), 0.1),
        'da_lq2': nrm(ks[21], (L, DA_QK_DIM), 0.1),
        'da_lk2': nrm(ks[22], (L, DA_QK_DIM), 0.1),
        'da_norm_g': 1.0 + nrm(ks[23], (L, DA_V_DIM), 0.02),
        'w_out': nrm(ks[24], (L, MIX_WIDTH, D), MIX_WIDTH ** -0.5),
        'norm2_g': 1.0 + nrm(ks[25], (L, D), 0.02),
        'peer_wq': nrm(ks[26], (L, D, PEER_HEADS * PEER_QDIM), D ** -0.5),
        'peer_keys': nrm(ks[27], (L, PEER_HEADS, 2, N_KEYS, PEER_QDIM // 2), (PEER_QDIM // 2) ** -0.5),
        'peer_u': nrm(ks[28], (L, N_EXPERTS, D), D ** -0.5),
        'peer_v': nrm(ks[29], (L, N_EXPERTS, D), 0.5),
        'final_g': 1.0 + nrm(ks[30], (D,), 0.02),
    }


def reference(x, c, ctx, c_ctx, w_mod, b_mod, norm1_g, w_in, hy_conv_w, hy_conv_b, hy_w1, hy_b1, hy_freq,
              hy_w2, hy_b2, hy_w3, hy_decay, hy_bias, wa_sink, da_lq1, da_lk1, da_lq2, da_lk2, da_norm_g,
              w_out, norm2_g, peer_wq, peer_keys, peer_u, peer_v, final_g):
    batch, n_lat, d = x.shape
    n_ctx = ctx.shape[1]
    rope_wa = axial_rope_tables(n_lat, HEAD_DIM)
    rope_da = axial_rope_tables(n_lat, DA_QK_DIM)
    c_act = jax.nn.silu(c)
    cc_act = jax.nn.silu(c_ctx)
    xc = ctx
    for li in range(DEPTH):
        need_ctx = li < DEPTH - 1
        lam_init = DA_LAMBDA_BASE - DA_LAMBDA_AMP * math.exp(-DA_LAMBDA_RATE * li)
        lp = {
            'w_in': w_in[li], 'w_out': w_out[li],
            'hy_conv_w': hy_conv_w[li], 'hy_conv_b': hy_conv_b[li],
            'hy_w1': hy_w1[li], 'hy_b1': hy_b1[li], 'hy_freq': hy_freq[li],
            'hy_w2': hy_w2[li], 'hy_b2': hy_b2[li], 'hy_w3': hy_w3[li],
            'hy_decay': hy_decay[li], 'hy_bias': hy_bias[li],
            'wa_sink': wa_sink[li],
            'da_lq1': da_lq1[li], 'da_lk1': da_lk1[li], 'da_lq2': da_lq2[li], 'da_lk2': da_lk2[li],
            'da_norm_g': da_norm_g[li],
        }
        mod = jnp.split((c_act @ w_mod[li] + b_mod[li])[:, None, :], N_MOD, axis=-1)
        modc = jnp.split((cc_act @ w_mod[li] + b_mod[li])[None, None, :], N_MOD, axis=-1)
        h = modulate(rmsnorm(x, norm1_g[li]), mod[0], mod[1])
        hc = modulate(rmsnorm(xc, norm1_g[li]), modc[0], modc[1])
        y, yc = token_mixer(h, hc, lp, rope_wa, rope_da, lam_init, need_ctx)
        x = x + mod[2] * y
        h2 = modulate(rmsnorm(x, norm2_g[li]), mod[3], mod[4])
        if need_ctx:
            xc = xc + modc[2] * yc
            h2c = modulate(rmsnorm(xc, norm2_g[li]), modc[3], modc[4])
            tok = jnp.concatenate([h2.reshape(-1, d), h2c.reshape(-1, d)], axis=0)
            out = peer_ffn(tok, peer_wq[li], peer_keys[li], peer_u[li], peer_v[li])
            x = x + mod[5] * out[:batch * n_lat].reshape(batch, n_lat, d)
            xc = xc + modc[5] * out[batch * n_lat:].reshape(batch, n_ctx, d)
        else:
            out = peer_ffn(h2.reshape(-1, d), peer_wq[li], peer_keys[li], peer_u[li], peer_v[li])
            x = x + mod[5] * out.reshape(batch, n_lat, d)
    return rmsnorm(x, final_g)
```

```cpp
#include <hip/hip_runtime.h>
#include <hip/hip_cooperative_groups.h>
#include <cstdio>
#include <cstdint>
namespace cg = cooperative_groups;

#define NT 512
#define LAS __attribute__((address_space(3)))

#define XB_TMO      128
#define XB_XCNT(j)  (256  + 64 * (j))
#define XB_XSUB(j)  (1280 + 64 * (j))
#define XB_XGEN(j)  (2304 + 64 * (j))
#define XB_TOP      3328
#define XB_TOPGEN   3392
#define XCD_BAR_WORDS 3456
#define XB_SPIN_CAP (1u << 26)

__device__ __forceinline__ unsigned xb_ld(unsigned* p)              { return __hip_atomic_load(p, __ATOMIC_RELAXED, __HIP_MEMORY_SCOPE_AGENT); }
__device__ __forceinline__ unsigned xb_add(unsigned* p, unsigned v) { return __hip_atomic_fetch_add(p, v, __ATOMIC_RELAXED, __HIP_MEMORY_SCOPE_AGENT); }
__device__ __forceinline__ unsigned xb_xcc_id() { return (unsigned)__builtin_amdgcn_s_getreg((3 << 11) | 20) & 0xFu; }
#define XB_SPIN(cond, bar) do { unsigned _sp = 0; while (cond) { __builtin_amdgcn_s_sleep(1); \
    if ((++_sp & 255u) == 0u) { if (xb_ld(&(bar)[XB_TMO])) break; if (_sp > XB_SPIN_CAP) { atomicAdd(&(bar)[XB_TMO], 1u); break; } } } } while (0)

struct XcdBarrier { unsigned* bar; unsigned x; volatile LAS unsigned* st; };

__device__ __forceinline__ XcdBarrier xcd_barrier_post(unsigned* bar, volatile LAS unsigned* st) {
    XcdBarrier b; b.bar = bar; b.x = xb_xcc_id(); b.st = st;
    if (threadIdx.x == 0) (void)xb_add(&bar[XB_XCNT(b.x)], 1u);
    return b;
}
__device__ __forceinline__ void xcd_barrier_complete(unsigned* bar, unsigned x, unsigned& nloc, unsigned& nx) {
    const unsigned G = gridDim.x * gridDim.y * gridDim.z;
    unsigned sum, cnt, mine, sp = 0u;
    for (;;) {
        sum = 0u; cnt = 0u; mine = 0u;
#pragma unroll
        for (unsigned j = 0; j < 16; ++j) { const unsigned c = xb_ld(&bar[XB_XCNT(j)]); sum += c; cnt += (c > 0u) ? 1u : 0u; mine = (j == x) ? c : mine; }
        if (sum == G) break;
        __builtin_amdgcn_s_sleep(1);
        if ((++sp & 255u) == 0u) { if (xb_ld(&bar[XB_TMO])) break; if (sp > XB_SPIN_CAP) { atomicAdd(&bar[XB_TMO], 1u); break; } }
    }
    nloc = mine > 0u ? mine : 1u; nx = cnt > 0u ? cnt : 1u;
}
__device__ __forceinline__ void xcd_barrier(const XcdBarrier& b) {
    asm volatile("s_waitcnt vmcnt(0)" ::: "memory");
    __syncthreads();
    if (threadIdx.x == 0) {
        unsigned* bar = b.bar;
        __builtin_amdgcn_s_waitcnt(0);
        unsigned nloc = b.st[0], nx = b.st[1];
        if (nloc == 0u) { xcd_barrier_complete(bar, b.x, nloc, nx); b.st[0] = nloc; b.st[1] = nx; }
        const unsigned old = xb_add(&bar[XB_XSUB(b.x)], 1u);
        const unsigned gen = old / nloc;
        if (old + 1u == (gen + 1u) * nloc) {
            __builtin_amdgcn_fence(__ATOMIC_RELEASE, "agent");
            asm volatile("s_waitcnt vmcnt(0)" ::: "memory");
            const unsigned og = xb_add(&bar[XB_TOP], 1u);
            const unsigned tg = og / nx;
            if (og + 1u == (tg + 1u) * nx) xb_add(&bar[XB_TOPGEN], 1u);
            else XB_SPIN(xb_ld(&bar[XB_TOPGEN]) == tg, bar);
            __builtin_amdgcn_fence(__ATOMIC_ACQUIRE, "agent");
            xb_add(&bar[XB_XGEN(b.x)], 1u);
            asm volatile("s_waitcnt vmcnt(0)" ::: "memory");
        } else {
            XB_SPIN(xb_ld(&bar[XB_XGEN(b.x)]) == gen, bar);
            __builtin_amdgcn_fence(__ATOMIC_ACQUIRE, "agent");
            asm volatile("s_waitcnt vmcnt(0)" ::: "memory");
        }
    }
    __syncthreads();
}

namespace pg8 {
#define PG8_LAS __attribute__((address_space(3)))
typedef unsigned short bf16_t;
typedef short bf16x8 __attribute__((ext_vector_type(8)));
typedef float f32x4 __attribute__((ext_vector_type(4)));
typedef unsigned u32x4 __attribute__((ext_vector_type(4)));
constexpr int BM = 256, BK = 64, HALF = 128, HTB = HALF * BK * 2  , STAGE_BYTES = 8 * HTB, NXCD = 8, WGM = 8;

__host__ __device__ __forceinline__ int lds_byte(int r, int c) { const int st = (r >> 4) * 2 + (c >> 5), rr = r & 15, cc = c & 31, ob = rr * 64 + cc * 2; return st * 1024 + (ob ^ (((ob >> 9) & 1) << 5)); }
__host__ __device__ __forceinline__ void stage_rc(int b, int& R, int& C) { const int st = b / 1024, sb = b % 1024, swz = sb ^ (((sb >> 9) & 1) << 5); R = (st >> 1) * 16 + swz / 64; C = (st & 1) * 32 + (swz % 64) / 2; }
__host__ __device__ __forceinline__ int perm32(int rho) { const int n = rho >> 4, i = rho & 15; return 8 * (i >> 2) + 4 * n + (i & 3); }

struct Unit { int pm, pn; };
struct Gemm { const bf16_t* A; const bf16_t* Bt; int M, N, K; };

struct StaticOrder {
    int nM, nN, nwg, G, c;
    __host__ __device__ void init(int M, int N, int G_, int c_) { nM = M / BM; nN = N / BM; nwg = nM * nN; G = G_; c = c_; }
    __host__ __device__ bool next(int i, Unit& u) const {
        const long L = (long)i * G + c; if (L >= nwg) return false;
        int wgid = (int)L; { const int q = nwg / NXCD, r = nwg % NXCD, xcd = wgid % NXCD, off = wgid / NXCD; wgid = (xcd < r ? xcd * (q + 1) : r * (q + 1) + (xcd - r) * q) + off; }
        const int nig = WGM * nN, gid = wgid / nig, fm = gid * WGM, gsz = (nM - fm) < WGM ? (nM - fm) : WGM;
        u.pm = fm + ((wgid % nig) % gsz); u.pn = (wgid % nig) / gsz; return true;
    }
    __device__ __forceinline__ void a_ready(const Unit&) const {}
    __device__ __forceinline__ void done(const Unit&) const {}
};
struct CountedOrder : StaticOrder {
    const unsigned* ready; unsigned need; unsigned* tmo;
    __device__ __forceinline__ void a_ready(const Unit& u) const {
        if (threadIdx.x < 64) {
            const unsigned long long t0 = __builtin_amdgcn_s_memrealtime(); unsigned polls = 0;
            while ((unsigned)__builtin_amdgcn_readfirstlane(__hip_atomic_load(ready + 64 * u.pm, __ATOMIC_RELAXED, __HIP_MEMORY_SCOPE_AGENT)) < need) {
                if ((++polls & 255u) == 0u && __builtin_amdgcn_readfirstlane(__hip_atomic_load(tmo, __ATOMIC_RELAXED, __HIP_MEMORY_SCOPE_AGENT)) != 0u) break;
                if (__builtin_amdgcn_s_memrealtime() - t0 > 2000000ull) {
                    if (threadIdx.x == 0) { unsigned expect = 0u; __hip_atomic_compare_exchange_strong(tmo + 1, &expect, 0x600u | (unsigned)(u.pm & 0xff), __ATOMIC_RELAXED, __ATOMIC_RELAXED, __HIP_MEMORY_SCOPE_AGENT); __hip_atomic_store(tmo, 1u, __ATOMIC_RELAXED, __HIP_MEMORY_SCOPE_AGENT); }
                    break; }
                __builtin_amdgcn_s_sleep(2); }
            __builtin_amdgcn_fence(__ATOMIC_ACQUIRE, "agent");
            asm volatile("s_waitcnt vmcnt(0)" ::: "memory");
        }
#if !defined(BROKEN_HOOK_NO_BARRIER)
        asm volatile("" ::: "memory"); __builtin_amdgcn_s_barrier(); asm volatile("" ::: "memory");
#endif
    }
};

__device__ __forceinline__ unsigned cvt_pk_bf16(float lo, float hi) { unsigned r; asm volatile("v_cvt_pk_bf16_f32 %0, %1, %2" : "=v"(r) : "v"(lo), "v"(hi)); return r; }
typedef float f32x2 __attribute__((ext_vector_type(2)));
__device__ __forceinline__ f32x2 gelu_pk(f32x2 v) {
    const f32x2 av = __builtin_elementwise_abs(v), d = av * 0.2316418882f + 1.0f;
    f32x2 t; t.x = __builtin_amdgcn_rcpf(d.x); t.y = __builtin_amdgcn_rcpf(d.y);
    f32x2 q = t * 0.5307027145f + (-0.7265760135f); q = q * t + 0.7107068705f; q = q * t + (-0.142248368f); q = q * t + 0.127414796f; q = q * t;
    const f32x2 s = (v * v) * (-0.72134752044f);
    f32x2 e; e.x = __builtin_amdgcn_exp2f(s.x); e.y = __builtin_amdgcn_exp2f(s.y);
    const f32x2 m = v * (q * e), r = v - m;
    f32x2 o; o.x = v.x < 0.f ? m.x : r.x; o.y = v.y < 0.f ? m.y : r.y; return o;
}

struct EpiF32 {
    static constexpr bool PERM = false, AFTER_DRAIN = false;
    float* C; int ldc; const float* bias;
    __device__ __forceinline__ void operator()(const f32x4 (&acc)[2][2][4][2], const Unit& u, int wr, int wc, int fr, int fq) const {
        const int row0 = u.pm * BM + wr * 64 + fr, col0 = u.pn * BM + wc * 32 + 4 * fq;
        f32x4 bv[2][2];
#pragma unroll
        for (int bj = 0; bj < 2; ++bj)
#pragma unroll
            for (int n = 0; n < 2; ++n) bv[bj][n] = bias ? *(const f32x4*)(bias + col0 + bj * HALF + n * 16) : (f32x4){0.f, 0.f, 0.f, 0.f};
#pragma unroll
        for (int ai = 0; ai < 2; ++ai)
#pragma unroll
            for (int m = 0; m < 4; ++m) { float* rowp = C + (size_t)(row0 + ai * HALF + m * 16) * ldc + col0;
#pragma unroll
                for (int bj = 0; bj < 2; ++bj)
#pragma unroll
                    for (int n = 0; n < 2; ++n) *(f32x4*)(rowp + bj * HALF + n * 16) = acc[ai][bj][m][n] + bv[bj][n]; }
    }
};

template <class Epi, class Sched>
__device__ __forceinline__ void gemm_phase(PG8_LAS unsigned char* lds, const Gemm g, const Sched& S, const Epi& E) {
    int tid_o = threadIdx.x; asm volatile("" : "+v"(tid_o));
    const int tid = tid_o, wid = __builtin_amdgcn_readfirstlane(tid >> 6), lane = tid & 63, wr = wid >> 2, wc = wid & 3, fr = lane & 15, fq = lane >> 4;
    const int K = g.K, nt = K / BK;
    unsigned voffA[2], voffB[2];
#pragma unroll
    for (int i = 0; i < 2; ++i) { int R, C; stage_rc(tid * 16 + i * 8192, R, C); const int Rb = Epi::PERM ? ((R & ~31) + perm32(R & 31)) : R;
        voffA[i] = (unsigned)(R * K + C) * 2u; voffB[i] = (unsigned)(Rb * K + C) * 2u; }
    const size_t kstep = (size_t)(BK * 2);
    const size_t hstep = (size_t)HALF * K * 2;
    const size_t tstep = 2 * hstep;
    const unsigned ldsw = (unsigned)wid * 1024u;
    const int aoff = lds_byte(wr * 64 + fr, fq * 8), boff = lds_byte(wc * 32 + fr, fq * 8);
#define PG8_SA(b, h) (((b) * 2 + (h)) * HTB)
#define PG8_SB(b, h) ((4 + (b) * 2 + (h)) * HTB)
#define PG8_STAGE(bufoff, gbase, voff) do { _Pragma("unroll") for (int _i = 0; _i < 2; ++_i) \
        __builtin_amdgcn_global_load_lds((const unsigned*)((const char*)(gbase) + (voff)[_i]), (PG8_LAS unsigned*)(lds + (bufoff) + ldsw + _i * 8192), 16, 0, 0); } while (0)
#define PG8_LDA(dst, b, h) do { _Pragma("unroll") for (int m = 0; m < 4; ++m) _Pragma("unroll") for (int k = 0; k < 2; ++k) dst[m][k] = *(const PG8_LAS bf16x8*)(lds + PG8_SA(b, h) + aoff + m * 2048 + k * 1024); } while (0)
#define PG8_LDB(dst, b, h) do { _Pragma("unroll") for (int n = 0; n < 2; ++n) _Pragma("unroll") for (int k = 0; k < 2; ++k) dst[n][k] = *(const PG8_LAS bf16x8*)(lds + PG8_SB(b, h) + boff + n * 2048 + k * 1024); } while (0)
#define PG8_MMA(ai, bj, At, Bt) do { __builtin_amdgcn_s_setprio(1); _Pragma("unroll") for (int m = 0; m < 4; ++m) _Pragma("unroll") for (int n = 0; n < 2; ++n) _Pragma("unroll") for (int k = 0; k < 2; ++k) \
        acc[ai][bj][m][n] = __builtin_amdgcn_mfma_f32_16x16x32_bf16(Bt[n][k], At[m][k], acc[ai][bj][m][n], 0, 0, 0); __builtin_amdgcn_s_setprio(0); } while (0)
#define PG8_WAIT_V(n) asm volatile("s_waitcnt vmcnt(" #n ")" ::: "memory")
#define PG8_WAIT_L(n) asm volatile("s_waitcnt lgkmcnt(" #n ")" ::: "memory")
#define PG8_BAR __builtin_amdgcn_s_barrier()
#define PG8_SCHED __builtin_amdgcn_sched_barrier(0)
    Unit cur, nxt; int ui = 0;
    if (!S.next(0, cur)) return;
    f32x4 acc[2][2][4][2];
#pragma unroll
    for (int a = 0; a < 2; ++a)
#pragma unroll
        for (int b = 0; b < 2; ++b)
#pragma unroll
            for (int m = 0; m < 4; ++m)
#pragma unroll
                for (int n = 0; n < 2; ++n) acc[a][b][m][n] = (f32x4){0.f, 0.f, 0.f, 0.f};
    bf16x8 At[4][2], B0[2][2], B1[2][2];
    const char* cA = (const char*)g.A + (size_t)cur.pm * tstep; const char* cB = (const char*)g.Bt + (size_t)cur.pn * tstep;
    S.a_ready(cur);
    PG8_STAGE(PG8_SB(0, 0), cB, voffB); PG8_STAGE(PG8_SA(0, 0), cA, voffA); PG8_STAGE(PG8_SB(0, 1), cB + hstep, voffB); PG8_STAGE(PG8_SA(0, 1), cA + hstep, voffA);
    if (wr == 1) PG8_BAR;
    PG8_WAIT_V(4); PG8_BAR;
    PG8_STAGE(PG8_SB(1, 0), cB + kstep, voffB); PG8_STAGE(PG8_SA(1, 0), cA + kstep, voffA); PG8_STAGE(PG8_SB(1, 1), cB + hstep + kstep, voffB);
    PG8_WAIT_V(6); PG8_BAR;
    for (;;) {
        const bool has_next = S.next(ui + 1, nxt);
        const char* nA = has_next ? (const char*)g.A + (size_t)nxt.pm * tstep : cA; const char* nB = has_next ? (const char*)g.Bt + (size_t)nxt.pn * tstep : cB;
        for (int t = 0; t < nt; t += 2) {
            const bool last = (t == nt - 2);
            const char* a1 = cA + (size_t)(t + 1) * kstep;
            const char* a2 = last ? nA : cA + (size_t)(t + 2) * kstep; const char* b2 = last ? nB : cB + (size_t)(t + 2) * kstep;
            const char* a3 = a2 + kstep; const char* b3 = b2 + kstep;
            if (last && has_next) S.a_ready(nxt);
            PG8_LDB(B0, 0, 0); PG8_SCHED; PG8_LDA(At, 0, 0); PG8_STAGE(PG8_SA(1, 1), a1 + hstep, voffA);
            PG8_WAIT_L(8); PG8_BAR; PG8_WAIT_L(0); PG8_MMA(0, 0, At, B0); PG8_BAR; PG8_SCHED;
            PG8_LDB(B1, 0, 1); PG8_STAGE(PG8_SB(0, 0), b2, voffB);
            PG8_BAR; PG8_WAIT_L(0); PG8_MMA(0, 1, At, B1); PG8_BAR;
            PG8_LDA(At, 0, 1); PG8_STAGE(PG8_SA(0, 0), a2, voffA);
            PG8_BAR; PG8_WAIT_L(0); PG8_MMA(1, 0, At, B0); PG8_BAR; PG8_SCHED;
            PG8_STAGE(PG8_SB(0, 1), b2 + hstep, voffB);
            PG8_WAIT_V(6); PG8_BAR; PG8_MMA(1, 1, At, B1); PG8_BAR;
            PG8_LDB(B0, 1, 0); PG8_SCHED; PG8_LDA(At, 1, 0); PG8_STAGE(PG8_SA(0, 1), a2 + hstep, voffA);
            PG8_WAIT_L(8); PG8_BAR; PG8_WAIT_L(0); PG8_MMA(0, 0, At, B0); PG8_BAR; PG8_SCHED;
            PG8_LDB(B1, 1, 1); PG8_STAGE(PG8_SB(1, 0), b3, voffB);
            PG8_BAR; PG8_WAIT_L(0); PG8_MMA(0, 1, At, B1); PG8_BAR;
            PG8_LDA(At, 1, 1); PG8_STAGE(PG8_SA(1, 0), a3, voffA);
            PG8_BAR; PG8_WAIT_L(0); PG8_MMA(1, 0, At, B0); PG8_BAR; PG8_SCHED;
            PG8_STAGE(PG8_SB(1, 1), b3 + hstep, voffB);
            PG8_WAIT_V(6); PG8_BAR; PG8_MMA(1, 1, At, B1); PG8_BAR;
        }
        if constexpr (!Epi::AFTER_DRAIN) { E(acc, cur, wr, wc, fr, fq); S.done(cur); }
        if (!has_next) break;
#pragma unroll
        for (int a = 0; a < 2; ++a)
#pragma unroll
            for (int b = 0; b < 2; ++b)
#pragma unroll
                for (int m = 0; m < 4; ++m)
#pragma unroll
                    for (int n = 0; n < 2; ++n) acc[a][b][m][n] = (f32x4){0.f, 0.f, 0.f, 0.f};
        cur = nxt; cA = nA; cB = nB; ++ui;
    }
    PG8_WAIT_V(0);
    if (wr == 0) PG8_BAR;
    PG8_BAR;
    if constexpr (Epi::AFTER_DRAIN) { E.fused(acc, cur, wr, wc, fr, fq, lds, wid, lane); S.done(cur); }
#undef PG8_SA
#undef PG8_SB
#undef PG8_STAGE
#undef PG8_LDA
#undef PG8_LDB
#undef PG8_MMA
#undef PG8_WAIT_V
#undef PG8_WAIT_L
#undef PG8_BAR
#undef PG8_SCHED
}
}


typedef unsigned short bf16_t;
constexpr int D = 1024, SEQ = 8192, CTX = 256, NLAT = 16384, NCTX = 512, NTOK = 16896, INC = 2304;
constexpr int C_WAQ = 768, C_WAK = 1280, C_WAV = 1408, C_DAQ = 1536, C_DAK = 1792, C_DAV = 2048;
constexpr int NEXP = 16384;

constexpr size_t OFF_BAR  = 0;
constexpr size_t OFF_X    = 65536;
constexpr size_t OFF_HB   = OFF_X    + (size_t)NTOK * D * 4;
constexpr size_t OFF_P    = OFF_HB   + (size_t)NTOK * D * 2;
constexpr size_t OFF_U    = OFF_P    + (size_t)NTOK * INC * 4;
constexpr size_t OFF_Z1   = OFF_U    + (size_t)NTOK * 768 * 4;
constexpr size_t OFF_Y    = OFF_Z1   + (size_t)NTOK * 256 * 4;
constexpr size_t OFF_HF   = OFF_Y    + (size_t)NTOK * D * 2;
constexpr size_t OFF_HFC  = OFF_HF   + (size_t)2 * SEQ * 1024 * 4;
constexpr size_t OFF_WIN  = OFF_HFC  + (size_t)CTX * 1024 * 4;
constexpr size_t OFF_WOUT = OFF_WIN  + (size_t)2 * INC * D * 2;
constexpr size_t OFF_WQ   = OFF_WOUT + (size_t)2 * D * D * 2;
constexpr size_t OFF_MODP = OFF_WQ   + (size_t)2 * 2048 * D * 2;
constexpr size_t OFF_MOD  = OFF_MODP + (size_t)16 * 2 * 3 * 6144 * 4;
constexpr size_t OFF_TAB  = OFF_MOD  + (size_t)2 * 3 * 6144 * 4;
constexpr size_t OFF_END  = OFF_TAB  + (size_t)128 * 24 * 2 * 4;

constexpr int LDS_BAR_OFF = 131072;
constexpr int LDS_BYTES = 131072 + 256;

struct Params { const float* in[31]; float* out; unsigned char* ws; };

__device__ __forceinline__ bf16_t f2bf(float f) { unsigned u = __float_as_uint(f); u += 0x7FFFu + ((u >> 16) & 1u); return (bf16_t)(u >> 16); }
__device__ __forceinline__ float wave_sum(float v) {
#pragma unroll
    for (int o = 32; o > 0; o >>= 1) v += __shfl_xor(v, o);
    return v;
}
__device__ __forceinline__ float wave_max(float v) {
#pragma unroll
    for (int o = 32; o > 0; o >>= 1) v = fmaxf(v, __shfl_xor(v, o));
    return v;
}
__device__ __forceinline__ float rdlane(float v, int l) { return __int_as_float(__builtin_amdgcn_readlane(__float_as_int(v), l)); }
#define WAVE_SYNC() do { __builtin_amdgcn_fence(__ATOMIC_RELEASE, "wavefront"); __builtin_amdgcn_wave_barrier(); __builtin_amdgcn_fence(__ATOMIC_ACQUIRE, "wavefront"); } while (0)

struct EpiResid {
    static constexpr bool PERM = false, AFTER_DRAIN = false;
    float* X; const float* mod;
    __device__ __forceinline__ void operator()(const pg8::f32x4 (&acc)[2][2][4][2], const pg8::Unit& u, int wr, int wc, int fr, int fq) const {
        using namespace pg8;
        const int row0 = u.pm * BM + wr * 64 + fr, col0 = u.pn * BM + wc * 32 + 4 * fq;
        const int rb = u.pm < 32 ? 0 : (u.pm < 64 ? 1 : 2);
        const float* gate = mod + rb * 6144 + 2048;
        f32x4 gv[2][2];
#pragma unroll
        for (int bj = 0; bj < 2; ++bj)
#pragma unroll
            for (int n = 0; n < 2; ++n) gv[bj][n] = *(const f32x4*)(gate + col0 + bj * HALF + n * 16);
#pragma unroll
        for (int ai = 0; ai < 2; ++ai)
#pragma unroll
            for (int m = 0; m < 4; ++m) { float* rowp = X + (size_t)(row0 + ai * HALF + m * 16) * D + col0;
#pragma unroll
                for (int bj = 0; bj < 2; ++bj)
#pragma unroll
                    for (int n = 0; n < 2; ++n) { f32x4* q = (f32x4*)(rowp + bj * HALF + n * 16); *q = *q + gv[bj][n] * acc[ai][bj][m][n]; } }
    }
};

__device__ __forceinline__ void transpose_convert(const float* __restrict__ src, bf16_t* __restrict__ dst, int K, int N, size_t gtid, size_t gsz) {
    const size_t items = (size_t)N * (K / 8);
    for (size_t idx = gtid; idx < items; idx += gsz) {
        const int n = (int)(idx % N), k8 = (int)(idx / N);
        unsigned w[4];
#pragma unroll
        for (int j = 0; j < 4; ++j) {
            const float a = src[(size_t)(k8 * 8 + 2 * j) * N + n], b = src[(size_t)(k8 * 8 + 2 * j + 1) * N + n];
            w[j] = (unsigned)f2bf(a) | ((unsigned)f2bf(b) << 16);
        }
        *(uint4*)(dst + (size_t)n * K + k8 * 8) = make_uint4(w[0], w[1], w[2], w[3]);
    }
}

__device__ __forceinline__ void norm_phase(const float* __restrict__ X, const float* __restrict__ g, const float* __restrict__ modl, int shift_off, int scale_off, int nrows,
                                           bf16_t* __restrict__ Hb, int gwave, int nwaves, int lane) {
    for (int row = gwave; row < nrows; row += nwaves) {
        const int r = row < NLAT ? (row >> 13) : 2;
        const float4* xr = (const float4*)(X + (size_t)row * D);
        float4 v[4]; float ss = 0.f;
#pragma unroll
        for (int j = 0; j < 4; ++j) { v[j] = xr[lane + 64 * j]; ss += v[j].x * v[j].x + v[j].y * v[j].y + v[j].z * v[j].z + v[j].w * v[j].w; }
        ss = wave_sum(ss);
        const float rs = rsqrtf(ss * (1.f / D) + 1e-6f);
        const float4* g4 = (const float4*)g;
        const float4* sh4 = (const float4*)(modl + r * 6144 + shift_off);
        const float4* sc4 = (const float4*)(modl + r * 6144 + scale_off);
#pragma unroll
        for (int j = 0; j < 4; ++j) {
            const float4 gg = g4[lane + 64 * j], sh = sh4[lane + 64 * j], sc = sc4[lane + 64 * j];
            const float a = v[j].x * rs * gg.x * (1.f + sc.x) + sh.x, b = v[j].y * rs * gg.y * (1.f + sc.y) + sh.y;
            const float c = v[j].z * rs * gg.z * (1.f + sc.z) + sh.z, d = v[j].w * rs * gg.w * (1.f + sc.w) + sh.w;
            uint2 w; w.x = (unsigned)f2bf(a) | ((unsigned)f2bf(b) << 16); w.y = (unsigned)f2bf(c) | ((unsigned)f2bf(d) << 16);
            *(uint2*)(Hb + (size_t)row * D + 4 * (lane + 64 * j)) = w;
        }
    }
}

__device__ __forceinline__ void hyena_conv_phase(int o, int l, bool with_ctx, const float* __restrict__ U, float* __restrict__ Z1, bf16_t* __restrict__ Y,
                                                 const float* __restrict__ HFl, const float* __restrict__ HFC, const float* __restrict__ hy_bias, int bid, int G, int tid) {
    const int nlat_items = 2 * (SEQ / 32), nctx_items = with_ctx ? 2 * (CTX / 32) : 0;
    const int c = tid & 255, th = tid >> 8;
    const float bias = hy_bias[(l * 2 + o) * 256 + c];
    for (int it = bid; it < nlat_items + nctx_items; it += G) {
        int n, rowbase, chunk; const float* F;
        if (it < nlat_items) { n = SEQ; const int s = it / (SEQ / 32); chunk = it % (SEQ / 32); rowbase = s * SEQ; F = HFl; }
        else { const int i2 = it - nlat_items; n = CTX; const int s = i2 / (CTX / 32); chunk = i2 % (CTX / 32); rowbase = NLAT + s * CTX; F = HFC; }
        const int t0 = chunk * 32 + th * 16;
        const float* Ff = F + o * 512 + c;
        const float* Fb = F + o * 512 + 256 + c;
        const float* zp; int zld;
        if (o == 0) { zp = U + (size_t)rowbase * 768 + 512 + c; zld = 768; } else { zp = Z1 + (size_t)rowbase * 256 + c; zld = 256; }
        float acc[16];
#pragma unroll
        for (int k = 0; k < 16; ++k) acc[k] = 0.f;
        for (int s = 0; s < t0; ++s) {
            const float zv = zp[(size_t)s * zld];
            const float* fp = Ff + (size_t)(t0 - s) * 1024;
#pragma unroll
            for (int k = 0; k < 16; ++k) acc[k] += fp[k * 1024] * zv;
        }
        for (int s = t0; s < t0 + 16; ++s) {
            const float zv = zp[(size_t)s * zld];
#pragma unroll
            for (int k = 0; k < 16; ++k) { const int d = t0 + k - s; const float h = d >= 0 ? Ff[(size_t)d * 1024] : Fb[(size_t)(-d) * 1024]; acc[k] += h * zv; }
        }
        for (int s = t0 + 16; s < n; ++s) {
            const float zv = zp[(size_t)s * zld];
            const float* fp = Fb + (size_t)(s - t0) * 1024;
#pragma unroll
            for (int k = 0; k < 16; ++k) acc[k] += fp[-k * 1024] * zv;
        }
#pragma unroll
        for (int k = 0; k < 16; ++k) {
            const int row = rowbase + t0 + k;
            const float zt = zp[(size_t)(t0 + k) * zld];
            const float gate = U[(size_t)row * 768 + o * 256 + c];
            const float res = gate * (acc[k] + bias * zt);
            if (o == 0) Z1[(size_t)row * 256 + c] = res; else Y[(size_t)row * D + c] = f2bf(res);
        }
    }
}

__global__ void __launch_bounds__(NT) mega(Params p) {
    extern __shared__ __attribute__((aligned(16))) unsigned char lds[];
    cg::grid_group grid = cg::this_grid();
    volatile LAS unsigned* bst = (volatile LAS unsigned*)(lds + LDS_BAR_OFF);
    if (threadIdx.x < 4) bst[threadIdx.x] = 0u;
    __syncthreads();
    unsigned char* ws = p.ws;
    XcdBarrier xb = xcd_barrier_post((unsigned*)(ws + OFF_BAR), bst);
    const int G = gridDim.x, bid = blockIdx.x;
    const size_t gsz = (size_t)G * NT;
    const int nwaves = G * 8;
    float* ldsf = (float*)lds;
#define PH_VARS int tid = threadIdx.x; asm volatile("" : "+v"(tid)); const int lane = tid & 63, wave = __builtin_amdgcn_readfirstlane(tid >> 6); \
    const size_t gtid = (size_t)bid * NT + tid; const int gwave = bid * 8 + wave; (void)gtid; (void)gwave; (void)lane;

    float* X = (float*)(ws + OFF_X);
    bf16_t* Hb = (bf16_t*)(ws + OFF_HB);
    float* P = (float*)(ws + OFF_P);
    float* Q = (float*)(ws + OFF_P);
    float* U = (float*)(ws + OFF_U);
    float* Z1 = (float*)(ws + OFF_Z1);
    bf16_t* Y = (bf16_t*)(ws + OFF_Y);
    float* HF = (float*)(ws + OFF_HF);
    float* HFC = (float*)(ws + OFF_HFC);
    bf16_t* WinT = (bf16_t*)(ws + OFF_WIN);
    bf16_t* WoutT = (bf16_t*)(ws + OFF_WOUT);
    bf16_t* WqT = (bf16_t*)(ws + OFF_WQ);
    float* MODP = (float*)(ws + OFF_MODP);
    float* MOD = (float*)(ws + OFF_MOD);
    float* TAB = (float*)(ws + OFF_TAB);

    {
        PH_VARS
        { const float4* s1 = (const float4*)p.in[0]; const float4* s2 = (const float4*)p.in[2]; float4* d4 = (float4*)X;
          const size_t n1 = (size_t)NLAT * D / 4, n2 = (size_t)NCTX * D / 4;
          for (size_t i = gtid; i < n1; i += gsz) d4[i] = s1[i];
          for (size_t i = gtid; i < n2; i += gsz) d4[n1 + i] = s2[i]; }
        for (int l = 0; l < 2; ++l) {
            transpose_convert(p.in[7] + (size_t)l * D * INC, WinT + (size_t)l * INC * D, D, INC, gtid, gsz);
            transpose_convert(p.in[24] + (size_t)l * D * D, WoutT + (size_t)l * D * D, D, D, gtid, gsz);
            transpose_convert(p.in[26] + (size_t)l * D * 2048, WqT + (size_t)l * 2048 * D, D, 2048, gtid, gsz);
        }
        for (int i = tid; i < 3 * D; i += NT) { const float cv = i < 2 * D ? p.in[1][i] : p.in[3][i - 2 * D]; ldsf[i] = cv / (1.f + expf(-cv)); }
        __syncthreads();
        for (size_t idx = gtid; idx < (size_t)16 * 2 * 6144; idx += gsz) {
            const int j = (int)(idx % 6144), l = (int)((idx / 6144) & 1), s = (int)(idx / 12288);
            const float* w = p.in[4] + ((size_t)l * D + s * 64) * 6144 + j;
            float a0 = 0.f, a1 = 0.f, a2 = 0.f;
            for (int k = 0; k < 64; ++k) { const float wv = w[(size_t)k * 6144]; a0 += ldsf[s * 64 + k] * wv; a1 += ldsf[D + s * 64 + k] * wv; a2 += ldsf[2 * D + s * 64 + k] * wv; }
            float* o = MODP + ((size_t)(s * 2 + l) * 3) * 6144 + j;
            o[0] = a0; o[6144] = a1; o[2 * 6144] = a2;
        }
        for (size_t idx = gtid; idx < 128 * 24; idx += gsz) {
            const int pos = (int)(idx / 24), f = (int)(idx % 24);
            const float inv = f < 16 ? powf(10000.f, -(float)(2 * f) / 32.f) : powf(10000.f, -(float)(2 * (f - 16)) / 16.f);
            const float ang = (float)pos * inv;
            TAB[idx * 2] = cosf(ang); TAB[idx * 2 + 1] = sinf(ang);
        }
        for (int it = gwave; it < 2 * SEQ + CTX; it += nwaves) {
            int l, n, t; float* dst;
            if (it < SEQ) { l = 0; n = SEQ; t = it; dst = HF; }
            else if (it < 2 * SEQ) { l = 1; n = SEQ; t = it - SEQ; dst = HF + (size_t)SEQ * 1024; }
            else { l = 0; n = CTX; t = it - 2 * SEQ; dst = HFC; }
            const float tt = (float)t / (float)(n - 1);
            float fe = 0.f;
            if (lane == 0) fe = tt;
            else if (lane <= 32) {
                const int j = (lane - 1) & 15;
                const float band = 1e-4f + (float)j * ((15.f - 1e-4f) / 15.f);
                const float ph = ((float)(6.283185307179586 / (double)n) * (float)t) * band;
                fe = lane <= 16 ? cosf(ph) : -sinf(ph);
            }
            const float* w1 = p.in[10] + (size_t)l * 33 * 64; const float* b1 = p.in[11] + l * 64; const float* fr = p.in[12] + l * 64;
            const float* w2 = p.in[13] + (size_t)l * 64 * 64; const float* b2 = p.in[14] + l * 64; const float* w3 = p.in[15] + (size_t)l * 64 * 1024;
            const float* dec = p.in[16] + (size_t)l * 1024;
            const float fq = fr[lane];
            float a1 = b1[lane];
#pragma unroll
            for (int e = 0; e < 33; ++e) a1 += rdlane(fe, e) * w1[e * 64 + lane];
            const float z1 = sinf(fq * a1);
            float a2 = b2[lane];
#pragma unroll
            for (int i = 0; i < 64; ++i) a2 += rdlane(z1, i) * w2[i * 64 + lane];
            const float z2 = sinf(fq * a2);
            float hv[16];
#pragma unroll
            for (int m = 0; m < 16; ++m) hv[m] = 0.f;
#pragma unroll
            for (int i = 0; i < 64; ++i) { const float zi = rdlane(z2, i);
#pragma unroll
                for (int m = 0; m < 16; ++m) hv[m] += zi * w3[(size_t)i * 1024 + lane + 64 * m]; }
#pragma unroll
            for (int m = 0; m < 16; ++m) { const int col = lane + 64 * m; dst[(size_t)t * 1024 + col] = hv[m] * expf(-tt * fabsf(dec[col])); }
        }
    }
    grid.sync();
    { PH_VARS
    for (size_t idx = gtid; idx < (size_t)2 * 3 * 6144; idx += gsz) {
        const int j = (int)(idx % 6144), r = (int)((idx / 6144) % 3), l = (int)(idx / (3 * 6144));
        float a = p.in[5][l * 6144 + j];
        for (int s = 0; s < 16; ++s) a += MODP[((size_t)(s * 2 + l) * 3 + r) * 6144 + j];
        MOD[idx] = a;
    } }
    xcd_barrier(xb);

    for (int l = 0; l < 2; ++l) {
        const bool with_ctx = (l == 0);
        const float* MODl = MOD + (size_t)l * 3 * 6144;
        const float* HFl = HF + (size_t)l * SEQ * 1024;
        const float lam_init = 0.8f - 0.6f * expf(-0.3f * (float)l);
        { PH_VARS norm_phase(X, p.in[6] + l * D, MODl, 0, 1024, NTOK, Hb, gwave, nwaves, lane); }
        xcd_barrier(xb);
        { pg8::Gemm g{Hb, WinT + (size_t)l * INC * D, NTOK, INC, D}; pg8::StaticOrder S; S.init(NTOK, INC, G, bid);
          pg8::EpiF32 E{P, INC, nullptr};
          pg8::gemm_phase<pg8::EpiF32, pg8::StaticOrder>((PG8_LAS unsigned char*)lds, g, S, E); }
        xcd_barrier(xb);
        {
            PH_VARS
            const float* cw = p.in[8] + (size_t)l * 3 * 768; const float* cb = p.in[9] + l * 768;
            for (int row = gwave; row < NTOK; row += nwaves) {
                bool hp, hn;
                if (row < NLAT) { const int t = row & (SEQ - 1); hp = t > 0; hn = t < SEQ - 1; } else { const int c = (row - NLAT) & (CTX - 1); hp = c > 0; hn = c < CTX - 1; }
                const float* pr = P + (size_t)row * INC;
#pragma unroll
                for (int m = 0; m < 12; ++m) { const int col = lane + 64 * m;
                    float a = cb[col] + cw[768 + col] * pr[col];
                    if (hp) a += cw[col] * pr[col - INC];
                    if (hn) a += cw[2 * 768 + col] * pr[col + INC];
                    U[(size_t)row * 768 + col] = a; }
                if (row < NLAT) {
                    const int t = row & (SEQ - 1), pos_r = t >> 6, pos_c = t & 63;
                    float* prw = P + (size_t)row * INC;
#pragma unroll
                    for (int m = 0; m < 9; ++m) { const int pp = lane + 64 * m;
                        int i1, i2, f, pos;
                        if (pp < 320) { const int hd = pp >> 5, j = pp & 31, half = j >> 4, i = j & 15;
                            const int base = (hd < 8 ? C_WAQ + hd * 64 : C_WAK + (hd - 8) * 64) + half * 32;
                            i1 = base + i; i2 = base + 16 + i; f = i; pos = half ? pos_c : pos_r; }
                        else { const int q = pp - 320, unit = q >> 4, j = q & 15, half = j >> 3, i = j & 7;
                            const int base = C_DAQ + unit * 32 + half * 16;
                            i1 = base + i; i2 = base + 8 + i; f = 16 + i; pos = half ? pos_c : pos_r; }
                        const float cs = TAB[(pos * 24 + f) * 2], sn = TAB[(pos * 24 + f) * 2 + 1];
                        const float x1 = prw[i1], x2 = prw[i2];
                        prw[i1] = x1 * cs - x2 * sn; prw[i2] = x2 * cs + x1 * sn; }
                }
            }
        }
        xcd_barrier(xb);
        { PH_VARS hyena_conv_phase(0, l, with_ctx, U, Z1, Y, HFl, HFC, p.in[17], bid, G, tid); }
        {
            PH_VARS
            float* qs = ldsf + wave * 640; float* sc = qs + 64;
            const int nrows = with_ctx ? NTOK : NLAT;
            for (int it = gwave; it < nrows * 8; it += nwaves) {
                const int hq = it & 7, row = it >> 3, hkv = hq >> 2;
                const bool isctx = row >= NLAT;
                const int b = isctx ? ((row - NLAT) >> 8) : (row >> 13);
                const int t = row & (SEQ - 1);
                qs[lane] = P[(size_t)row * INC + C_WAQ + hq * 64 + lane] * 0.125f;
                WAVE_SYNC();
                int lo = 0, nl = 0;
                if (!isctx) { lo = t - 128 < 0 ? 0 : t - 128; const int hi = t + 128 > SEQ - 1 ? SEQ - 1 : t + 128; nl = hi - lo + 1; }
                const int nk = nl + CTX;
                const float sink = p.in[18][l * 8 + hq];
                float mx = -3.0e38f;
                for (int j = lane; j < nk; j += 64) {
                    const int keyrow = j < nl ? b * SEQ + lo + j : NLAT + b * CTX + (j - nl);
                    const float4* kp = (const float4*)(P + (size_t)keyrow * INC + C_WAK + hkv * 64);
                    float s = 0.f;
#pragma unroll
                    for (int d4 = 0; d4 < 16; ++d4) { const float4 kv = kp[d4]; s += qs[4 * d4] * kv.x + qs[4 * d4 + 1] * kv.y + qs[4 * d4 + 2] * kv.z + qs[4 * d4 + 3] * kv.w; }
                    sc[j] = s; mx = fmaxf(mx, s);
                }
                mx = fmaxf(wave_max(mx), sink);
                float sm = 0.f;
                for (int j = lane; j < nk; j += 64) { const float e = expf(sc[j] - mx); sc[j] = e; sm += e; }
                sm = wave_sum(sm) + expf(sink - mx);
                WAVE_SYNC();
                float acc = 0.f;
                for (int j = 0; j < nk; ++j) {
                    const int keyrow = j < nl ? b * SEQ + lo + j : NLAT + b * CTX + (j - nl);
                    acc += sc[j] * P[(size_t)keyrow * INC + C_WAV + hkv * 64 + lane];
                }
                Y[(size_t)row * D + 256 + hq * 64 + lane] = f2bf(acc / sm);
                WAVE_SYNC();
            }
        }
        {
            PH_VARS
            float* qs = ldsf + wave * 640; float* as = qs + 64;
            float lam;
            { float s1 = 0.f, s2 = 0.f;
              for (int i = 0; i < 32; ++i) { s1 += p.in[19][l * 32 + i] * p.in[20][l * 32 + i]; s2 += p.in[21][l * 32 + i] * p.in[22][l * 32 + i]; }
              lam = expf(s1) - expf(s2) + lam_init; }
            const int nrows = with_ctx ? NTOK : NLAT;
            for (int it = gwave; it < nrows * 4; it += nwaves) {
                const int h = it & 3, row = it >> 2;
                const bool isctx = row >= NLAT;
                const int b = isctx ? ((row - NLAT) >> 8) : (row >> 13);
                qs[lane] = P[(size_t)row * INC + C_DAQ + h * 64 + lane] * 0.17677669529663687f;
                WAVE_SYNC();
                const int nk = isctx ? CTX : SEQ + CTX;
                float m1 = -3.0e38f, m2 = -3.0e38f, l1 = 0.f, l2 = 0.f;
                for (int j = lane; j < nk; j += 64) {
                    const int keyrow = isctx ? NLAT + b * CTX + j : (j < SEQ ? b * SEQ + j : NLAT + b * CTX + (j - SEQ));
                    const float4* kp = (const float4*)(P + (size_t)keyrow * INC + C_DAK + h * 64);
                    float s1 = 0.f, s2 = 0.f;
#pragma unroll
                    for (int d4 = 0; d4 < 8; ++d4) { const float4 kv = kp[d4]; s1 += qs[4 * d4] * kv.x + qs[4 * d4 + 1] * kv.y + qs[4 * d4 + 2] * kv.z + qs[4 * d4 + 3] * kv.w; }
#pragma unroll
                    for (int d4 = 8; d4 < 16; ++d4) { const float4 kv = kp[d4]; s2 += qs[4 * d4] * kv.x + qs[4 * d4 + 1] * kv.y + qs[4 * d4 + 2] * kv.z + qs[4 * d4 + 3] * kv.w; }
                    if (s1 > m1) { l1 = l1 * expf(m1 - s1) + 1.f; m1 = s1; } else l1 += expf(s1 - m1);
                    if (s2 > m2) { l2 = l2 * expf(m2 - s2) + 1.f; m2 = s2; } else l2 += expf(s2 - m2);
                }
                const float M1 = wave_max(m1), M2 = wave_max(m2);
                const float L1 = wave_sum(l1 * expf(m1 - M1)), L2 = wave_sum(l2 * expf(m2 - M2));
                const float i1 = 1.f / L1, i2 = lam / L2;
                float acc = 0.f;
                for (int j0 = 0; j0 < nk; j0 += 64) {
                    const int j = j0 + lane;
                    const int keyrow = isctx ? NLAT + b * CTX + j : (j < SEQ ? b * SEQ + j : NLAT + b * CTX + (j - SEQ));
                    const float4* kp = (const float4*)(P + (size_t)keyrow * INC + C_DAK + h * 64);
                    float s1 = 0.f, s2 = 0.f;
#pragma unroll
                    for (int d4 = 0; d4 < 8; ++d4) { const float4 kv = kp[d4]; s1 += qs[4 * d4] * kv.x + qs[4 * d4 + 1] * kv.y + qs[4 * d4 + 2] * kv.z + qs[4 * d4 + 3] * kv.w; }
#pragma unroll
                    for (int d4 = 8; d4 < 16; ++d4) { const float4 kv = kp[d4]; s2 += qs[4 * d4] * kv.x + qs[4 * d4 + 1] * kv.y + qs[4 * d4 + 2] * kv.z + qs[4 * d4 + 3] * kv.w; }
                    as[lane] = expf(s1 - M1) * i1 - expf(s2 - M2) * i2;
                    WAVE_SYNC();
                    const int kr0 = isctx ? NLAT + b * CTX + j0 : (j0 < SEQ ? b * SEQ + j0 : NLAT + b * CTX + (j0 - SEQ));
                    const float* vp = P + (size_t)kr0 * INC + C_DAV + h * 64 + lane;
#pragma unroll 8
                    for (int jj = 0; jj < 64; ++jj) acc += as[jj] * vp[(size_t)jj * INC];
                    WAVE_SYNC();
                }
                const float ss = wave_sum(acc * acc);
                const float y = acc * rsqrtf(ss * (1.f / 64.f) + 1e-6f) * p.in[23][l * 64 + lane] * (1.f - lam_init);
                Y[(size_t)row * D + 768 + h * 64 + lane] = f2bf(y);
            }
        }
        xcd_barrier(xb);
        { PH_VARS hyena_conv_phase(1, l, with_ctx, U, Z1, Y, HFl, HFC, p.in[17], bid, G, tid); }
        xcd_barrier(xb);
        const int Mrows = with_ctx ? NTOK : NLAT;
        { pg8::Gemm g{Y, WoutT + (size_t)l * D * D, Mrows, D, D}; pg8::StaticOrder S; S.init(Mrows, D, G, bid);
          EpiResid E{X, MODl};
          pg8::gemm_phase<EpiResid, pg8::StaticOrder>((PG8_LAS unsigned char*)lds, g, S, E); }
        xcd_barrier(xb);
        { PH_VARS norm_phase(X, p.in[25] + l * D, MODl, 3072, 4096, Mrows, Hb, gwave, nwaves, lane); }
        xcd_barrier(xb);
        { pg8::Gemm g{Hb, WqT + (size_t)l * 2048 * D, Mrows, 2048, D}; pg8::StaticOrder S; S.init(Mrows, 2048, G, bid);
          pg8::EpiF32 E{Q, 2048, nullptr};
          pg8::gemm_phase<pg8::EpiF32, pg8::StaticOrder>((PG8_LAS unsigned char*)lds, g, S, E); }
        xcd_barrier(xb);
        {
            PH_VARS
            float* qs = ldsf + wave * 2816;
            float* st = qs + 2048; int* itp = (int*)(st + 256); int* gidx = itp + 256; float* gate = (float*)(gidx + 128);
            const float* KEYS = p.in[27] + (size_t)l * 16 * 128 * 128;
            const float* UU = p.in[28] + (size_t)l * NEXP * D; const float* VV = p.in[29] + (size_t)l * NEXP * D;
            const float4* g4 = (const float4*)(p.in[25] + l * D);
            for (int row = gwave; row < Mrows; row += nwaves) {
                const int r = row < NLAT ? (row >> 13) : 2;
#pragma unroll
                for (int i = 0; i < 32; ++i) qs[lane + 64 * i] = Q[(size_t)row * 2048 + lane + 64 * i];
                WAVE_SYNC();
                for (int g = 0; g < 16; ++g) {
                    const float4* k0p = (const float4*)(KEYS + ((size_t)g * 128 + lane) * 128);
                    const float4* k1p = (const float4*)(KEYS + ((size_t)g * 128 + lane + 64) * 128);
                    const float* qg = qs + g * 128;
                    float s0 = 0.f, s1 = 0.f;
#pragma unroll 8
                    for (int d4 = 0; d4 < 32; ++d4) { const float4 a = k0p[d4], b = k1p[d4];
                        const float q0 = qg[4 * d4], q1 = qg[4 * d4 + 1], q2 = qg[4 * d4 + 2], q3 = qg[4 * d4 + 3];
                        s0 += q0 * a.x + q1 * a.y + q2 * a.z + q3 * a.w; s1 += q0 * b.x + q1 * b.y + q2 * b.z + q3 * b.w; }
                    for (int r16 = 0; r16 < 16; ++r16) {
                        float bv; int bi;
                        if (s0 >= s1) { bv = s0; bi = lane; } else { bv = s1; bi = lane + 64; }
#pragma unroll
                        for (int o = 32; o > 0; o >>= 1) { const float ov = __shfl_xor(bv, o); const int oi = __shfl_xor(bi, o); if (ov > bv || (ov == bv && oi < bi)) { bv = ov; bi = oi; } }
                        if (lane == 0) { st[g * 16 + r16] = bv; itp[g * 16 + r16] = bi; }
                        if (bi == lane) s0 = -3.0e38f;
                        if (bi == lane + 64) s1 = -3.0e38f;
                    }
                }
                WAVE_SYNC();
                for (int h = 0; h < 8; ++h) {
                    float cs[4];
#pragma unroll
                    for (int e = 0; e < 4; ++e) { const int f = lane + 64 * e; cs[e] = st[(2 * h) * 16 + (f >> 4)] + st[(2 * h + 1) * 16 + (f & 15)]; }
                    float mys = -3.0e38f; int myf = 0;
                    for (int r16 = 0; r16 < 16; ++r16) {
                        float bv = cs[0]; int bi = lane;
#pragma unroll
                        for (int e = 1; e < 4; ++e) if (cs[e] > bv) { bv = cs[e]; bi = lane + 64 * e; }
#pragma unroll
                        for (int o = 32; o > 0; o >>= 1) { const float ov = __shfl_xor(bv, o); const int oi = __shfl_xor(bi, o); if (ov > bv || (ov == bv && oi < bi)) { bv = ov; bi = oi; } }
                        if (lane == r16) { mys = bv; myf = bi; }
#pragma unroll
                        for (int e = 0; e < 4; ++e) if (bi == lane + 64 * e) cs[e] = -3.0e38f;
                    }
                    const float mxs = wave_max(mys);
                    const float ev = lane < 16 ? expf(mys - mxs) : 0.f;
                    const float sm = wave_sum(ev);
                    if (lane < 16) { gidx[h * 16 + lane] = itp[(2 * h) * 16 + (myf >> 4)] * 128 + itp[(2 * h + 1) * 16 + (myf & 15)]; gate[h * 16 + lane] = ev / sm; }
                }
                WAVE_SYNC();
                float4 xv[4], hv[4]; float ss = 0.f;
                const float4* xr = (const float4*)(X + (size_t)row * D);
#pragma unroll
                for (int j = 0; j < 4; ++j) { xv[j] = xr[lane + 64 * j]; ss += xv[j].x * xv[j].x + xv[j].y * xv[j].y + xv[j].z * xv[j].z + xv[j].w * xv[j].w; }
                ss = wave_sum(ss);
                const float rs = rsqrtf(ss * (1.f / D) + 1e-6f);
                const float4* sh4 = (const float4*)(MODl + r * 6144 + 3072); const float4* sc4 = (const float4*)(MODl + r * 6144 + 4096);
#pragma unroll
                for (int j = 0; j < 4; ++j) { const float4 gg = g4[lane + 64 * j], sh = sh4[lane + 64 * j], sc = sc4[lane + 64 * j];
                    hv[j].x = xv[j].x * rs * gg.x * (1.f + sc.x) + sh.x; hv[j].y = xv[j].y * rs * gg.y * (1.f + sc.y) + sh.y;
                    hv[j].z = xv[j].z * rs * gg.z * (1.f + sc.z) + sh.z; hv[j].w = xv[j].w * rs * gg.w * (1.f + sc.w) + sh.w; }
                float4 ov[4];
#pragma unroll
                for (int j = 0; j < 4; ++j) ov[j] = make_float4(0.f, 0.f, 0.f, 0.f);
                for (int e = 0; e < 128; ++e) {
                    const int ex = gidx[e]; const float gt = gate[e];
                    const float4* up = (const float4*)(UU + (size_t)ex * D); const float4* vp = (const float4*)(VV + (size_t)ex * D);
                    float dot = 0.f;
#pragma unroll
                    for (int j = 0; j < 4; ++j) { const float4 u4 = up[lane + 64 * j]; dot += hv[j].x * u4.x + hv[j].y * u4.y + hv[j].z * u4.z + hv[j].w * u4.w; }
                    dot = wave_sum(dot);
                    const float w = gt * 0.5f * dot * (1.f + erff(dot * 0.70710678118654752f));
#pragma unroll
                    for (int j = 0; j < 4; ++j) { const float4 v4 = vp[lane + 64 * j]; ov[j].x += w * v4.x; ov[j].y += w * v4.y; ov[j].z += w * v4.z; ov[j].w += w * v4.w; }
                }
                const float4* gm4 = (const float4*)(MODl + r * 6144 + 5120);
                float4* xw = (float4*)(X + (size_t)row * D);
#pragma unroll
                for (int j = 0; j < 4; ++j) { const float4 gm = gm4[lane + 64 * j]; float4 o;
                    o.x = xv[j].x + gm.x * ov[j].x; o.y = xv[j].y + gm.y * ov[j].y; o.z = xv[j].z + gm.z * ov[j].z; o.w = xv[j].w + gm.w * ov[j].w; xw[lane + 64 * j] = o; }
                WAVE_SYNC();
            }
        }
        xcd_barrier(xb);
    }
    {
        PH_VARS
        const float4* fg = (const float4*)p.in[30];
        for (int row = gwave; row < NLAT; row += nwaves) {
            const float4* xr = (const float4*)(X + (size_t)row * D);
            float4 v[4]; float ss = 0.f;
#pragma unroll
            for (int j = 0; j < 4; ++j) { v[j] = xr[lane + 64 * j]; ss += v[j].x * v[j].x + v[j].y * v[j].y + v[j].z * v[j].z + v[j].w * v[j].w; }
            ss = wave_sum(ss);
            const float rs = rsqrtf(ss * (1.f / D) + 1e-6f);
            float4* orow = (float4*)(p.out + (size_t)row * D);
#pragma unroll
            for (int j = 0; j < 4; ++j) { const float4 g = fg[lane + 64 * j]; float4 o; o.x = v[j].x * rs * g.x; o.y = v[j].y * rs * g.y; o.z = v[j].z * rs * g.z; o.w = v[j].w * rs * g.w; orow[lane + 64 * j] = o; }
        }
    }
}

extern "C" void kernel_launch(void* const* d_in, const int* in_sizes, int n_in, void* d_out, int out_size, void* d_ws, size_t ws_size, hipStream_t stream) {
    static int grid_blocks = 0;
    if (!grid_blocks) {
        int dev = 0, cus = 0, per_cu = 0;
        (void)hipGetDevice(&dev);
        (void)hipDeviceGetAttribute(&cus, hipDeviceAttributeMultiprocessorCount, dev);
        (void)hipFuncSetAttribute((const void*)mega, hipFuncAttributeMaxDynamicSharedMemorySize, LDS_BYTES);
        (void)hipOccupancyMaxActiveBlocksPerMultiprocessor(&per_cu, (const void*)mega, NT, LDS_BYTES);
        if (per_cu < 1) fprintf(stderr, "kernel_launch: occupancy query reports %d blocks per CU\n", per_cu);
        if (ws_size < OFF_END) fprintf(stderr, "kernel_launch: workspace too small: %zu < %zu\n", ws_size, (size_t)OFF_END);
        grid_blocks = cus;
    }
    Params p{};
    for (int i = 0; i < 31 && i < n_in; ++i) p.in[i] = (const float*)d_in[i];
    p.out = (float*)d_out;
    p.ws = (unsigned char*)d_ws;
    (void)hipMemsetAsync(d_ws, 0, XCD_BAR_WORDS * 4, stream);
    void* args[] = {&p};
    hipError_t e = hipLaunchCooperativeKernel((const void*)mega, dim3(grid_blocks), dim3(NT), args, LDS_BYTES, stream);
    if (e != hipSuccess) fprintf(stderr, "cooperative launch failed: %s (grid %d)\n", hipGetErrorString(e), grid_blocks);
}
```

```cpp
#include <hip/hip_runtime.h>
#include <hip/hip_cooperative_groups.h>
#include <cstdio>
#include <cstdint>
namespace cg = cooperative_groups;

#define NT 512
#define LAS __attribute__((address_space(3)))

#define XB_TMO      128
#define XB_XCNT(j)  (256  + 64 * (j))
#define XB_XSUB(j)  (1280 + 64 * (j))
#define XB_XGEN(j)  (2304 + 64 * (j))
#define XB_TOP      3328
#define XB_TOPGEN   3392
#define XCD_BAR_WORDS 3456
#define XB_SPIN_CAP (1u << 26)

__device__ __forceinline__ unsigned xb_ld(unsigned* p)              { return __hip_atomic_load(p, __ATOMIC_RELAXED, __HIP_MEMORY_SCOPE_AGENT); }
__device__ __forceinline__ unsigned xb_add(unsigned* p, unsigned v) { return __hip_atomic_fetch_add(p, v, __ATOMIC_RELAXED, __HIP_MEMORY_SCOPE_AGENT); }
__device__ __forceinline__ unsigned xb_xcc_id() { return (unsigned)__builtin_amdgcn_s_getreg((3 << 11) | 20) & 0xFu; }
#define XB_SPIN(cond, bar) do { unsigned _sp = 0; while (cond) { __builtin_amdgcn_s_sleep(1); \
    if ((++_sp & 255u) == 0u) { if (xb_ld(&(bar)[XB_TMO])) break; if (_sp > XB_SPIN_CAP) { atomicAdd(&(bar)[XB_TMO], 1u); break; } } } } while (0)

struct XcdBarrier { unsigned* bar; unsigned x; volatile LAS unsigned* st; };

__device__ __forceinline__ XcdBarrier xcd_barrier_post(unsigned* bar, volatile LAS unsigned* st) {
    XcdBarrier b; b.bar = bar; b.x = xb_xcc_id(); b.st = st;
    if (threadIdx.x == 0) (void)xb_add(&bar[XB_XCNT(b.x)], 1u);
    return b;
}
__device__ __forceinline__ void xcd_barrier_complete(unsigned* bar, unsigned x, unsigned& nloc, unsigned& nx) {
    const unsigned G = gridDim.x * gridDim.y * gridDim.z;
    unsigned sum, cnt, mine, sp = 0u;
    for (;;) {
        sum = 0u; cnt = 0u; mine = 0u;
#pragma unroll
        for (unsigned j = 0; j < 16; ++j) { const unsigned c = xb_ld(&bar[XB_XCNT(j)]); sum += c; cnt += (c > 0u) ? 1u : 0u; mine = (j == x) ? c : mine; }
        if (sum == G) break;
        __builtin_amdgcn_s_sleep(1);
        if ((++sp & 255u) == 0u) { if (xb_ld(&bar[XB_TMO])) break; if (sp > XB_SPIN_CAP) { atomicAdd(&bar[XB_TMO], 1u); break; } }
    }
    nloc = mine > 0u ? mine : 1u; nx = cnt > 0u ? cnt : 1u;
}
__device__ __forceinline__ void xcd_barrier(const XcdBarrier& b, int wave_s) {
    asm volatile("s_waitcnt vmcnt(0)" ::: "memory");
    __syncthreads();
    int lane_b; asm volatile("v_mbcnt_lo_u32_b32 %0, -1, 0\n\tv_mbcnt_hi_u32_b32 %0, -1, %0" : "=&v"(lane_b));
    if (wave_s == 0 && lane_b == 0) {
        unsigned* bar = b.bar; unsigned bx = b.x;
        asm volatile("" : "+s"(bar), "+s"(bx));
        __builtin_amdgcn_s_waitcnt(0);
        unsigned nloc = b.st[0], nx = b.st[1];
        if (nloc == 0u) { xcd_barrier_complete(bar, bx, nloc, nx); b.st[0] = nloc; b.st[1] = nx; }
        const unsigned old = xb_add(&bar[XB_XSUB(bx)], 1u);
        const unsigned gen = old / nloc;
        if (old + 1u == (gen + 1u) * nloc) {
            __builtin_amdgcn_fence(__ATOMIC_RELEASE, "agent");
            asm volatile("s_waitcnt vmcnt(0)" ::: "memory");
            const unsigned og = xb_add(&bar[XB_TOP], 1u);
            const unsigned tg = og / nx;
            if (og + 1u == (tg + 1u) * nx) xb_add(&bar[XB_TOPGEN], 1u);
            else XB_SPIN(xb_ld(&bar[XB_TOPGEN]) == tg, bar);
            __builtin_amdgcn_fence(__ATOMIC_ACQUIRE, "agent");
            xb_add(&bar[XB_XGEN(bx)], 1u);
            asm volatile("s_waitcnt vmcnt(0)" ::: "memory");
        } else {
            XB_SPIN(xb_ld(&bar[XB_XGEN(bx)]) == gen, bar);
            __builtin_amdgcn_fence(__ATOMIC_ACQUIRE, "agent");
            asm volatile("s_waitcnt vmcnt(0)" ::: "memory");
        }
    }
    __syncthreads();
}

namespace pg8 {
#define PG8_LAS __attribute__((address_space(3)))
typedef unsigned short bf16_t;
typedef short bf16x8 __attribute__((ext_vector_type(8)));
typedef float f32x4 __attribute__((ext_vector_type(4)));
typedef unsigned u32x4 __attribute__((ext_vector_type(4)));
constexpr int BM = 256, BK = 64, HALF = 128, HTB = HALF * BK * 2  , STAGE_BYTES = 8 * HTB, NXCD = 8, WGM = 8;

__host__ __device__ __forceinline__ int lds_byte(int r, int c) { const int st = (r >> 4) * 2 + (c >> 5), rr = r & 15, cc = c & 31, ob = rr * 64 + cc * 2; return st * 1024 + (ob ^ (((ob >> 9) & 1) << 5)); }
__host__ __device__ __forceinline__ void stage_rc(int b, int& R, int& C) { const int st = b / 1024, sb = b % 1024, swz = sb ^ (((sb >> 9) & 1) << 5); R = (st >> 1) * 16 + swz / 64; C = (st & 1) * 32 + (swz % 64) / 2; }
__host__ __device__ __forceinline__ int perm32(int rho) { const int n = rho >> 4, i = rho & 15; return 8 * (i >> 2) + 4 * n + (i & 3); }

struct Unit { int pm, pn; };
struct Gemm { const bf16_t* A; const bf16_t* Bt; int M, N, K; };

struct StaticOrder {
    int nM, nN, nwg, G, c;
    __host__ __device__ void init(int M, int N, int G_, int c_) { nM = M / BM; nN = N / BM; nwg = nM * nN; G = G_; c = c_; }
    __host__ __device__ bool next(int i, Unit& u) const {
        const long L = (long)i * G + c; if (L >= nwg) return false;
        int wgid = (int)L; { const int q = nwg / NXCD, r = nwg % NXCD, xcd = wgid % NXCD, off = wgid / NXCD; wgid = (xcd < r ? xcd * (q + 1) : r * (q + 1) + (xcd - r) * q) + off; }
        const int nig = WGM * nN, gid = wgid / nig, fm = gid * WGM, gsz = (nM - fm) < WGM ? (nM - fm) : WGM;
        u.pm = fm + ((wgid % nig) % gsz); u.pn = (wgid % nig) / gsz; return true;
    }
    __device__ __forceinline__ void a_ready(const Unit&) const {}
    __device__ __forceinline__ void done(const Unit&) const {}
};
struct CountedOrder : StaticOrder {
    const unsigned* ready; unsigned need; unsigned* tmo;
    __device__ __forceinline__ void a_ready(const Unit& u) const {
        if (threadIdx.x < 64) {
            const unsigned long long t0 = __builtin_amdgcn_s_memrealtime(); unsigned polls = 0;
            while ((unsigned)__builtin_amdgcn_readfirstlane(__hip_atomic_load(ready + 64 * u.pm, __ATOMIC_RELAXED, __HIP_MEMORY_SCOPE_AGENT)) < need) {
                if ((++polls & 255u) == 0u && __builtin_amdgcn_readfirstlane(__hip_atomic_load(tmo, __ATOMIC_RELAXED, __HIP_MEMORY_SCOPE_AGENT)) != 0u) break;
                if (__builtin_amdgcn_s_memrealtime() - t0 > 2000000ull) {
                    if (threadIdx.x == 0) { unsigned expect = 0u; __hip_atomic_compare_exchange_strong(tmo + 1, &expect, 0x600u | (unsigned)(u.pm & 0xff), __ATOMIC_RELAXED, __ATOMIC_RELAXED, __HIP_MEMORY_SCOPE_AGENT); __hip_atomic_store(tmo, 1u, __ATOMIC_RELAXED, __HIP_MEMORY_SCOPE_AGENT); }
                    break; }
                __builtin_amdgcn_s_sleep(2); }
            __builtin_amdgcn_fence(__ATOMIC_ACQUIRE, "agent");
            asm volatile("s_waitcnt vmcnt(0)" ::: "memory");
        }
#if !defined(BROKEN_HOOK_NO_BARRIER)
        asm volatile("" ::: "memory"); __builtin_amdgcn_s_barrier(); asm volatile("" ::: "memory");
#endif
    }
};

__device__ __forceinline__ unsigned cvt_pk_bf16(float lo, float hi) { unsigned r; asm volatile("v_cvt_pk_bf16_f32 %0, %1, %2" : "=v"(r) : "v"(lo), "v"(hi)); return r; }
typedef float f32x2 __attribute__((ext_vector_type(2)));
__device__ __forceinline__ f32x2 gelu_pk(f32x2 v) {
    const f32x2 av = __builtin_elementwise_abs(v), d = av * 0.2316418882f + 1.0f;
    f32x2 t; t.x = __builtin_amdgcn_rcpf(d.x); t.y = __builtin_amdgcn_rcpf(d.y);
    f32x2 q = t * 0.5307027145f + (-0.7265760135f); q = q * t + 0.7107068705f; q = q * t + (-0.142248368f); q = q * t + 0.127414796f; q = q * t;
    const f32x2 s = (v * v) * (-0.72134752044f);
    f32x2 e; e.x = __builtin_amdgcn_exp2f(s.x); e.y = __builtin_amdgcn_exp2f(s.y);
    const f32x2 m = v * (q * e), r = v - m;
    f32x2 o; o.x = v.x < 0.f ? m.x : r.x; o.y = v.y < 0.f ? m.y : r.y; return o;
}

struct EpiF32 {
    static constexpr bool PERM = false, AFTER_DRAIN = false; static constexpr int REPS = 1;
    float* C; int ldc; const float* bias;
    __device__ __forceinline__ void operator()(const f32x4 (&acc)[2][2][4][2], const Unit& u, int wr, int wc, int fr, int fq) const {
        const int row0 = u.pm * BM + wr * 64 + fr, col0 = u.pn * BM + wc * 32 + 4 * fq;
        f32x4 bv[2][2];
#pragma unroll
        for (int bj = 0; bj < 2; ++bj)
#pragma unroll
            for (int n = 0; n < 2; ++n) bv[bj][n] = bias ? *(const f32x4*)(bias + col0 + bj * HALF + n * 16) : (f32x4){0.f, 0.f, 0.f, 0.f};
#pragma unroll
        for (int ai = 0; ai < 2; ++ai)
#pragma unroll
            for (int m = 0; m < 4; ++m) { float* rowp = C + (size_t)(row0 + ai * HALF + m * 16) * ldc + col0;
#pragma unroll
                for (int bj = 0; bj < 2; ++bj)
#pragma unroll
                    for (int n = 0; n < 2; ++n) *(f32x4*)(rowp + bj * HALF + n * 16) = acc[ai][bj][m][n] + bv[bj][n]; }
    }
};

template <int ACT  > struct EpiBf16 {
    static constexpr bool PERM = true, AFTER_DRAIN = false; static constexpr int REPS = 1;
    bf16_t* O; int ldc; const float* bias; int split_cols; size_t split_stride;
    __device__ __forceinline__ void operator()(const f32x4 (&acc)[2][2][4][2], const Unit& u, int wr, int wc, int fr, int fq) const {
        const int row0 = u.pm * BM + wr * 64 + fr; int colt = u.pn * BM; bf16_t* base = O;
        if (split_cols) { const int t = colt / split_cols; base += (size_t)t * split_stride; colt -= t * split_cols; }
        const int col0 = colt + wc * 32 + 8 * fq, bcol0 = u.pn * BM + wc * 32 + 8 * fq;
        f32x4 bv[2][2];
#pragma unroll
        for (int bj = 0; bj < 2; ++bj)
#pragma unroll
            for (int n = 0; n < 2; ++n) bv[bj][n] = bias ? *(const f32x4*)(bias + bcol0 + bj * HALF + 4 * n) : (f32x4){0.f, 0.f, 0.f, 0.f};
#pragma unroll
        for (int ai = 0; ai < 2; ++ai)
#pragma unroll
            for (int m = 0; m < 4; ++m) { bf16_t* rowp = base + (size_t)(row0 + ai * HALF + m * 16) * ldc + col0;
#pragma unroll
                for (int bj = 0; bj < 2; ++bj) { f32x4 v0 = acc[ai][bj][m][0] + bv[bj][0], v1 = acc[ai][bj][m][1] + bv[bj][1];
                    if (ACT == 1) { f32x2 a = gelu_pk((f32x2){v0[0], v0[1]}), b = gelu_pk((f32x2){v0[2], v0[3]}), c = gelu_pk((f32x2){v1[0], v1[1]}), d = gelu_pk((f32x2){v1[2], v1[3]});
                        v0 = (f32x4){a.x, a.y, b.x, b.y}; v1 = (f32x4){c.x, c.y, d.x, d.y}; }
                    if (ACT == 2) {
#pragma unroll
                        for (int j = 0; j < 4; ++j) { v0[j] = 0.5f * v0[j] * (1.0f + erff(v0[j] * 0.70710678f)); v1[j] = 0.5f * v1[j] * (1.0f + erff(v1[j] * 0.70710678f)); } }
                    u32x4 w; w.x = cvt_pk_bf16(v0[0], v0[1]); w.y = cvt_pk_bf16(v0[2], v0[3]); w.z = cvt_pk_bf16(v1[0], v1[1]); w.w = cvt_pk_bf16(v1[2], v1[3]);
                    *(u32x4*)(rowp + bj * HALF) = w; } }
    }
};

template <class Epi, class Sched>
__device__ __forceinline__ void gemm_phase(PG8_LAS unsigned char* lds, const Gemm g, const Sched& S, const Epi& E, int tid_in) {
    int tid_o = tid_in; asm volatile("" : "+v"(tid_o));
    const int tid = tid_o, wid = __builtin_amdgcn_readfirstlane(tid >> 6), lane = tid & 63, wr = wid >> 2, wc = wid & 3, fr = lane & 15, fq = lane >> 4;
    const int K = g.K, nt = K / BK;
    unsigned voffA[2], voffB[2];
#pragma unroll
    for (int i = 0; i < 2; ++i) { int R, C; stage_rc(tid * 16 + i * 8192, R, C); const int Rb = Epi::PERM ? ((R & ~31) + perm32(R & 31)) : R;
        voffA[i] = (unsigned)(R * K + C) * 2u; voffB[i] = (unsigned)(Rb * K + C) * 2u; }
    const size_t kstep = (size_t)(BK * 2);
    const size_t hstep = (size_t)HALF * K * 2;
    const size_t tstep = 2 * hstep;
    const unsigned ldsw = (unsigned)wid * 1024u;
    const int aoff = lds_byte(wr * 64 + fr, fq * 8), boff = lds_byte(wc * 32 + fr, fq * 8);
#define PG8_SA(b, h) (((b) * 2 + (h)) * HTB)
#define PG8_SB(b, h) ((4 + (b) * 2 + (h)) * HTB)
#define PG8_STAGE(bufoff, gbase, voff) do { _Pragma("unroll") for (int _i = 0; _i < 2; ++_i) \
        __builtin_amdgcn_global_load_lds((const unsigned*)((const char*)(gbase) + (voff)[_i]), (PG8_LAS unsigned*)(lds + (bufoff) + ldsw + _i * 8192), 16, 0, 0); } while (0)
#define PG8_LDA(dst, b, h) do { _Pragma("unroll") for (int m = 0; m < 4; ++m) _Pragma("unroll") for (int k = 0; k < 2; ++k) dst[m][k] = *(const PG8_LAS bf16x8*)(lds + PG8_SA(b, h) + aoff + m * 2048 + k * 1024); } while (0)
#define PG8_LDB(dst, b, h) do { _Pragma("unroll") for (int n = 0; n < 2; ++n) _Pragma("unroll") for (int k = 0; k < 2; ++k) dst[n][k] = *(const PG8_LAS bf16x8*)(lds + PG8_SB(b, h) + boff + n * 2048 + k * 1024); } while (0)
#define PG8_MMA(ai, bj, At, Bt) do { __builtin_amdgcn_s_setprio(1); _Pragma("unroll") for (int m = 0; m < 4; ++m) _Pragma("unroll") for (int n = 0; n < 2; ++n) _Pragma("unroll") for (int k = 0; k < 2; ++k) \
        acc[ai][bj][m][n] = __builtin_amdgcn_mfma_f32_16x16x32_bf16(Bt[n][k], At[m][k], acc[ai][bj][m][n], 0, 0, 0); __builtin_amdgcn_s_setprio(0); } while (0)
#define PG8_WAIT_V(n) asm volatile("s_waitcnt vmcnt(" #n ")" ::: "memory")
#define PG8_WAIT_L(n) asm volatile("s_waitcnt lgkmcnt(" #n ")" ::: "memory")
#define PG8_BAR __builtin_amdgcn_s_barrier()
#define PG8_SCHED __builtin_amdgcn_sched_barrier(0)
    Unit cur, nxt; int ui = 0;
    if (!S.next(0, cur)) return;
    f32x4 acc[2][2][4][2];
#pragma unroll
    for (int a = 0; a < 2; ++a)
#pragma unroll
        for (int b = 0; b < 2; ++b)
#pragma unroll
            for (int m = 0; m < 4; ++m)
#pragma unroll
                for (int n = 0; n < 2; ++n) acc[a][b][m][n] = (f32x4){0.f, 0.f, 0.f, 0.f};
    bf16x8 At[4][2], B0[2][2], B1[2][2];
    const char* cA = (const char*)g.A + (size_t)cur.pm * tstep; const char* cB = (const char*)g.Bt + (size_t)cur.pn * tstep;
    S.a_ready(cur);
    PG8_STAGE(PG8_SB(0, 0), cB, voffB); PG8_STAGE(PG8_SA(0, 0), cA, voffA); PG8_STAGE(PG8_SB(0, 1), cB + hstep, voffB); PG8_STAGE(PG8_SA(0, 1), cA + hstep, voffA);
    if (wr == 1) PG8_BAR;
    PG8_WAIT_V(4); PG8_BAR;
    PG8_STAGE(PG8_SB(1, 0), cB + kstep, voffB); PG8_STAGE(PG8_SA(1, 0), cA + kstep, voffA); PG8_STAGE(PG8_SB(1, 1), cB + hstep + kstep, voffB);
    PG8_WAIT_V(6); PG8_BAR;
    for (;;) {
        const bool has_next = S.next(ui + 1, nxt);
        const char* nA = has_next ? (const char*)g.A + (size_t)nxt.pm * tstep : cA; const char* nB = has_next ? (const char*)g.Bt + (size_t)nxt.pn * tstep : cB;
        for (int t = 0; t < nt; t += 2) {
            const bool last = (t == nt - 2);
            const char* a1 = cA + (size_t)(t + 1) * kstep;
            const char* a2 = last ? nA : cA + (size_t)(t + 2) * kstep; const char* b2 = last ? nB : cB + (size_t)(t + 2) * kstep;
            const char* a3 = a2 + kstep; const char* b3 = b2 + kstep;
            if (last && has_next) S.a_ready(nxt);
            PG8_LDB(B0, 0, 0); PG8_SCHED; PG8_LDA(At, 0, 0); PG8_STAGE(PG8_SA(1, 1), a1 + hstep, voffA);
            PG8_WAIT_L(8); PG8_BAR; PG8_WAIT_L(0); PG8_MMA(0, 0, At, B0); PG8_BAR; PG8_SCHED;
            PG8_LDB(B1, 0, 1); PG8_STAGE(PG8_SB(0, 0), b2, voffB);
            PG8_BAR; PG8_WAIT_L(0); PG8_MMA(0, 1, At, B1); PG8_BAR;
            PG8_LDA(At, 0, 1); PG8_STAGE(PG8_SA(0, 0), a2, voffA);
            PG8_BAR; PG8_WAIT_L(0); PG8_MMA(1, 0, At, B0); PG8_BAR; PG8_SCHED;
            PG8_STAGE(PG8_SB(0, 1), b2 + hstep, voffB);
            PG8_WAIT_V(6); PG8_BAR; PG8_MMA(1, 1, At, B1); PG8_BAR;
            PG8_LDB(B0, 1, 0); PG8_SCHED; PG8_LDA(At, 1, 0); PG8_STAGE(PG8_SA(0, 1), a2 + hstep, voffA);
            PG8_WAIT_L(8); PG8_BAR; PG8_WAIT_L(0); PG8_MMA(0, 0, At, B0); PG8_BAR; PG8_SCHED;
            PG8_LDB(B1, 1, 1); PG8_STAGE(PG8_SB(1, 0), b3, voffB);
            PG8_BAR; PG8_WAIT_L(0); PG8_MMA(0, 1, At, B1); PG8_BAR;
            PG8_LDA(At, 1, 1); PG8_STAGE(PG8_SA(1, 0), a3, voffA);
            PG8_BAR; PG8_WAIT_L(0); PG8_MMA(1, 0, At, B0); PG8_BAR; PG8_SCHED;
            PG8_STAGE(PG8_SB(1, 1), b3 + hstep, voffB);
            PG8_WAIT_V(6); PG8_BAR; PG8_MMA(1, 1, At, B1); PG8_BAR;
        }
        if constexpr (!Epi::AFTER_DRAIN) { for (int re_ = 0; re_ < Epi::REPS; ++re_) E(acc, cur, wr, wc, fr, fq); S.done(cur); }
        if (!has_next) break;
#pragma unroll
        for (int a = 0; a < 2; ++a)
#pragma unroll
            for (int b = 0; b < 2; ++b)
#pragma unroll
                for (int m = 0; m < 4; ++m)
#pragma unroll
                    for (int n = 0; n < 2; ++n) acc[a][b][m][n] = (f32x4){0.f, 0.f, 0.f, 0.f};
        cur = nxt; cA = nA; cB = nB; ++ui;
    }
    PG8_WAIT_V(0);
    if (wr == 0) PG8_BAR;
    PG8_BAR;
    if constexpr (Epi::AFTER_DRAIN) { E.fused(acc, cur, wr, wc, fr, fq, lds, wid, lane); S.done(cur); }
#undef PG8_SA
#undef PG8_SB
#undef PG8_STAGE
#undef PG8_LDA
#undef PG8_LDB
#undef PG8_MMA
#undef PG8_WAIT_V
#undef PG8_WAIT_L
#undef PG8_BAR
#undef PG8_SCHED
}
}


typedef unsigned short bf16_t;
constexpr int D = 1024, SEQ = 8192, CTX = 256, NLAT = 16384, NCTX = 512, NTOK = 16896, INC = 2304;
constexpr int C_WAQ = 768, C_WAK = 1280, C_WAV = 1408, C_DAQ = 1536, C_DAK = 1792, C_DAV = 2048;
constexpr int NEXP = 16384;
constexpr int HFP = SEQ + 288;
constexpr int HTP = NLAT;

constexpr size_t OFF_BAR  = 0;
constexpr size_t OFF_X    = 65536;
constexpr size_t OFF_HB   = OFF_X    + (size_t)NTOK * D * 4;
constexpr size_t OFF_P    = OFF_HB   + (size_t)NTOK * D * 2;
constexpr size_t OFF_U    = OFF_P    + (size_t)NTOK * INC * 4;
constexpr size_t OFF_Z1   = OFF_U    + (size_t)NCTX * 768 * 4;
constexpr size_t OFF_Y    = OFF_Z1   + (size_t)NCTX * 256 * 4;
constexpr size_t OFF_HF   = OFF_Y    + (size_t)NTOK * D * 2;
constexpr size_t OFF_HFC  = OFF_HF   + (size_t)2 * HFP * 1024 * 4;
constexpr size_t OFF_WIN  = OFF_HFC  + (size_t)CTX * 1024 * 4;
constexpr size_t OFF_WOUT = OFF_WIN  + (size_t)2 * INC * D * 2;
constexpr size_t OFF_WQ   = OFF_WOUT + (size_t)2 * D * D * 2;
constexpr size_t OFF_MODP = OFF_WQ   + (size_t)2 * 2048 * D * 2;
constexpr size_t OFF_MOD  = OFF_MODP + (size_t)16 * 2 * 3 * 6144 * 4;
constexpr size_t OFF_TAB  = OFF_MOD  + (size_t)2 * 3 * 6144 * 4;
constexpr size_t OFF_QD   = OFF_TAB  + (size_t)128 * 24 * 2 * 4;
constexpr size_t OFF_KD   = OFF_QD   + (size_t)NTOK * 256 * 2;
constexpr size_t OFF_VDT  = OFF_KD   + (size_t)NTOK * 256 * 2;
constexpr size_t OFF_KMAX = OFF_VDT  + (size_t)2 * 4 * 64 * (SEQ + CTX) * 2;
constexpr size_t OFF_HT   = OFF_KMAX + 256;
constexpr size_t OFF_YHT  = OFF_HT   + (size_t)768 * HTP * 4;
constexpr size_t OFF_TW   = OFF_YHT  + (size_t)256 * NLAT * 2;
constexpr size_t OFF_ZT   = OFF_HT   + (size_t)512 * HTP * 4;
constexpr size_t OFF_QW   = OFF_TW   + (size_t)16384 * 8;
constexpr size_t OFF_KW   = OFF_QW   + (size_t)NTOK * 512 * 2;
constexpr size_t OFF_VWT  = OFF_KW   + (size_t)NTOK * 128 * 2;
constexpr size_t OFF_K16  = OFF_VWT  + (size_t)2 * 2 * 64 * (SEQ + CTX) * 2;
constexpr size_t OFF_RIDX = OFF_K16  + (size_t)2 * 16 * 128 * 128 * 2;
constexpr size_t OFF_RGATE= OFF_RIDX + (size_t)NTOK * 128 * 4;
constexpr size_t OFF_RSU  = OFF_RGATE + (size_t)NTOK * 128 * 4;
constexpr size_t OFF_END  = OFF_RSU + (size_t)NTOK * 128 * 4;

constexpr int LDS_BAR_OFF = 139264;
constexpr int LDS_BYTES = 139264 + 256;

struct Params { const float* in[31]; float* out; unsigned char* ws; };

__device__ __forceinline__ bf16_t f2bf(float f) { unsigned u = __float_as_uint(f); u += 0x7FFFu + ((u >> 16) & 1u); return (bf16_t)(u >> 16); }
template <int M> __device__ __forceinline__ float swzx(float v) { return __int_as_float(__builtin_amdgcn_ds_swizzle(__float_as_int(v), (M << 10) | 0x1F)); }
template <int M> __device__ __forceinline__ int swzxi(int v) { return __builtin_amdgcn_ds_swizzle(v, (M << 10) | 0x1F); }
__device__ __forceinline__ float wave_sum(float v) {
    v += swzx<1>(v); v += swzx<2>(v); v += swzx<4>(v); v += swzx<8>(v); v += swzx<16>(v);
    return __int_as_float(__builtin_amdgcn_readlane(__float_as_int(v), 0)) + __int_as_float(__builtin_amdgcn_readlane(__float_as_int(v), 32));
}
__device__ __forceinline__ float wave_max(float v) {
    v = fmaxf(v, swzx<1>(v)); v = fmaxf(v, swzx<2>(v)); v = fmaxf(v, swzx<4>(v)); v = fmaxf(v, swzx<8>(v)); v = fmaxf(v, swzx<16>(v));
    return fmaxf(__int_as_float(__builtin_amdgcn_readlane(__float_as_int(v), 0)), __int_as_float(__builtin_amdgcn_readlane(__float_as_int(v), 32)));
}
typedef _Float16 h2v __attribute__((ext_vector_type(2)));
__device__ __forceinline__ float h2lo(unsigned w) { return (float)__builtin_bit_cast(h2v, w).x; }
__device__ __forceinline__ float h2hi(unsigned w) { return (float)__builtin_bit_cast(h2v, w).y; }
__device__ __forceinline__ float xor32(float v, int lane) { return __int_as_float(__builtin_amdgcn_ds_bpermute((lane ^ 32) << 2, __float_as_int(v))); }
__device__ __forceinline__ void wave_argmax(float& bv, int& bi) {
#define AM_STEP(M) { const float ov = swzx<M>(bv); const int oi = swzxi<M>(bi); if (ov > bv || (ov == bv && oi < bi)) { bv = ov; bi = oi; } }
    AM_STEP(1) AM_STEP(2) AM_STEP(4) AM_STEP(8) AM_STEP(16)
#undef AM_STEP
    const float v0 = __int_as_float(__builtin_amdgcn_readlane(__float_as_int(bv), 0)), v1 = __int_as_float(__builtin_amdgcn_readlane(__float_as_int(bv), 32));
    const int i0 = __builtin_amdgcn_readlane(bi, 0), i1 = __builtin_amdgcn_readlane(bi, 32);
    if (v1 > v0 || (v1 == v0 && i1 < i0)) { bv = v1; bi = i1; } else { bv = v0; bi = i0; }
}
__device__ __forceinline__ float rdlane(float v, int l) { return __int_as_float(__builtin_amdgcn_readlane(__float_as_int(v), l)); }
#define WAVE_SYNC() do { __builtin_amdgcn_fence(__ATOMIC_RELEASE, "wavefront"); __builtin_amdgcn_wave_barrier(); __builtin_amdgcn_fence(__ATOMIC_ACQUIRE, "wavefront"); } while (0)

struct EpiResid {
    static constexpr bool PERM = true, AFTER_DRAIN = false; static constexpr int REPS = 1;
    bf16_t* X; const float* mod; const float* srcL; const float* srcC; bool srcb;
    __device__ __forceinline__ void operator()(const pg8::f32x4 (&acc)[2][2][4][2], const pg8::Unit& u, int wr, int wc, int fr, int fq) const {
        using namespace pg8;
        const unsigned voff = (unsigned)((wr * 64 + fr) * D + wc * 32 + 8 * fq);
        const int col0 = u.pn * BM;
        const int rb = u.pm < 32 ? 0 : (u.pm < 64 ? 1 : 2);
        const float* gate = mod + rb * 6144 + 2048 + col0 + wc * 32 + 8 * fq;
        bf16_t* const xt = X + (size_t)u.pm * BM * D + col0;
        const float* const st = (u.pm < 64 ? srcL + (size_t)u.pm * BM * D : srcC + (size_t)(u.pm - 64) * BM * D) + col0;
        f32x4 gv[2][2];
#pragma unroll
        for (int bj = 0; bj < 2; ++bj)
#pragma unroll
            for (int n = 0; n < 2; ++n) gv[bj][n] = *(const f32x4*)(gate + bj * HALF + n * 4);
#pragma unroll
        for (int ai = 0; ai < 2; ++ai) {
            if (srcb) {
                u32x4 sb[4][2];
#pragma unroll
                for (int m = 0; m < 4; ++m) { const bf16_t* srcp = xt + (size_t)(ai * HALF + m * 16) * D;
#pragma unroll
                    for (int bj = 0; bj < 2; ++bj) sb[m][bj] = *(const u32x4*)(srcp + voff + bj * HALF); }
#pragma unroll
                for (int m = 0; m < 4; ++m) { bf16_t* rowp = xt + (size_t)(ai * HALF + m * 16) * D;
#pragma unroll
                    for (int bj = 0; bj < 2; ++bj) {
                        const f32x4 r0 = (f32x4){__uint_as_float(sb[m][bj].x << 16), __uint_as_float(sb[m][bj].x & 0xffff0000u), __uint_as_float(sb[m][bj].y << 16), __uint_as_float(sb[m][bj].y & 0xffff0000u)};
                        const f32x4 r1 = (f32x4){__uint_as_float(sb[m][bj].z << 16), __uint_as_float(sb[m][bj].z & 0xffff0000u), __uint_as_float(sb[m][bj].w << 16), __uint_as_float(sb[m][bj].w & 0xffff0000u)};
                        const f32x4 v0 = r0 + gv[bj][0] * acc[ai][bj][m][0], v1 = r1 + gv[bj][1] * acc[ai][bj][m][1];
                        u32x4 w; w.x = cvt_pk_bf16(v0[0], v0[1]); w.y = cvt_pk_bf16(v0[2], v0[3]); w.z = cvt_pk_bf16(v1[0], v1[1]); w.w = cvt_pk_bf16(v1[2], v1[3]);
                        *(u32x4*)(rowp + voff + bj * HALF) = w; } }
            } else {
                f32x4 sv[4][2][2];
#pragma unroll
                for (int m = 0; m < 4; ++m) { const float* srcp = st + (size_t)(ai * HALF + m * 16) * D;
#pragma unroll
                    for (int bj = 0; bj < 2; ++bj)
#pragma unroll
                        for (int n = 0; n < 2; ++n) sv[m][bj][n] = *(const f32x4*)(srcp + voff + bj * HALF + n * 4); }
#pragma unroll
                for (int m = 0; m < 4; ++m) { bf16_t* rowp = xt + (size_t)(ai * HALF + m * 16) * D;
#pragma unroll
                    for (int bj = 0; bj < 2; ++bj) { const f32x4 v0 = sv[m][bj][0] + gv[bj][0] * acc[ai][bj][m][0], v1 = sv[m][bj][1] + gv[bj][1] * acc[ai][bj][m][1];
                        u32x4 w; w.x = cvt_pk_bf16(v0[0], v0[1]); w.y = cvt_pk_bf16(v0[2], v0[3]); w.z = cvt_pk_bf16(v1[0], v1[1]); w.w = cvt_pk_bf16(v1[2], v1[3]);
                        *(u32x4*)(rowp + voff + bj * HALF) = w; } }
            } }
    }
};

template <bool DAPERM>
__device__ __forceinline__ void transpose_convert(const float* __restrict__ src, bf16_t* __restrict__ dst, int K, int N, size_t gtid, size_t gsz) {
    const size_t items = (size_t)N * (K / 8);
    for (size_t idx = gtid; idx < items; idx += gsz) {
        const int nd = (int)(idx % N), k8 = (int)(idx / N);
        int n = nd;
        if (DAPERM && nd >= C_DAQ && nd < C_DAV) { const int r = nd & 15, fq = r >> 2, j = r & 3; n = (nd & ~15) + 2 * fq + (j >> 1) + 8 * (j & 1); }
        unsigned w[4];
#pragma unroll
        for (int j = 0; j < 4; ++j) {
            const float a = src[(size_t)(k8 * 8 + 2 * j) * N + n], b = src[(size_t)(k8 * 8 + 2 * j + 1) * N + n];
            w[j] = (unsigned)f2bf(a) | ((unsigned)f2bf(b) << 16);
        }
        *(uint4*)(dst + (size_t)nd * K + k8 * 8) = make_uint4(w[0], w[1], w[2], w[3]);
    }
}

__device__ __forceinline__ void norm_phase(const float* __restrict__ X, const float* __restrict__ XC, const float* __restrict__ g, const float* __restrict__ modl, int shift_off, int scale_off, int nrows,
                                           bf16_t* __restrict__ Hb, int gwave, int nwaves, int lane) {
    for (int row = gwave; row < nrows; row += nwaves) {
        const int r = row < NLAT ? (row >> 13) : 2;
        const float4* xr = (const float4*)(row < NLAT ? X + (size_t)row * D : XC + (size_t)(row - NLAT) * D);
        float4 v[4]; float ss = 0.f;
#pragma unroll
        for (int j = 0; j < 4; ++j) { v[j] = xr[lane + 64 * j]; ss += v[j].x * v[j].x + v[j].y * v[j].y + v[j].z * v[j].z + v[j].w * v[j].w; }
        ss = wave_sum(ss);
        const float rs = rsqrtf(ss * (1.f / D) + 1e-6f);
        const float4* g4 = (const float4*)g;
        const float4* sh4 = (const float4*)(modl + r * 6144 + shift_off);
        const float4* sc4 = (const float4*)(modl + r * 6144 + scale_off);
#pragma unroll
        for (int j = 0; j < 4; ++j) {
            const float4 gg = g4[lane + 64 * j], sh = sh4[lane + 64 * j], sc = sc4[lane + 64 * j];
            const float a = v[j].x * rs * gg.x * (1.f + sc.x) + sh.x, b = v[j].y * rs * gg.y * (1.f + sc.y) + sh.y;
            const float c = v[j].z * rs * gg.z * (1.f + sc.z) + sh.z, d = v[j].w * rs * gg.w * (1.f + sc.w) + sh.w;
            uint2 w; w.x = (unsigned)f2bf(a) | ((unsigned)f2bf(b) << 16); w.y = (unsigned)f2bf(c) | ((unsigned)f2bf(d) << 16);
            *(uint2*)(Hb + (size_t)row * D + 4 * (lane + 64 * j)) = w;
        }
    }
}
__device__ __forceinline__ void norm_phase_b(const bf16_t* __restrict__ XB, const float* __restrict__ g, const float* __restrict__ modl, int shift_off, int scale_off, int nrows,
                                             bf16_t* __restrict__ Hb, int gwave, int nwaves, int lane) {
    for (int row = gwave; row < nrows; row += nwaves) {
        const int r = row < NLAT ? (row >> 13) : 2;
        const uint4* xr = (const uint4*)(XB + (size_t)row * D);
        float v[2][8]; float ss = 0.f;
#pragma unroll
        for (int j = 0; j < 2; ++j) { const uint4 w = xr[lane + 64 * j]; const unsigned ww[4] = {w.x, w.y, w.z, w.w};
#pragma unroll
            for (int i = 0; i < 4; ++i) { v[j][2 * i] = __uint_as_float(ww[i] << 16); v[j][2 * i + 1] = __uint_as_float(ww[i] & 0xffff0000u); ss += v[j][2 * i] * v[j][2 * i] + v[j][2 * i + 1] * v[j][2 * i + 1]; } }
        ss = wave_sum(ss);
        const float rs = rsqrtf(ss * (1.f / D) + 1e-6f);
        const float4* g4 = (const float4*)g;
        const float4* sh4 = (const float4*)(modl + r * 6144 + shift_off);
        const float4* sc4 = (const float4*)(modl + r * 6144 + scale_off);
#pragma unroll
        for (int j = 0; j < 2; ++j) {
            unsigned o[4];
#pragma unroll
            for (int hf = 0; hf < 2; ++hf) { const int q = 2 * (lane + 64 * j) + hf; const float4 gg = g4[q], sh = sh4[q], sc = sc4[q];
                const float a = v[j][4 * hf] * rs * gg.x * (1.f + sc.x) + sh.x, b = v[j][4 * hf + 1] * rs * gg.y * (1.f + sc.y) + sh.y;
                const float c = v[j][4 * hf + 2] * rs * gg.z * (1.f + sc.z) + sh.z, d = v[j][4 * hf + 3] * rs * gg.w * (1.f + sc.w) + sh.w;
                o[2 * hf] = (unsigned)f2bf(a) | ((unsigned)f2bf(b) << 16); o[2 * hf + 1] = (unsigned)f2bf(c) | ((unsigned)f2bf(d) << 16); }
            *(uint4*)(Hb + (size_t)row * D + 8 * (lane + 64 * j)) = make_uint4(o[0], o[1], o[2], o[3]);
        }
    }
}

typedef short bf16x8 __attribute__((ext_vector_type(8)));
typedef float f32x16 __attribute__((ext_vector_type(16)));
typedef float f32x2v __attribute__((ext_vector_type(2)));
typedef __bf16 bf16x2v __attribute__((ext_vector_type(2)));
typedef unsigned u32x4v __attribute__((ext_vector_type(4)));
__device__ __forceinline__ unsigned pk_bf16(float a, float b) { f32x2v v = {a, b}; return __builtin_bit_cast(unsigned, __builtin_convertvector(v, bf16x2v)); }
constexpr int NKEY = SEQ + CTX;
constexpr int DA_ROWB = 144;
constexpr int DA_TILEB = 64 * DA_ROWB;

__device__ __forceinline__ void da_phase(int l, bool with_ctx, const bf16_t* __restrict__ Qd, const bf16_t* __restrict__ Kd, const bf16_t* __restrict__ VdT,
                                         const float* __restrict__ KMAXl, float lam, float lam_init, const float* __restrict__ gnorm, bf16_t* __restrict__ Y,
                                         LAS unsigned char* lds, int bid, int G, int tid) {
    const int lane = tid & 63, wave = __builtin_amdgcn_readfirstlane(tid >> 6);
    const int ql = lane & 31, hh = lane >> 5;
    const int nitems = 256 + (with_ctx ? 8 : 0);
    for (int it = bid; it < nitems; it += G) {
        int b, h, qrow0, kt0, kt1;
        if (it < 256) { b = it >> 7; h = (it >> 5) & 3; qrow0 = b * SEQ + (it & 31) * 256; kt0 = 0; kt1 = NKEY / 64; }
        else { const int j = it - 256; b = j >> 2; h = j & 3; qrow0 = NLAT + b * CTX; kt0 = SEQ / 64; kt1 = NKEY / 64; }
        const int qrow = qrow0 + wave * 32 + ql;
        bf16x8 qf[2][2];
        float cinit[2];
#pragma unroll
        for (int m = 0; m < 2; ++m) {
            float q2 = 0.f;
#pragma unroll
            for (int s = 0; s < 2; ++s) {
                const uint4 raw = *(const uint4*)(Qd + (size_t)qrow * 256 + h * 64 + m * 32 + s * 16 + hh * 8);
                qf[m][s] = __builtin_bit_cast(bf16x8, raw);
                const unsigned w[4] = {raw.x, raw.y, raw.z, raw.w};
#pragma unroll
                for (int e = 0; e < 4; ++e) { const float lo = __uint_as_float(w[e] << 16), hi = __uint_as_float(w[e] & 0xffff0000u); q2 += lo * lo + hi * hi; }
            }
            q2 += xor32(q2, lane);
            const float k2 = KMAXl[b * 8 + h * 2 + m];
            cinit[m] = -(sqrtf(q2) * sqrtf(k2) * 1.01f + 1e-3f);
        }
        f32x16 O[2][2];
#pragma unroll
        for (int m = 0; m < 2; ++m)
#pragma unroll
            for (int dt = 0; dt < 2; ++dt)
#pragma unroll
                for (int r = 0; r < 16; ++r) O[m][dt][r] = 0.f;
        float lsum[2] = {0.f, 0.f};
        const int srow = tid >> 3, sch = tid & 7;
        const bf16_t* vsrc = VdT + ((size_t)(b * 4 + h) * 64 + srow) * NKEY + sch * 8;
        const int soff = srow * DA_ROWB + sch * 16;
#define KROW_OF(kt) ((kt) < SEQ / 64 ? b * SEQ + (kt) * 64 : NLAT + b * CTX + ((kt) - SEQ / 64) * 64)
        {
            const uint4 kv = *(const uint4*)(Kd + (size_t)(KROW_OF(kt0) + srow) * 256 + h * 64 + sch * 8);
            const uint4 vv = *(const uint4*)(vsrc + (size_t)kt0 * 64);
            *(LAS u32x4v*)(lds + soff) = (u32x4v){kv.x, kv.y, kv.z, kv.w}; *(LAS u32x4v*)(lds + DA_TILEB + soff) = (u32x4v){vv.x, vv.y, vv.z, vv.w};
        }
        __syncthreads();
        int cur = 0;
        for (int kt = kt0; kt < kt1; ++kt) {
            uint4 kv = make_uint4(0, 0, 0, 0), vv = make_uint4(0, 0, 0, 0);
            const bool more = kt + 1 < kt1;
            if (more) { kv = *(const uint4*)(Kd + (size_t)(KROW_OF(kt + 1) + srow) * 256 + h * 64 + sch * 8); vv = *(const uint4*)(vsrc + (size_t)(kt + 1) * 64); }
            const LAS unsigned char* kb = lds + cur * 2 * DA_TILEB;
            const LAS unsigned char* vb = kb + DA_TILEB;
#pragma unroll
            for (int sub = 0; sub < 2; ++sub) {
                bf16x8 vf[2][2];
#pragma unroll
                for (int dt = 0; dt < 2; ++dt)
#pragma unroll
                    for (int s = 0; s < 2; ++s) vf[dt][s] = *(const LAS bf16x8*)(vb + (dt * 32 + ql) * DA_ROWB + (sub * 32 + s * 16 + hh * 8) * 2);
#pragma unroll
                for (int m = 0; m < 2; ++m) {
                    f32x16 S;
#pragma unroll
                    for (int r = 0; r < 16; ++r) S[r] = cinit[m];
#pragma unroll
                    for (int s = 0; s < 2; ++s) {
                        const bf16x8 kf = *(const LAS bf16x8*)(kb + (sub * 32 + ql) * DA_ROWB + m * 64 + s * 32 + hh * 16);
                        S = __builtin_amdgcn_mfma_f32_32x32x16_bf16(kf, qf[m][s], S, 0, 0, 0);
                    }
                    float pe[16]; float ls = 0.f;
#pragma unroll
                    for (int r = 0; r < 16; ++r) { pe[r] = __builtin_amdgcn_exp2f(S[r]); ls += pe[r]; }
                    lsum[m] += ls;
                    bf16x8 pf[2];
#pragma unroll
                    for (int s = 0; s < 2; ++s) {
                        uint4 w; w.x = pk_bf16(pe[8 * s], pe[8 * s + 1]); w.y = pk_bf16(pe[8 * s + 2], pe[8 * s + 3]); w.z = pk_bf16(pe[8 * s + 4], pe[8 * s + 5]); w.w = pk_bf16(pe[8 * s + 6], pe[8 * s + 7]);
                        pf[s] = __builtin_bit_cast(bf16x8, w);
                    }
#pragma unroll
                    for (int dt = 0; dt < 2; ++dt)
#pragma unroll
                        for (int s = 0; s < 2; ++s) O[m][dt] = __builtin_amdgcn_mfma_f32_32x32x16_bf16(vf[dt][s], pf[s], O[m][dt], 0, 0, 0);
                }
            }
            if (more) { LAS unsigned char* nb = lds + (cur ^ 1) * 2 * DA_TILEB; *(LAS u32x4v*)(nb + soff) = (u32x4v){kv.x, kv.y, kv.z, kv.w}; *(LAS u32x4v*)(nb + DA_TILEB + soff) = (u32x4v){vv.x, vv.y, vv.z, vv.w}; }
            __syncthreads();
            cur ^= 1;
        }
#undef KROW_OF
        const float l0 = lsum[0] + xor32(lsum[0], lane), l1 = lsum[1] + xor32(lsum[1], lane);
        const float i0 = 1.f / l0, i1 = lam / l1;
        float ss = 0.f;
#pragma unroll
        for (int dt = 0; dt < 2; ++dt)
#pragma unroll
            for (int r = 0; r < 16; ++r) { const float o = O[0][dt][r] * i0 - O[1][dt][r] * i1; O[0][dt][r] = o; ss += o * o; }
        ss += xor32(ss, lane);
        const float rn = rsqrtf(ss * (1.f / 64.f) + 1e-6f) * (1.f - lam_init);
        bf16_t* yrow = Y + (size_t)qrow * D + 768 + h * 64;
        const float* gn = gnorm; asm volatile("" : "+s"(gn));
#pragma unroll
        for (int dt = 0; dt < 2; ++dt)
#pragma unroll
            for (int rg = 0; rg < 4; ++rg) {
                const int d0 = 32 * dt + 8 * rg + 4 * hh;
                const float4 g4 = *(const float4*)(gn + d0);
                uint2 w; w.x = pk_bf16(O[0][dt][4 * rg] * rn * g4.x, O[0][dt][4 * rg + 1] * rn * g4.y); w.y = pk_bf16(O[0][dt][4 * rg + 2] * rn * g4.z, O[0][dt][4 * rg + 3] * rn * g4.w);
                *(uint2*)(yrow + d0) = w;
            }
    }
}

__device__ __forceinline__ void wa_phase(bool with_ctx, const bf16_t* __restrict__ Qw, const bf16_t* __restrict__ Kw, const bf16_t* __restrict__ VwT,
                                         const float* __restrict__ KMAXWl, const float* __restrict__ sinkl, bf16_t* __restrict__ Y,
                                         LAS unsigned char* lds, int bid, int G, int tid) {
    const int lane = tid & 63, wave = __builtin_amdgcn_readfirstlane(tid >> 6);
    const int ql = lane & 31, hh = lane >> 5;
    const int nitems = 256 + (with_ctx ? 8 : 0);
    for (int it = bid; it < nitems; it += G) {
        int b, hkv, qrow0, pos0, tlo, nloc;
        if (it < 256) { b = it >> 7; hkv = (it >> 6) & 1; const int qb = it & 63; qrow0 = b * SEQ + qb * 128; pos0 = qb * 128;
            tlo = 2 * qb - 2 < 0 ? 0 : 2 * qb - 2; const int thi = 2 * qb + 3 > SEQ / 64 - 1 ? SEQ / 64 - 1 : 2 * qb + 3; nloc = thi - tlo + 1; }
        else { const int j = it - 256; b = j >> 2; hkv = (j >> 1) & 1; qrow0 = NLAT + b * CTX + (j & 1) * 128; pos0 = 0; tlo = 0; nloc = 0; }
        const int ntile = nloc + CTX / 64;
        const int hq = hkv * 4 + (wave & 3), rg0 = wave >> 2;
        const float sink2 = sinkl[hq] * 1.4426950408889634f;
        bf16x8 qf[2][4]; float cinit[2]; int qrow[2], qpos[2];
#pragma unroll
        for (int tk = 0; tk < 2; ++tk) {
            qrow[tk] = qrow0 + (rg0 + 2 * tk) * 32 + ql; qpos[tk] = pos0 + (rg0 + 2 * tk) * 32 + ql;
            float q2 = 0.f;
#pragma unroll
            for (int s = 0; s < 4; ++s) {
                const uint4 raw = *(const uint4*)(Qw + (size_t)qrow[tk] * 512 + hq * 64 + s * 16 + hh * 8);
                qf[tk][s] = __builtin_bit_cast(bf16x8, raw);
                const unsigned w[4] = {raw.x, raw.y, raw.z, raw.w};
#pragma unroll
                for (int e = 0; e < 4; ++e) { const float lo = __uint_as_float(w[e] << 16), hi = __uint_as_float(w[e] & 0xffff0000u); q2 += lo * lo + hi * hi; }
            }
            q2 += xor32(q2, lane);
            cinit[tk] = -fmaxf(sqrtf(q2) * sqrtf(KMAXWl[b * 4 + hkv * 2] + KMAXWl[b * 4 + hkv * 2 + 1]) * 1.01f + 1e-3f, sink2);
        }
        f32x16 O[2][2];
#pragma unroll
        for (int tk = 0; tk < 2; ++tk)
#pragma unroll
            for (int dt = 0; dt < 2; ++dt)
#pragma unroll
                for (int r = 0; r < 16; ++r) O[tk][dt][r] = 0.f;
        float lsum[2] = {0.f, 0.f};
        const int srow = tid >> 3, sch = tid & 7;
        const bf16_t* vsrc = VwT + ((size_t)(b * 2 + hkv) * 64 + srow) * NKEY + sch * 8;
        const int soff = srow * DA_ROWB + sch * 16;
#define WKT(i) ((i) < nloc ? tlo + (i) : SEQ / 64 + ((i) - nloc))
#define WKROW(kt) ((kt) < SEQ / 64 ? b * SEQ + (kt) * 64 : NLAT + b * CTX + ((kt) - SEQ / 64) * 64)
        {
            const int kt = WKT(0);
            const uint4 kv = *(const uint4*)(Kw + (size_t)(WKROW(kt) + srow) * 128 + hkv * 64 + sch * 8);
            const uint4 vv = *(const uint4*)(vsrc + (size_t)kt * 64);
            *(LAS u32x4v*)(lds + soff) = (u32x4v){kv.x, kv.y, kv.z, kv.w}; *(LAS u32x4v*)(lds + DA_TILEB + soff) = (u32x4v){vv.x, vv.y, vv.z, vv.w};
        }
        __syncthreads();
        int cur = 0;
        for (int ti = 0; ti < ntile; ++ti) {
            const int kt = WKT(ti);
            uint4 kv = make_uint4(0, 0, 0, 0), vv = make_uint4(0, 0, 0, 0);
            const bool more = ti + 1 < ntile;
            if (more) { const int kn = WKT(ti + 1); kv = *(const uint4*)(Kw + (size_t)(WKROW(kn) + srow) * 128 + hkv * 64 + sch * 8); vv = *(const uint4*)(vsrc + (size_t)kn * 64); }
            const LAS unsigned char* kb = lds + cur * 2 * DA_TILEB;
            const LAS unsigned char* vb = kb + DA_TILEB;
            const bool local = kt < SEQ / 64;
#pragma unroll
            for (int sub = 0; sub < 2; ++sub) {
                const int k0 = kt * 64 + sub * 32;
                bf16x8 vf[2][2], kf[4];
#pragma unroll
                for (int dt = 0; dt < 2; ++dt)
#pragma unroll
                    for (int s = 0; s < 2; ++s) vf[dt][s] = *(const LAS bf16x8*)(vb + (dt * 32 + ql) * DA_ROWB + (sub * 32 + s * 16 + hh * 8) * 2);
#pragma unroll
                for (int s = 0; s < 4; ++s) kf[s] = *(const LAS bf16x8*)(kb + (sub * 32 + ql) * DA_ROWB + s * 32 + hh * 16);
#pragma unroll
                for (int tk = 0; tk < 2; ++tk) {
                    bool needmask = false;
                    if (local) { const int r0 = pos0 + (rg0 + 2 * tk) * 32;
                        if (k0 + 31 < r0 - 128 || k0 > r0 + 31 + 128) continue;
                        needmask = !(k0 >= r0 + 31 - 128 && k0 + 31 <= r0 + 128); }
                    f32x16 S;
#pragma unroll
                    for (int r = 0; r < 16; ++r) S[r] = cinit[tk];
#pragma unroll
                    for (int s = 0; s < 4; ++s) S = __builtin_amdgcn_mfma_f32_32x32x16_bf16(kf[s], qf[tk][s], S, 0, 0, 0);
                    float pe[16]; float ls = 0.f;
#pragma unroll
                    for (int r = 0; r < 16; ++r) pe[r] = __builtin_amdgcn_exp2f(S[r]);
                    if (needmask) {
                        int dbase = qpos[tk] - k0 - 4 * hh + 128; asm volatile("" : "+v"(dbase));
#pragma unroll
                        for (int r = 0; r < 16; ++r) { const unsigned dk = (unsigned)(dbase - ((r & 3) + 8 * (r >> 2))); pe[r] = dk <= 256u ? pe[r] : 0.f; } }
#pragma unroll
                    for (int r = 0; r < 16; ++r) ls += pe[r];
                    lsum[tk] += ls;
                    bf16x8 pf[2];
#pragma unroll
                    for (int s = 0; s < 2; ++s) {
                        uint4 w; w.x = pk_bf16(pe[8 * s], pe[8 * s + 1]); w.y = pk_bf16(pe[8 * s + 2], pe[8 * s + 3]); w.z = pk_bf16(pe[8 * s + 4], pe[8 * s + 5]); w.w = pk_bf16(pe[8 * s + 6], pe[8 * s + 7]);
                        pf[s] = __builtin_bit_cast(bf16x8, w);
                    }
#pragma unroll
                    for (int dt = 0; dt < 2; ++dt)
#pragma unroll
                        for (int s = 0; s < 2; ++s) O[tk][dt] = __builtin_amdgcn_mfma_f32_32x32x16_bf16(vf[dt][s], pf[s], O[tk][dt], 0, 0, 0);
                }
            }
            if (more) { LAS unsigned char* nb = lds + (cur ^ 1) * 2 * DA_TILEB; *(LAS u32x4v*)(nb + soff) = (u32x4v){kv.x, kv.y, kv.z, kv.w}; *(LAS u32x4v*)(nb + DA_TILEB + soff) = (u32x4v){vv.x, vv.y, vv.z, vv.w}; }
            __syncthreads();
            cur ^= 1;
        }
#undef WKT
#undef WKROW
#pragma unroll
        for (int tk = 0; tk < 2; ++tk) {
            const float lt = lsum[tk] + xor32(lsum[tk], lane) + __builtin_amdgcn_exp2f(sink2 + cinit[tk]);
            const float inv = 1.f / lt;
            bf16_t* yrow = Y + (size_t)qrow[tk] * D + 256 + hq * 64;
#pragma unroll
            for (int dt = 0; dt < 2; ++dt)
#pragma unroll
                for (int rg = 0; rg < 4; ++rg) {
                    const int d0 = 32 * dt + 8 * rg + 4 * hh;
                    uint2 w; w.x = pk_bf16(O[tk][dt][4 * rg] * inv, O[tk][dt][4 * rg + 1] * inv); w.y = pk_bf16(O[tk][dt][4 * rg + 2] * inv, O[tk][dt][4 * rg + 3] * inv);
                    *(uint2*)(yrow + d0) = w;
                }
        }
    }
}

#ifndef REP_EPI
#define REP_EPI 1
#endif
struct EpiInProj {
    static constexpr bool PERM = false, AFTER_DRAIN = false; static constexpr int REPS = REP_EPI;
    float* __restrict__ HT; float* __restrict__ PC; bf16_t* __restrict__ Qw; bf16_t* __restrict__ Kw; bf16_t* __restrict__ VwT; bf16_t* __restrict__ Qd; bf16_t* __restrict__ Kd; bf16_t* __restrict__ VdT; const unsigned* __restrict__ TABH; unsigned* __restrict__ KMX; int l;
    __device__ __forceinline__ void operator()(const pg8::f32x4 (&acc)[2][2][4][2], const pg8::Unit& u, int wr, int wc, int fr_in, int fq_in) const {
        using pg8::f32x4;
        (void)fr_in; (void)fq_in;
        int lid_; asm volatile("v_mbcnt_lo_u32_b32 %0, -1, 0\n\tv_mbcnt_hi_u32_b32 %0, -1, %0" : "=v"(lid_));
        const int fr = lid_ & 15, fq = lid_ >> 4;
        const int pn = u.pn, pm = u.pm;
        const bool lat = pm < 64;
        const int b = lat ? (pm >> 5) : (pm - 64);
        const int t0 = (lat ? (pm & 31) * 256 : 0) + wr * 64 + fr;
        const int grow0 = pm * 256 + wr * 64 + fr;
        const int lane = fq * 16 + fr;
        const float QSCW = 0.125f * 1.4426950408889634f, QSCD = 0.17677669529663687f * 1.4426950408889634f;
        if (pn < 3) {
            if (lat) {
#pragma unroll
                for (int bj = 0; bj < 2; ++bj)
#pragma unroll
                    for (int n = 0; n < 2; ++n) { float* hp = HT + (size_t)(pn * 256 + bj * 128 + wc * 32 + n * 16 + fq * 4) * HTP + grow0;
#pragma unroll
                        for (int ai = 0; ai < 2; ++ai)
#pragma unroll
                            for (int m = 0; m < 4; ++m) { const f32x4 v = acc[ai][bj][m][n]; float* q = hp + ai * 128 + m * 16;
                                q[0] = v[0]; q[HTP] = v[1]; q[2 * (size_t)HTP] = v[2]; q[3 * (size_t)HTP] = v[3]; } }
            } else {
#pragma unroll
                for (int ai = 0; ai < 2; ++ai)
#pragma unroll
                    for (int m = 0; m < 4; ++m) { float* rp = PC + (size_t)(grow0 - NLAT + ai * 128 + m * 16) * 768 + pn * 256 + wc * 32 + fq * 4;
#pragma unroll
                        for (int bj = 0; bj < 2; ++bj)
#pragma unroll
                            for (int n = 0; n < 2; ++n) *(f32x4*)(rp + bj * 128 + n * 16) = acc[ai][bj][m][n]; }
            }
        } else if (pn < 5 || (pn == 5)) {
            float kmx = 0.f;
            const int halfw = wc & 1;
            pg8::u32x4 cw[4];
#pragma unroll
            for (int i = 0; i < 4; ++i) { const int pos = lat ? (halfw ? ((t0 + 16 * i) & 63) : ((t0 + 128 * (i & 1)) >> 6)) : 0;
                cw[i] = *(const pg8::u32x4*)(TABH + pos * 24 + fq * 4); }
#pragma unroll
            for (int bj = 0; bj < 2; ++bj) {
                const int g32 = bj * 4 + wc;
                if (pn == 5 && bj == 1) {
                    const int pf = fr < 4 ? fr : (fr < 8 ? fr + 4 : (fr < 12 ? fr - 4 : fr));
                    const int kbase = (lat ? (pm & 31) * 256 : SEQ) + wr * 64 + pf;
#pragma unroll
                    for (int n = 0; n < 2; ++n)
#pragma unroll
                        for (int j = 0; j < 4; ++j) { bf16_t* vp = VwT + ((size_t)(b * 2 + (wc >> 1)) * 64 + (wc & 1) * 32 + n * 16 + fq * 4 + j) * NKEY + kbase;
#pragma unroll
                            for (int ai = 0; ai < 2; ++ai)
#pragma unroll
                                for (int m = 0; m < 4; ++m) vp[ai * 128 + m * 16] = f2bf(acc[ai][bj][m][n][j]); }
                } else {
                    const int half = g32 & 1;
#pragma unroll
                    for (int ai = 0; ai < 2; ++ai)
#pragma unroll
                        for (int m = 0; m < 4; ++m) {
                            const pg8::u32x4 ce = halfw ? cw[m] : cw[ai];
                            const f32x4 x1 = acc[ai][bj][m][0], x2 = acc[ai][bj][m][1];
                            const float cs[4] = {h2lo(ce.x), h2lo(ce.y), h2lo(ce.z), h2lo(ce.w)}, sn[4] = {h2hi(ce.x), h2hi(ce.y), h2hi(ce.z), h2hi(ce.w)};
                            float y1[4], y2[4];
#pragma unroll
                            for (int j = 0; j < 4; ++j) { y1[j] = x1[j] * cs[j] - x2[j] * sn[j]; y2[j] = x2[j] * cs[j] + x1[j] * sn[j]; }
                            const size_t grow = (size_t)(grow0 + ai * 128 + m * 16);
                            if (pn < 5) { bf16_t* qp = Qw + grow * 512 + ((pn - 3) * 4 + (g32 >> 1)) * 64 + half * 32 + fq * 4;
                                uint2 w1, w2; w1.x = pk_bf16(y1[0] * QSCW, y1[1] * QSCW); w1.y = pk_bf16(y1[2] * QSCW, y1[3] * QSCW); w2.x = pk_bf16(y2[0] * QSCW, y2[1] * QSCW); w2.y = pk_bf16(y2[2] * QSCW, y2[3] * QSCW);
                                *(uint2*)qp = w1; *(uint2*)(qp + 16) = w2; }
                            else { bf16_t* kp = Kw + grow * 128 + (wc >> 1) * 64 + half * 32 + fq * 4;
                                uint2 w1, w2; w1.x = pk_bf16(y1[0], y1[1]); w1.y = pk_bf16(y1[2], y1[3]); w2.x = pk_bf16(y2[0], y2[1]); w2.y = pk_bf16(y2[2], y2[3]);
                                *(uint2*)kp = w1; *(uint2*)(kp + 16) = w2;
                                float sq = 0.f;
#pragma unroll
                                for (int j = 0; j < 4; ++j) sq += y1[j] * y1[j] + y2[j] * y2[j];
                                sq += swzx<16>(sq); sq += xor32(sq, lane);
                                kmx = fmaxf(kmx, sq); }
                            __builtin_amdgcn_sched_barrier(0);
                        }
                }
            }
            if (pn == 5) {
                kmx = fmaxf(kmx, swzx<1>(kmx)); kmx = fmaxf(kmx, swzx<2>(kmx)); kmx = fmaxf(kmx, swzx<4>(kmx)); kmx = fmaxf(kmx, swzx<8>(kmx));
                if (lane == 0) atomicMax(KMX + 32 + l * 8 + b * 4 + wc, __float_as_uint(kmx));
            }
        } else if (pn < 8) {
            float kmx[2] = {0.f, 0.f};
            uint2 ca[2], cm[4];
#pragma unroll
            for (int ai = 0; ai < 2; ++ai) { const int pos = lat ? ((t0 + ai * 128) >> 6) : 0; ca[ai] = *(const uint2*)(TABH + pos * 24 + 16 + 2 * fq); }
#pragma unroll
            for (int m = 0; m < 4; ++m) { const int pos = lat ? ((t0 + m * 16) & 63) : 0; cm[m] = *(const uint2*)(TABH + pos * 24 + 16 + 2 * fq); }
#pragma unroll
            for (int bj = 0; bj < 2; ++bj) {
                const int g32 = bj * 4 + wc;
#pragma unroll
                for (int ai = 0; ai < 2; ++ai)
#pragma unroll
                    for (int m = 0; m < 4; ++m) {
                        const size_t grow = (size_t)(grow0 + ai * 128 + m * 16);
                        float sq = 0.f;
#pragma unroll
                        for (int n = 0; n < 2; ++n) {
                            const uint2 ce = n ? cm[m] : ca[ai];
                            const float c0 = h2lo(ce.x), s0 = h2hi(ce.x), c1 = h2lo(ce.y), s1 = h2hi(ce.y);
                            const f32x4 x = acc[ai][bj][m][n];
                            const float y0 = x[0] * c0 - x[1] * s0, y1 = x[1] * c0 + x[0] * s0, y2 = x[2] * c1 - x[3] * s1, y3 = x[3] * c1 + x[2] * s1;
                            sq += y0 * y0 + y1 * y1 + y2 * y2 + y3 * y3;
                            const float scl = pn == 6 ? QSCD : 1.f;
                            bf16_t* dp = (pn == 6 ? Qd : Kd) + grow * 256 + g32 * 32 + n * 16 + fq * 4;
                            uint2 w; w.x = pk_bf16(y0 * scl, y1 * scl); w.y = pk_bf16(y2 * scl, y3 * scl);
                            *(uint2*)dp = w;
                        }
                        if (pn == 7) { sq += swzx<16>(sq); sq += xor32(sq, lane); kmx[bj] = fmaxf(kmx[bj], sq); }
                    }
            }
            if (pn == 7) {
#pragma unroll
                for (int bj = 0; bj < 2; ++bj) { float k = kmx[bj];
                    k = fmaxf(k, swzx<1>(k)); k = fmaxf(k, swzx<2>(k)); k = fmaxf(k, swzx<4>(k)); k = fmaxf(k, swzx<8>(k));
                    if (lane == 0) atomicMax(KMX + l * 16 + b * 8 + bj * 4 + wc, __float_as_uint(k)); }
            }
        } else {
            const int pf = fr < 4 ? fr : (fr < 8 ? fr + 4 : (fr < 12 ? fr - 4 : fr));
            const int kbase = (lat ? (pm & 31) * 256 : SEQ) + wr * 64 + pf;
#pragma unroll
            for (int bj = 0; bj < 2; ++bj) { const int g32 = bj * 4 + wc;
#pragma unroll
                for (int n = 0; n < 2; ++n)
#pragma unroll
                    for (int j = 0; j < 4; ++j) { bf16_t* vp = VdT + ((size_t)(b * 4 + (g32 >> 1)) * 64 + (g32 & 1) * 32 + n * 16 + fq * 4 + j) * NKEY + kbase;
#pragma unroll
                        for (int ai = 0; ai < 2; ++ai)
#pragma unroll
                            for (int m = 0; m < 4; ++m) vp[ai * 128 + m * 16] = f2bf(acc[ai][bj][m][n][j]); } }
        }
    }
};

static constexpr float CT32[32] = {1.f, 0.98078528f, 0.923879533f, 0.831469612f, 0.707106781f, 0.555570233f, 0.382683432f, 0.195090322f, 0.f, -0.195090322f, -0.382683432f, -0.555570233f,
    -0.707106781f, -0.831469612f, -0.923879533f, -0.98078528f, -1.f, -0.98078528f, -0.923879533f, -0.831469612f, -0.707106781f, -0.555570233f, -0.382683432f, -0.195090322f, 0.f, 0.195090322f,
    0.382683432f, 0.555570233f, 0.707106781f, 0.831469612f, 0.923879533f, 0.98078528f};
__host__ __device__ constexpr int br5(int i) { return ((i & 1) << 4) | ((i & 2) << 2) | (i & 4) | ((i & 8) >> 2) | ((i & 16) >> 4); }
__host__ __device__ constexpr int br4(int i) { return ((i & 1) << 3) | ((i & 2) << 1) | ((i & 4) >> 1) | ((i & 8) >> 3); }
template <int R, bool INV, int OFF> __device__ __forceinline__ void fft_dif(float (&re)[32], float (&im)[32]) {
#pragma unroll
    for (int len = R; len >= 2; len >>= 1) {
        const int half = len >> 1, step = 32 / len;
#pragma unroll
        for (int base = 0; base < R; base += len) {
#pragma unroll
            for (int j = 0; j < half; ++j) {
                const int a = OFF + base + j, b = a + half;
                const float ar = re[a], ai = im[a], br = re[b], bi = im[b];
                re[a] = ar + br; im[a] = ai + bi;
                const float dr = ar - br, di = ai - bi;
                const float c = CT32[(j * step) & 31], s0 = CT32[(j * step + 24) & 31];
                const float s = INV ? s0 : -s0;
                re[b] = dr * c - di * s; im[b] = dr * s + di * c;
            }
        }
    }
}
template <int R, bool INV, int OFF> __device__ __forceinline__ void fft_dit(float (&re)[32], float (&im)[32]) {
#pragma unroll
    for (int len = 2; len <= R; len <<= 1) {
        const int half = len >> 1, step = 32 / len;
#pragma unroll
        for (int base = 0; base < R; base += len) {
#pragma unroll
            for (int j = 0; j < half; ++j) {
                const int a = OFF + base + j, b = a + half;
                const float c = CT32[(j * step) & 31], s0 = CT32[(j * step + 24) & 31];
                const float s = INV ? s0 : -s0;
                const float tr = re[b] * c - im[b] * s, ti = re[b] * s + im[b] * c;
                const float ar = re[a], ai = im[a];
                re[a] = ar + tr; im[a] = ai + ti; re[b] = ar - tr; im[b] = ai - ti;
            }
        }
    }
}
constexpr int FFT_L1P = 528;
constexpr int FFT_LDS_BYTES = 1024 * 17 * 8;
__device__ __forceinline__ void fft16k_fwd(float (&re)[32], float (&im)[32], LAS f32x2v* L, const float2* __restrict__ TW, int tid_in) {
    int tid = tid_in; asm volatile("" : "+v"(tid));
    fft_dif<32, false, 0>(re, im);
    { const float2 w = TW[16 * (tid >> 4)]; float pr = 1.f, pi = 0.f;
#pragma unroll
      for (int k = 0; k < 32; ++k) { const int idx = br5(k); const float xr = re[idx], xi = im[idx];
          re[idx] = xr * pr - xi * pi; im[idx] = xr * pi + xi * pr;
          const float npr = pr * w.x + pi * w.y, npi = pi * w.x - pr * w.y; pr = npr; pi = npi; } }
    __syncthreads();
#pragma unroll
    for (int i = 0; i < 32; ++i) L[br5(i) * FFT_L1P + tid] = (f32x2v){re[i], im[i]};
    __syncthreads();
    asm volatile("" : "+v"(tid));
    const int k1 = tid >> 4, n3 = tid & 15;
#pragma unroll
    for (int n2 = 0; n2 < 32; ++n2) { const f32x2v v = L[k1 * FFT_L1P + n2 * 16 + n3]; re[n2] = v.x; im[n2] = v.y; }
    __syncthreads();
    fft_dif<32, false, 0>(re, im);
    { const float2 b0 = TW[n3 * k1], st = TW[32 * n3]; float pr = b0.x, pi = -b0.y;
#pragma unroll
      for (int k = 0; k < 32; ++k) { const int idx = br5(k); const float xr = re[idx], xi = im[idx];
          re[idx] = xr * pr - xi * pi; im[idx] = xr * pi + xi * pr;
          const float npr = pr * st.x + pi * st.y, npi = pi * st.x - pr * st.y; pr = npr; pi = npi; } }
#pragma unroll
    for (int i = 0; i < 32; ++i) L[(k1 * 32 + br5(i)) * 17 + n3] = (f32x2v){re[i], im[i]};
    __syncthreads();
#pragma unroll
    for (int h = 0; h < 2; ++h)
#pragma unroll
        for (int j = 0; j < 16; ++j) { const f32x2v v = L[(tid + 512 * h) * 17 + j]; re[16 * h + j] = v.x; im[16 * h + j] = v.y; }
    fft_dif<16, false, 0>(re, im);
    fft_dif<16, false, 16>(re, im);
}
__device__ __forceinline__ void fft16k_inv(float (&re)[32], float (&im)[32], LAS f32x2v* L, const float2* __restrict__ TW, int tid_in) {
    int tid = tid_in; asm volatile("" : "+v"(tid));
    fft_dit<16, true, 0>(re, im);
    fft_dit<16, true, 16>(re, im);
#pragma unroll
    for (int h = 0; h < 2; ++h) { const int pr_ = tid + 512 * h; const float2 st = TW[(pr_ >> 5) + 32 * (pr_ & 31)]; float pr = 1.f, pi = 0.f;
#pragma unroll
        for (int j = 0; j < 16; ++j) { const float xr = re[16 * h + j], xi = im[16 * h + j];
            re[16 * h + j] = xr * pr - xi * pi; im[16 * h + j] = xr * pi + xi * pr;
            const float npr = pr * st.x - pi * st.y, npi = pi * st.x + pr * st.y; pr = npr; pi = npi; } }
    __syncthreads();
#pragma unroll
    for (int h = 0; h < 2; ++h)
#pragma unroll
        for (int j = 0; j < 16; ++j) L[(tid + 512 * h) * 17 + j] = (f32x2v){re[16 * h + j], im[16 * h + j]};
    __syncthreads();
    asm volatile("" : "+v"(tid));
    const int k1 = tid >> 4, n3 = tid & 15;
#pragma unroll
    for (int i = 0; i < 32; ++i) { const f32x2v v = L[(k1 * 32 + br5(i)) * 17 + n3]; re[i] = v.x; im[i] = v.y; }
    __syncthreads();
    fft_dit<32, true, 0>(re, im);
    { const float2 st = TW[16 * k1]; float pr = 1.f, pi = 0.f;
#pragma unroll
      for (int n2 = 0; n2 < 32; ++n2) { const float xr = re[n2], xi = im[n2];
          re[n2] = xr * pr - xi * pi; im[n2] = xr * pi + xi * pr;
          const float npr = pr * st.x - pi * st.y, npi = pi * st.x + pr * st.y; pr = npr; pi = npi; } }
#pragma unroll
    for (int n2 = 0; n2 < 32; ++n2) L[k1 * FFT_L1P + n2 * 16 + n3] = (f32x2v){re[n2], im[n2]};
    __syncthreads();
#pragma unroll
    for (int i = 0; i < 32; ++i) { const f32x2v v = L[br5(i) * FFT_L1P + tid]; re[i] = v.x; im[i] = v.y; }
    fft_dit<32, true, 0>(re, im);
}
template <bool COS> __device__ __forceinline__ float hy_sincos(float x) {
    const float k = rintf(x * 0.63661977236758134f);
    float r = fmaf(k, -1.5703125f, x); r = fmaf(k, -4.837512969970703125e-4f, r); r = fmaf(k, -7.54978995489188216e-8f, r);
    const int q = (int)k + (COS ? 1 : 0);
    const float z = r * r;
    const float sp = fmaf(fmaf(fmaf(-1.9515295891e-4f, z, 8.3321608736e-3f), z, -1.6666654611e-1f) * z, r, r);
    const float cp = fmaf(fmaf(fmaf(2.443315711809948e-5f, z, -1.388731625493765e-3f), z, 4.166664568298827e-2f) * z, z, fmaf(-0.5f, z, 1.f));
    const float v = (q & 1) ? cp : sp;
    return (q & 2) ? -v : v;
}
template <int NP>
__device__ __forceinline__ void hy_filter_z2(const float* __restrict__ w1, const float* __restrict__ b1, const float* __restrict__ fr, const float* __restrict__ w2,
                                             const float* __restrict__ b2, int n, int t0, int lane, float (&z2)[NP]) {
    const float fq = fr[lane];
    float fe[NP], a1[NP], a2[NP], z1[NP];
#pragma unroll
    for (int q = 0; q < NP; ++q) {
        const int t = t0 + q;
        const float tt = (float)t / (float)(n - 1);
        fe[q] = 0.f;
        if (lane == 0) fe[q] = tt;
        else if (lane <= 32) {
            const int j = (lane - 1) & 15;
            const float band = 1e-4f + (float)j * ((15.f - 1e-4f) / 15.f);
            const float ph = ((float)(6.283185307179586 / (double)n) * (float)t) * band;
            fe[q] = lane <= 16 ? hy_sincos<true>(ph) : -hy_sincos<false>(ph);
        }
        a1[q] = b1[lane]; a2[q] = b2[lane];
    }
#pragma unroll
    for (int e = 0; e < 33; ++e) { const float w = w1[e * 64 + lane];
#pragma unroll
        for (int q = 0; q < NP; ++q) a1[q] += rdlane(fe[q], e) * w; }
#pragma unroll
    for (int q = 0; q < NP; ++q) z1[q] = hy_sincos<false>(fq * a1[q]);
#pragma unroll 16
    for (int i = 0; i < 64; ++i) { const float w = w2[i * 64 + lane];
#pragma unroll
        for (int q = 0; q < NP; ++q) a2[q] += rdlane(z1[q], i) * w; }
#pragma unroll
    for (int q = 0; q < NP; ++q) z2[q] = hy_sincos<false>(fq * a2[q]);
}

__device__ __forceinline__ void hyena_fft_phase(int l, const float* __restrict__ HT, const float* __restrict__ HFTl, const float2* __restrict__ TW, const float* __restrict__ cw,
                                                const float* __restrict__ cb, const float* __restrict__ hy_bias_l, bf16_t* __restrict__ YhT, float* ZT, float2* HS, LAS f32x2v* L, int bid, int G, int tid) {
    for (int c = bid; c < 256; c += G) {
        float re[32], im[32];
        float2* hs = HS + (size_t)bid * 32 * 512;
        float* z0 = ZT + (size_t)c * HTP; float* z1 = z0 + SEQ;
#pragma unroll 1
        for (int o = 0; o < 2; ++o) {
            int tq = tid; asm volatile("" : "+v"(tq));
            { const float* hf = HFTl + (size_t)((o * 2 + 0) * 256 + c) * HFP; const float* hb = HFTl + (size_t)((o * 2 + 1) * 256 + c) * HFP;
#pragma unroll
              for (int n1 = 0; n1 < 16; ++n1) { re[n1] = hf[512 * n1 + tq]; im[n1] = 0.f; }
              if (tq == 0) re[0] += hy_bias_l[o * 256 + c];
#pragma unroll
              for (int n1 = 16; n1 < 32; ++n1) { const int m = 16384 - (512 * n1 + tq); re[n1] = (m == 8192) ? 0.f : hb[m & 8191]; im[n1] = 0.f; } }
            fft16k_fwd(re, im, L, TW, tid);
#pragma unroll
            for (int i = 0; i < 32; ++i) hs[i * 512 + tq] = make_float2(re[i] * (1.f / 16384.f), im[i] * (1.f / 16384.f));
            asm volatile("" : "+v"(tq));
            if (o == 0) {
                const int col = 512 + c; const float w0 = cw[col], w1 = cw[768 + col], w2 = cw[1536 + col], bb = cb[col];
                const float* h0 = HT + (size_t)col * HTP; const float* h1 = h0 + SEQ;
#pragma unroll
                for (int n1 = 0; n1 < 16; ++n1) { const int t = 512 * n1 + tq;
                    float a = bb + w1 * h0[t], b = bb + w1 * h1[t];
                    if (t > 0) { a += w0 * h0[t - 1]; b += w0 * h1[t - 1]; }
                    if (t < SEQ - 1) { a += w2 * h0[t + 1]; b += w2 * h1[t + 1]; }
                    re[n1] = a; im[n1] = b; }
            } else {
#pragma unroll
                for (int n1 = 0; n1 < 16; ++n1) { re[n1] = z0[512 * n1 + tq]; im[n1] = z1[512 * n1 + tq]; }
            }
#pragma unroll
            for (int n1 = 16; n1 < 32; ++n1) { re[n1] = 0.f; im[n1] = 0.f; }
            fft16k_fwd(re, im, L, TW, tid);
            asm volatile("" : "+v"(tq));
#pragma unroll
            for (int i = 0; i < 32; ++i) { const float2 hv = hs[i * 512 + tq]; const float a = re[i], b = im[i]; re[i] = a * hv.x - b * hv.y; im[i] = a * hv.y + b * hv.x; }
            fft16k_inv(re, im, L, TW, tid);
            asm volatile("" : "+v"(tq));
            { const int col = o * 256 + c; const float w0 = cw[col], w1 = cw[768 + col], w2 = cw[1536 + col], bb = cb[col];
              const float* h0 = HT + (size_t)col * HTP; const float* h1 = h0 + SEQ;
#pragma unroll
              for (int n1 = 0; n1 < 16; ++n1) { const int t = 512 * n1 + tq;
                  float a = bb + w1 * h0[t], b = bb + w1 * h1[t];
                  if (t > 0) { a += w0 * h0[t - 1]; b += w0 * h1[t - 1]; }
                  if (t < SEQ - 1) { a += w2 * h0[t + 1]; b += w2 * h1[t + 1]; }
                  const float ra = a * re[n1], rb = b * im[n1];
                  if (o == 0) { z0[t] = ra; z1[t] = rb; }
                  else { YhT[(size_t)c * NLAT + t] = f2bf(ra); YhT[(size_t)c * NLAT + SEQ + t] = f2bf(rb); } } }
        }
    }
}

__device__ __forceinline__ void hyena_ctx_fused(int l, const float* __restrict__ PC, const float* __restrict__ cw, const float* __restrict__ cb, bf16_t* __restrict__ Y,
                                                const float* __restrict__ Z2C, const float* __restrict__ w3, const float* __restrict__ dec, const float* __restrict__ hy_bias, float* ldsf, int bid, int G, int tid) {
    const int lane = tid & 63, c = __builtin_amdgcn_readfirstlane(tid >> 6);
    float* zb = ldsf;
    float* z1 = ldsf + 2048;
    float* comb = ldsf + 4096;
    for (int it = bid; it < 64; it += G) {
        const int s = it >> 5, c0 = (it & 31) * 8, rowbase = s * CTX;
        for (int idx = tid; idx < 2048; idx += NT) { const int t = idx >> 3, cc = idx & 7, col = 512 + c0 + cc;
            const float* pp = PC + (size_t)(rowbase + t) * 768 + col;
            float a = cb[col] + cw[768 + col] * pp[0];
            if (t > 0) a += cw[col] * pp[-768];
            if (t < CTX - 1) a += cw[1536 + col] * pp[768];
            zb[cc * 256 + t] = a; }
        float* w3s = ldsf + 4096 + 8192;
        float* z2s = w3s + 2048;
        for (int idx = tid; idx < 2048; idx += NT) { const int i = idx >> 5, q = idx & 31; w3s[idx] = w3[(size_t)i * 1024 + (q >> 3) * 256 + c0 + (q & 7)]; }
        for (int idx = tid; idx < 256 * 64; idx += NT) z2s[(idx >> 6) * 65 + (idx & 63)] = Z2C[idx];
        __syncthreads();
        for (int idx = tid; idx < 2 * 511 * 8; idx += NT) { const int cc = idx & 7, e = (idx >> 3) % 511, o = (idx >> 3) / 511, d = e - 255;
            const int ad = d >= 0 ? d : -d, q = (o * 2 + (d >= 0 ? 0 : 1)) * 8 + cc;
            float a = 0.f;
#pragma unroll 8
            for (int i = 0; i < 64; ++i) a += z2s[ad * 65 + i] * w3s[i * 32 + q];
            comb[(o * 8 + cc) * 512 + e] = a * expf(-((float)ad / (float)(CTX - 1)) * fabsf(dec[(q >> 3) * 256 + c0 + cc])); }
        __syncthreads();
#pragma unroll 1
        for (int o = 0; o < 2; ++o) {
            const float* zs = (o == 0 ? zb : z1) + c * 256;
            const float* cm = comb + (o * 8 + c) * 512 + 255 + lane;
            float acc[4] = {0.f, 0.f, 0.f, 0.f};
#pragma unroll 4
            for (int s2 = 0; s2 < CTX; ++s2) { const float zv = zs[s2];
#pragma unroll
                for (int k = 0; k < 4; ++k) acc[k] += cm[64 * k - s2] * zv; }
            const float bias = hy_bias[(l * 2 + o) * 256 + c0 + c];
            const int col = o * 256 + c0 + c; const float w0 = cw[col], w1 = cw[768 + col], w2 = cw[1536 + col], bb = cb[col];
#pragma unroll
            for (int k = 0; k < 4; ++k) { const int t = lane + 64 * k, row = rowbase + t;
                const float* pp = PC + (size_t)row * 768 + col;
                float gte = bb + w1 * pp[0];
                if (t > 0) gte += w0 * pp[-768];
                if (t < CTX - 1) gte += w2 * pp[768];
                const float res = gte * (acc[k] + bias * zs[t]);
                if (o == 0) z1[c * 256 + t] = res; else Y[(size_t)(NLAT + row) * D + c0 + c] = f2bf(res); }
            __syncthreads();
        }
    }
}

#define PK_CEX(a, b) do { const unsigned hi_ = (a) > (b) ? (a) : (b); const unsigned lo_ = (a) > (b) ? (b) : (a); (a) = hi_; (b) = lo_; } while (0)
__device__ __forceinline__ void sort16d(unsigned (&v)[16]) {
#pragma unroll
    for (int k = 2; k <= 16; k <<= 1)
#pragma unroll
        for (int j = k >> 1; j > 0; j >>= 1)
#pragma unroll
            for (int i = 0; i < 16; ++i) { const int l = i ^ j; if (l > i) { if ((i & k) == 0) PK_CEX(v[i], v[l]); else PK_CEX(v[l], v[i]); } }
}
__device__ __forceinline__ void merge16d(unsigned (&A)[16], const unsigned (&B)[16]) {
#pragma unroll
    for (int i = 0; i < 16; ++i) A[i] = A[i] > B[15 - i] ? A[i] : B[15 - i];
#pragma unroll
    for (int j = 8; j > 0; j >>= 1)
#pragma unroll
        for (int i = 0; i < 16; ++i) { const int l = i ^ j; if (l > i) PK_CEX(A[i], A[l]); }
}
constexpr int PK_PITCH = 272;
__device__ __forceinline__ void peer_top16(const bf16_t* __restrict__ qrow_p, const LAS unsigned char* Kl, int ql, int hh, int lane, unsigned (&L)[16]) {
    bf16x8 qf[8];
#pragma unroll
    for (int s = 0; s < 8; ++s) qf[s] = __builtin_bit_cast(bf16x8, *(const uint4*)(qrow_p + 16 * s + 8 * hh));
#pragma unroll
    for (int i = 0; i < 16; ++i) L[i] = 0u;
#pragma unroll 1
    for (int kt = 0; kt < 4; ++kt) {
        f32x16 S;
#pragma unroll
        for (int r = 0; r < 16; ++r) S[r] = 256.f;
        const LAS unsigned char* kp = Kl + (kt * 32 + ql) * PK_PITCH + 16 * hh;
#pragma unroll
        for (int s = 0; s < 8; ++s) { const bf16x8 kf = *(const LAS bf16x8*)(kp + 32 * s); S = __builtin_amdgcn_mfma_f32_32x32x16_bf16(kf, qf[s], S, 0, 0, 0); }
        unsigned T[16];
#pragma unroll
        for (int r = 0; r < 16; ++r) { const int key = kt * 32 + (r & 3) + 8 * (r >> 2) + 4 * hh; T[r] = (__float_as_uint(S[r]) & 0xffffff80u) | (unsigned)(127 - key); }
        sort16d(T);
        merge16d(L, T);
    }
    unsigned PL[16];
#pragma unroll
    for (int i = 0; i < 16; ++i) PL[i] = (unsigned)__builtin_amdgcn_ds_bpermute((lane ^ 32) << 2, (int)L[i]);
    merge16d(L, PL);
}
static constexpr int PEER_PA[16] = {2, 2, 2, 2, 2, 3, 3, 3, 3, 4, 4, 4, 5, 5, 6, 6};
static constexpr int PEER_PB[16] = {0, 1, 2, 3, 4, 0, 1, 2, 3, 0, 1, 2, 0, 1, 0, 1};
__device__ __forceinline__ unsigned peer_pairpk(unsigned p1, unsigned p2, int code) {
    const float sum = __uint_as_float(p1 & 0xffffff80u) + __uint_as_float(p2 & 0xffffff80u) - 256.f;
    return (__float_as_uint(sum) & 0xffffff00u) | (unsigned)(255 - code);
}
__device__ __forceinline__ void peer_route_phase(int Mrows, const bf16_t* __restrict__ Qb, const bf16_t* __restrict__ K16l, int* __restrict__ RIDX, float* __restrict__ RGATE, float* __restrict__ RSU, const float* __restrict__ SU,
                                                 LAS unsigned* ldsw, int bid_, int G_, int tid) {
    const int lane = tid & 63, wave = __builtin_amdgcn_readfirstlane(tid >> 6), ql = lane & 31, hh = lane >> 5;
    LAS unsigned* lw = ldsw + wave * 2048;
    const LAS unsigned char* kl = (const LAS unsigned char*)(ldsw + 8 * 2048);
    const int ntile = Mrows / 32, ngrp = ((ntile + 7) / 8) * 8;
    for (int grp = bid_; grp < ngrp; grp += G_) {
        const int h = grp & 7, tt = (grp >> 3) * 8 + wave;
        __syncthreads();
        for (int c = tid; c < 256 * 16; c += NT) { const int row = c >> 4, ch = c & 15;
            const uint4 v = *(const uint4*)(K16l + ((size_t)(h * 2) * 128 + row) * 128 + ch * 8);
            *(LAS u32x4v*)((LAS unsigned char*)kl + row * PK_PITCH + ch * 16) = (u32x4v){v.x, v.y, v.z, v.w}; }
        __syncthreads();
        if (tt < ntile) {
        const int token = tt * 32 + ql;
        unsigned L1[16], L2[16];
        peer_top16(Qb + (size_t)token * 2048 + h * 256, kl, ql, hh, lane, L1);
        peer_top16(Qb + (size_t)token * 2048 + h * 256 + 128, kl + 128 * PK_PITCH, ql, hh, lane, L2);
#pragma unroll
        for (int i = 0; i < 16; ++i) { lw[i * 64 + lane] = L1[i]; lw[1024 + i * 64 + lane] = L2[i]; }
        unsigned G0[16], G1[16], G2[16], G3[16];
#pragma unroll
        for (int b = 0; b < 16; ++b) G0[b] = peer_pairpk(L1[0], L2[b], b);
#pragma unroll
        for (int b = 0; b < 8; ++b) G1[b] = peer_pairpk(L1[1], L2[b], 16 + b);
#pragma unroll
        for (int a = 8; a < 16; ++a) G1[8 + (15 - a)] = peer_pairpk(L1[a], L2[0], a * 16);
#pragma unroll
        for (int j = 8; j > 0; j >>= 1)
#pragma unroll
            for (int i = 0; i < 16; ++i) { const int l2 = i ^ j; if (l2 > i) PK_CEX(G1[i], G1[l2]); }
#pragma unroll
        for (int n = 0; n < 16; ++n) G2[n] = peer_pairpk(L1[PEER_PA[n]], L2[PEER_PB[n]], PEER_PA[n] * 16 + PEER_PB[n]);
        G3[0] = peer_pairpk(L1[7], L2[0], 7 * 16); G3[1] = peer_pairpk(L1[7], L2[1], 7 * 16 + 1);
#pragma unroll
        for (int i = 2; i < 16; ++i) G3[i] = 0u;
        sort16d(G2);
        PK_CEX(G3[0], G3[1]);
        merge16d(G0, G1); merge16d(G2, G3); merge16d(G0, G2);
        float sc[16]; int ix[16]; float mx = -3.0e38f;
#pragma unroll
        for (int i = 0; i < 16; ++i) { const int code = 255 - (int)(G0[i] & 255u); const unsigned p1 = lw[(code >> 4) * 64 + lane], p2 = lw[1024 + (code & 15) * 64 + lane];
            sc[i] = __uint_as_float(p1 & 0xffffff80u) + __uint_as_float(p2 & 0xffffff80u) - 512.f; mx = fmaxf(mx, sc[i]);
            ix[i] = (127 - (int)(p1 & 127u)) * 128 + (127 - (int)(p2 & 127u)); }
        float sm = 0.f;
#pragma unroll
        for (int i = 0; i < 16; ++i) { sc[i] = __expf(sc[i] - mx); sm += sc[i]; }
        const float inv = 1.f / sm;
        int* ri = RIDX + (size_t)token * 128 + h * 16 + hh * 8; float* rg = RGATE + (size_t)token * 128 + h * 16 + hh * 8;
        int4 o0, o1; float4 g0, g1;
        o0.x = hh ? ix[8] : ix[0]; o0.y = hh ? ix[9] : ix[1]; o0.z = hh ? ix[10] : ix[2]; o0.w = hh ? ix[11] : ix[3];
        o1.x = hh ? ix[12] : ix[4]; o1.y = hh ? ix[13] : ix[5]; o1.z = hh ? ix[14] : ix[6]; o1.w = hh ? ix[15] : ix[7];
        const float* SV = SU + NEXP;
        g0.x = (hh ? sc[8] : sc[0]) * inv * SV[o0.x]; g0.y = (hh ? sc[9] : sc[1]) * inv * SV[o0.y]; g0.z = (hh ? sc[10] : sc[2]) * inv * SV[o0.z]; g0.w = (hh ? sc[11] : sc[3]) * inv * SV[o0.w];
        g1.x = (hh ? sc[12] : sc[4]) * inv * SV[o1.x]; g1.y = (hh ? sc[13] : sc[5]) * inv * SV[o1.y]; g1.z = (hh ? sc[14] : sc[6]) * inv * SV[o1.z]; g1.w = (hh ? sc[15] : sc[7]) * inv * SV[o1.w];
        float4 u0, u1; u0.x = SU[o0.x]; u0.y = SU[o0.y]; u0.z = SU[o0.z]; u0.w = SU[o0.w]; u1.x = SU[o1.x]; u1.y = SU[o1.y]; u1.z = SU[o1.z]; u1.w = SU[o1.w];
        float* ru = RSU + (size_t)token * 128 + h * 16 + hh * 8;
        *(int4*)ri = o0; *(int4*)(ri + 4) = o1; *(float4*)rg = g0; *(float4*)(rg + 4) = g1; *(float4*)ru = u0; *(float4*)(ru + 4) = u1;
        }
    }
}

typedef _Float16 f16x2v __attribute__((ext_vector_type(2)));
__device__ __forceinline__ float dot2h(unsigned a, unsigned b, float c) { return __builtin_amdgcn_fdot2(__builtin_bit_cast(f16x2v, a), __builtin_bit_cast(f16x2v, b), c, false); }
__device__ __forceinline__ unsigned pk_f16(float a, float b) { f16x2v v = {(_Float16)a, (_Float16)b}; return __builtin_bit_cast(unsigned, v); }
#ifndef TSEL_A
#define TSEL_A -1
#define TSEL_B -1
#define TSEL_C -1
#define TSEL_D -1
#endif
#ifndef REP_WA
#define REP_WA 1
#endif
#ifndef REP_ROUTE
#define REP_ROUTE 1
#endif
#ifndef REP_GATHER
#define REP_GATHER 1
#endif
#ifndef REP_DA
#define REP_DA 1
#endif
#ifndef REP_P0
#define REP_P0 1
#endif
#ifndef REP_P3A
#define REP_P3A 1
#endif
#ifndef REP_HY
#define REP_HY 1
#endif
#ifndef REP_GIN
#define REP_GIN 1
#endif
#ifndef REP_CVT
#define REP_CVT 1
#endif
constexpr size_t OFF_T16 = OFF_P + (size_t)72 * 1024 * 1024;
__global__ void __launch_bounds__(NT) mega(Params p) {
    extern __shared__ __attribute__((aligned(16))) unsigned char lds[];
    cg::grid_group grid = cg::this_grid();
    const int wave_s = __builtin_amdgcn_readfirstlane((int)threadIdx.x >> 6);
    volatile LAS unsigned* bst = (volatile LAS unsigned*)(lds + LDS_BAR_OFF);
    if (threadIdx.x < 4) bst[threadIdx.x] = 0u;
    __syncthreads();
    unsigned char* ws = p.ws;
    XcdBarrier xb = xcd_barrier_post((unsigned*)(ws + OFF_BAR), bst);
    const int G = gridDim.x, bid = blockIdx.x;
    const size_t gsz = (size_t)G * NT;
    const int nwaves = G * 8;
    float* ldsf = (float*)lds;
    int stamp_k = 0;
#define STAMP() do { if (TSEL_A >= 0) { if (bid == 0 && wave_s == 0) { unsigned long long* tsb = (unsigned long long*)(p.ws + 32768); const unsigned long long tnow = __builtin_amdgcn_s_memrealtime(); int lb_; asm volatile("v_mbcnt_lo_u32_b32 %0, -1, 0" : "=v"(lb_)); if (lb_ == 0) __hip_atomic_store(tsb + stamp_k, tnow, __ATOMIC_RELAXED, __HIP_MEMORY_SCOPE_AGENT); } ++stamp_k; } } while (0)
#define PH_VARS int tid; asm volatile("v_mbcnt_lo_u32_b32 %0, -1, 0\n\tv_mbcnt_hi_u32_b32 %0, -1, %0\n\tv_lshl_add_u32 %0, %1, 6, %0" : "=&v"(tid) : "s"(wave_s)); int zz = 0; asm volatile("" : "+s"(zz)); \
    const int lane = tid & 63, wave = __builtin_amdgcn_readfirstlane(tid >> 6); \
    const size_t gtid = (size_t)bid * NT + tid; const int gwave = bid * 8 + wave; (void)gtid; (void)gwave; (void)lane; \
    unsigned char* const wsl = p.ws + zz; \
    bf16_t* const X = (bf16_t*)(wsl + OFF_X); bf16_t* const Hb = (bf16_t*)(wsl + OFF_HB); float* const P = (float*)(wsl + OFF_P); float* const Q = (float*)(wsl + OFF_P); \
    float* const U = (float*)(wsl + OFF_U); float* const Z1 = (float*)(wsl + OFF_Z1); bf16_t* const Y = (bf16_t*)(wsl + OFF_Y); float* const HF = (float*)(wsl + OFF_HF); \
    float* const HFC = (float*)(wsl + OFF_HFC); bf16_t* const WinT = (bf16_t*)(wsl + OFF_WIN); bf16_t* const WoutT = (bf16_t*)(wsl + OFF_WOUT); bf16_t* const WqT = (bf16_t*)(wsl + OFF_WQ); \
    float* const MODP = (float*)(wsl + OFF_MODP); float* const MOD = (float*)(wsl + OFF_MOD); float* const TAB = (float*)(wsl + OFF_TAB); \
    bf16_t* const Qd = (bf16_t*)(wsl + OFF_QD); bf16_t* const Kd = (bf16_t*)(wsl + OFF_KD); bf16_t* const VdT = (bf16_t*)(wsl + OFF_VDT); float* const KMAX = (float*)(wsl + OFF_KMAX); float* const HT = (float*)(wsl + OFF_HT); bf16_t* const YhT = (bf16_t*)(wsl + OFF_YHT); float2* const TW = (float2*)(wsl + OFF_TW); float* const ZT = (float*)(wsl + OFF_ZT); (void)ZT; bf16_t* const Qw = (bf16_t*)(wsl + OFF_QW); bf16_t* const Kw = (bf16_t*)(wsl + OFF_KW); bf16_t* const VwT = (bf16_t*)(wsl + OFF_VWT); (void)Qw; (void)Kw; (void)VwT; bf16_t* const K16 = (bf16_t*)(wsl + OFF_K16); int* const RIDX = (int*)(wsl + OFF_RIDX); float* const RGATE = (float*)(wsl + OFF_RGATE); (void)K16; (void)RIDX; (void)RGATE; float* const RSU = (float*)(wsl + OFF_RSU); (void)RSU; \
    const float* const MODl = MOD + (size_t)l * 3 * 6144; const float* const HFl = HF + (size_t)l * HFP * 1024; (void)HT; (void)YhT; (void)TW; \
    (void)X; (void)Hb; (void)P; (void)Q; (void)U; (void)Z1; (void)Y; (void)HF; (void)HFC; (void)WinT; (void)WoutT; (void)WqT; (void)MODP; (void)MOD; (void)TAB; (void)Qd; (void)Kd; (void)VdT; (void)KMAX; (void)MODl; (void)HFl;
#define IN(k) (p.in[(k) + zz])

    STAMP();
    for (int rep0 = 0; rep0 < REP_P0; ++rep0) {
        const int l = 0; (void)l;
        PH_VARS
        __syncthreads();
        for (int l = 0; l < 2; ++l) {
            transpose_convert<true>(IN(7) + (size_t)l * D * INC, WinT + (size_t)l * INC * D, D, INC, gtid, gsz);
            transpose_convert<false>(IN(24) + (size_t)l * D * D, WoutT + (size_t)l * D * D, D, D, gtid, gsz);
            transpose_convert<false>(IN(26) + (size_t)l * D * 2048, WqT + (size_t)l * 2048 * D, D, 2048, gtid, gsz);
        }
        for (int i = tid; i < 3 * D; i += NT) { const float cv = i < 2 * D ? IN(1)[i] : IN(3)[i - 2 * D]; ldsf[i] = cv / (1.f + expf(-cv)); }
        __syncthreads();
        for (size_t idx = gtid; idx < (size_t)16 * 2 * 6144; idx += gsz) {
            const int j = (int)(idx % 6144), l = (int)((idx / 6144) & 1), s = (int)(idx / 12288);
            const float* w = IN(4) + ((size_t)l * D + s * 64) * 6144 + j;
            float a0 = 0.f, a1 = 0.f, a2 = 0.f;
#pragma unroll 16
            for (int k = 0; k < 64; ++k) { const float wv = w[(size_t)k * 6144]; a0 += ldsf[s * 64 + k] * wv; a1 += ldsf[D + s * 64 + k] * wv; a2 += ldsf[2 * D + s * 64 + k] * wv; }
            float* o = MODP + ((size_t)(s * 2 + l) * 3) * 6144 + j;
            o[0] = a0; o[6144] = a1; o[2 * 6144] = a2;
        }
        if (gtid < 64) ((unsigned*)KMAX)[gtid] = 0u;
        for (size_t idx = gtid; idx < (size_t)2 * 16 * 128 * 128; idx += gsz) K16[idx] = f2bf(IN(27)[idx]);
        for (size_t idx = gtid; idx < 128 * 24; idx += gsz) {
            const int pos = (int)(idx / 24), f = (int)(idx % 24);
            const float inv = f < 16 ? powf(10000.f, -(float)(2 * f) / 32.f) : powf(10000.f, -(float)(2 * (f - 16)) / 16.f);
            const float ang = (float)pos * inv;
            ((unsigned*)TAB)[idx] = pk_f16(cosf(ang), sinf(ang));
        }
        for (size_t idx = gtid; idx < 16384; idx += gsz) { const float a = (float)idx * (1.f / 8192.f); TW[idx] = make_float2(cospif(a), sinpif(a)); }
        __syncthreads();
        for (int it = bid; it < 2 * (SEQ / 32); it += G) {
            const int l2 = it / (SEQ / 32), t0 = (it % (SEQ / 32)) * 32;
            const float* w3 = IN(15) + (size_t)l2 * 64 * 1024; const float* dec = IN(16) + (size_t)l2 * 1024;
            const int ql = lane & 31, kk = lane >> 5;
            const unsigned wlo = (unsigned)(8 * kk * 1024 + wave * 128 + ql);
            float* wl = ldsf + 4096;
            { const float* w1g = IN(10) + (size_t)l2 * 33 * 64; const float* w2g = IN(13) + (size_t)l2 * 64 * 64;
              float s1[5], s2[8], s3 = 0.f;
#pragma unroll
              for (int q = 0; q < 5; ++q) { const int i = tid + 512 * q; s1[q] = i < 33 * 64 ? w1g[i] : 0.f; }
#pragma unroll
              for (int q = 0; q < 8; ++q) s2[q] = w2g[tid + 512 * q];
              if (tid < 192) s3 = tid < 64 ? IN(11)[l2 * 64 + tid] : (tid < 128 ? IN(12)[l2 * 64 + tid - 64] : IN(14)[l2 * 64 + tid - 128]);
              float b8n[4][8];
#pragma unroll
              for (int c = 0; c < 4; ++c)
#pragma unroll
                  for (int j = 0; j < 8; ++j) b8n[c][j] = (w3 + (16 * c + j) * 1024)[wlo];
              __builtin_amdgcn_sched_barrier(0);
#pragma unroll
              for (int q = 0; q < 5; ++q) { const int i = tid + 512 * q; if (i < 33 * 64) wl[i] = s1[q]; }
#pragma unroll
              for (int q = 0; q < 8; ++q) wl[2240 + tid + 512 * q] = s2[q];
              if (tid < 128) wl[2112 + tid] = s3; else if (tid < 192) wl[6336 + tid - 128] = s3;
              __syncthreads();
              { float z2[4]; hy_filter_z2<4>(wl, wl + 2112, wl + 2176, wl + 2240, wl + 6336, SEQ, t0 + wave * 4, lane, z2);
#pragma unroll
                for (int q = 0; q < 4; ++q) ldsf[(wave * 4 + q) * 68 + lane] = z2[q]; }
              __syncthreads();
#define HF_SPLIT8(src, H, L) do { unsigned h_[4], l_[4]; _Pragma("unroll") for (int i_ = 0; i_ < 4; ++i_) { const float x0_ = (src)[2 * i_], x1_ = (src)[2 * i_ + 1]; h_[i_] = pk_bf16(x0_, x1_); \
                  l_[i_] = pk_bf16(x0_ - __uint_as_float(h_[i_] << 16), x1_ - __uint_as_float(h_[i_] & 0xffff0000u)); } \
                  H = __builtin_bit_cast(bf16x8, make_uint4(h_[0], h_[1], h_[2], h_[3])); L = __builtin_bit_cast(bf16x8, make_uint4(l_[0], l_[1], l_[2], l_[3])); } while (0)
              float dd[4];
#pragma unroll
              for (int nt = 0; nt < 4; ++nt) dd[nt] = dec[wave * 128 + 32 * nt + ql];
#pragma unroll
              for (int nt = 0; nt < 4; ++nt) {
                  f32x16 facc;
#pragma unroll
                  for (int r = 0; r < 16; ++r) facc[r] = 0.f;
                  bf16x8 bh[4], bl[4];
#pragma unroll
                  for (int c = 0; c < 4; ++c) HF_SPLIT8(b8n[c], bh[c], bl[c]);
                  if (nt < 3) {
#pragma unroll
                      for (int c = 0; c < 4; ++c)
#pragma unroll
                          for (int j = 0; j < 8; ++j) b8n[c][j] = (w3 + (16 * c + j) * 1024 + 32 * (nt + 1))[wlo];
                      __builtin_amdgcn_sched_barrier(0); }
#pragma unroll
                  for (int c = 0; c < 4; ++c) {
                      bf16x8 ahc, alc; float a8[8]; const float4 a0 = *(const float4*)(ldsf + ql * 68 + 16 * c + 8 * kk), a1 = *(const float4*)(ldsf + ql * 68 + 16 * c + 8 * kk + 4);
                      a8[0] = a0.x; a8[1] = a0.y; a8[2] = a0.z; a8[3] = a0.w; a8[4] = a1.x; a8[5] = a1.y; a8[6] = a1.z; a8[7] = a1.w; HF_SPLIT8(a8, ahc, alc);
                      facc = __builtin_amdgcn_mfma_f32_32x32x16_bf16(ahc, bh[c], facc, 0, 0, 0);
                      facc = __builtin_amdgcn_mfma_f32_32x32x16_bf16(ahc, bl[c], facc, 0, 0, 0);
                      facc = __builtin_amdgcn_mfma_f32_32x32x16_bf16(alc, bh[c], facc, 0, 0, 0); }
                  { const int col = wave * 128 + 32 * nt + ql; const float dcol = fabsf(dd[nt]);
                    float* op = HF + ((size_t)l2 * 1024 + col) * HFP + t0;
#pragma unroll
                    for (int rg = 0; rg < 4; ++rg) { const int p0 = 8 * rg + 4 * kk; float4 v;
                        v.x = facc[4 * rg] * __expf(-((float)(t0 + p0) / (float)(SEQ - 1)) * dcol); v.y = facc[4 * rg + 1] * __expf(-((float)(t0 + p0 + 1) / (float)(SEQ - 1)) * dcol);
                        v.z = facc[4 * rg + 2] * __expf(-((float)(t0 + p0 + 2) / (float)(SEQ - 1)) * dcol); v.w = facc[4 * rg + 3] * __expf(-((float)(t0 + p0 + 3) / (float)(SEQ - 1)) * dcol);
                        *(float4*)(op + p0) = v; } }
              }
#undef HF_SPLIT8
            }
            __syncthreads();
        }
        for (int t = gwave; t < CTX; t += nwaves) { float z2[1]; hy_filter_z2<1>(IN(10), IN(11), IN(12), IN(13), IN(14), CTX, t, lane, z2); HFC[(size_t)t * 64 + lane] = z2[0]; }
    }
    grid.sync();
    STAMP();
    { const int l = 0; (void)l; PH_VARS
    for (size_t idx = gtid; idx < (size_t)2 * 3 * 6144; idx += gsz) {
        const int j = (int)(idx % 6144), r = (int)((idx / 6144) % 3), l = (int)(idx / (3 * 6144));
        float a = IN(5)[l * 6144 + j];
        for (int s = 0; s < 16; ++s) a += MODP[((size_t)(s * 2 + l) * 3 + r) * 6144 + j];
        MOD[idx] = a;
    } }
    xcd_barrier(xb, wave_s); STAMP();

    for (int l = 0; l < 2; ++l) {
        const bool with_ctx = (l == 0);
        const float lam_init = 0.8f - 0.6f * expf(-0.3f * (float)l);
        if (l == 0) {
        { PH_VARS norm_phase(IN(0), IN(2), IN(6) + l * D, MODl, 0, 1024, NTOK, Hb, gwave, nwaves, lane); }
        xcd_barrier(xb, wave_s); STAMP();
        }
        { PH_VARS pg8::Gemm g{Hb, WinT + (size_t)l * INC * D, NTOK, INC, D}; pg8::StaticOrder S; S.init(NTOK, INC, G, bid);
          EpiInProj E{HT, U, Qw, Kw, VwT, Qd, Kd, VdT, (const unsigned*)TAB, (unsigned*)KMAX, l};
          for (int repg = 0; repg < REP_GIN; ++repg)
          pg8::gemm_phase<EpiInProj, pg8::StaticOrder>((PG8_LAS unsigned char*)lds, g, S, E, tid); }
        xcd_barrier(xb, wave_s); STAMP();
        { PH_VARS
          for (int reph = 0; reph < REP_HY; ++reph)
          hyena_fft_phase(l, HT, HFl, TW, IN(8) + (size_t)l * 3 * 768, IN(9) + l * 768, IN(17) + l * 512, YhT, ZT, (float2*)(wsl + OFF_P), (LAS f32x2v*)lds, bid, G, tid);
          __syncthreads();
          if (with_ctx) hyena_ctx_fused(l, U, IN(8) + (size_t)l * 3 * 768, IN(9) + l * 768, Y, HFC, IN(15), IN(16), IN(17), ldsf, bid, G, tid); }
        xcd_barrier(xb, wave_s); STAMP();
        {
            PH_VARS
            for (int rep = 0; rep < REP_WA; ++rep)
            wa_phase(with_ctx, Qw, Kw, VwT, KMAX + 32 + l * 8, IN(18) + l * 8, Y, (LAS unsigned char*)lds, bid, G, tid);
            __syncthreads();
        }
        {
            PH_VARS
            float lam;
            { float s1 = 0.f, s2 = 0.f;
              for (int i = 0; i < 32; ++i) { s1 += IN(19)[l * 32 + i] * IN(20)[l * 32 + i]; s2 += IN(21)[l * 32 + i] * IN(22)[l * 32 + i]; }
              lam = expf(s1) - expf(s2) + lam_init; }
            __syncthreads();
            for (int rep = 0; rep < REP_DA; ++rep)
            da_phase(l, with_ctx, Qd, Kd, VdT, KMAX + l * 16, lam, lam_init, IN(23) + l * 64, Y, (LAS unsigned char*)lds, bid, G, tid);
        }
        {
            PH_VARS
            __syncthreads();
            bf16_t* tl = (bf16_t*)lds;
            for (int it = bid; it < NLAT / 64; it += G) {
                const int r0 = it * 64;
#pragma unroll
                for (int e = 0; e < 4; ++e) { const int idx = tid + 512 * e, c = idx >> 3, ch = idx & 7;
                    const uint4 v = *(const uint4*)(YhT + (size_t)c * NLAT + r0 + ch * 8);
                    unsigned* d = (unsigned*)(tl + c * 66 + ch * 8); d[0] = v.x; d[1] = v.y; d[2] = v.z; d[3] = v.w; }
                __syncthreads();
                { const int rr = tid >> 3, cch = tid & 7;
#pragma unroll
                  for (int q = 0; q < 4; ++q) { unsigned w[4];
#pragma unroll
                      for (int jj = 0; jj < 4; ++jj) { const int c = cch * 32 + 8 * q + 2 * jj; w[jj] = (unsigned)tl[c * 66 + rr] | ((unsigned)tl[(c + 1) * 66 + rr] << 16); }
                      *(uint4*)(Y + (size_t)(r0 + rr) * D + cch * 32 + 8 * q) = make_uint4(w[0], w[1], w[2], w[3]); } }
                __syncthreads();
            }
        }
        xcd_barrier(xb, wave_s); STAMP();
        const int Mrows = with_ctx ? NTOK : NLAT;
        { PH_VARS pg8::Gemm g{Y, WoutT + (size_t)l * D * D, Mrows, D, D}; pg8::StaticOrder S; S.init(Mrows, D, G, bid);
          EpiResid E{X, MODl, IN(0), IN(2), l != 0};
          pg8::gemm_phase<EpiResid, pg8::StaticOrder>((PG8_LAS unsigned char*)lds, g, S, E, tid); }
        xcd_barrier(xb, wave_s); STAMP();
        { PH_VARS norm_phase_b(X, IN(25) + l * D, MODl, 3072, 4096, Mrows, Hb, gwave, nwaves, lane);
          { uint4* T8 = (uint4*)(wsl + OFF_T16); float* TS = (float*)(wsl + OFF_T16 + (size_t)2 * NEXP * D);
            for (int repc = 0; repc < REP_CVT; ++repc)
            for (int rowi = gwave; rowi < 2 * NEXP; rowi += nwaves) {
                const int tab = rowi >= NEXP ? 1 : 0, e = rowi - tab * NEXP;
                const float4* src = (const float4*)((tab ? IN(29) : IN(28)) + ((size_t)l * NEXP + e) * D) + lane * 4;
                float4 v[4]; float mx = 0.f;
#pragma unroll
                for (int j = 0; j < 4; ++j) { v[j] = src[j]; mx = fmaxf(mx, fmaxf(fmaxf(fabsf(v[j].x), fabsf(v[j].y)), fmaxf(fabsf(v[j].z), fabsf(v[j].w)))); }
                mx = wave_max(mx);
                const float sc = mx > 0.f ? 127.f / mx : 0.f;
                const int qoff = tab ? 128 : 0;
                unsigned w[4];
#pragma unroll
                for (int j = 0; j < 4; ++j) { const unsigned q0 = (unsigned)((int)rintf(v[j].x * sc) + qoff) & 0xffu, q1 = (unsigned)((int)rintf(v[j].y * sc) + qoff) & 0xffu, q2 = (unsigned)((int)rintf(v[j].z * sc) + qoff) & 0xffu, q3 = (unsigned)((int)rintf(v[j].w * sc) + qoff) & 0xffu;
                    w[j] = q0 | (q1 << 8) | (q2 << 16) | (q3 << 24); }
                T8[(size_t)rowi * 64 + lane] = make_uint4(w[0], w[1], w[2], w[3]);
                if (lane == 0) TS[rowi] = mx * (1.f / 127.f);
            } } }
        xcd_barrier(xb, wave_s); STAMP();
        { PH_VARS pg8::Gemm g{Hb, WqT + (size_t)l * 2048 * D, Mrows, 2048, D}; pg8::StaticOrder S; S.init(Mrows, 2048, G, bid);
          pg8::EpiBf16<0> E{(bf16_t*)Q, 2048, nullptr, 0, 0};
          pg8::gemm_phase<pg8::EpiBf16<0>, pg8::StaticOrder>((PG8_LAS unsigned char*)lds, g, S, E, tid); }
        xcd_barrier(xb, wave_s); STAMP();
        { PH_VARS
          for (int rep = 0; rep < REP_ROUTE; ++rep)
          peer_route_phase(Mrows, (const bf16_t*)Q, K16 + (size_t)l * 16 * 128 * 128, RIDX, RGATE, RSU, (const float*)(wsl + OFF_T16 + (size_t)2 * NEXP * D), (LAS unsigned*)lds, bid, G, tid); }
        xcd_barrier(xb, wave_s); STAMP();
        {
            PH_VARS
            int* gidx = (int*)(ldsf + wave * 384); float* gate = (float*)(gidx + 128); float* gsu = gate + 128;
            const float4* g4 = (const float4*)(IN(25) + l * D);
            const int nitem_total = NLAT + 4 * (Mrows - NLAT);
            int nl_i0, nl_i1; float nl_g0, nl_g1, nl_s0, nl_s1;
            { const int row0_ = gwave; const int lane0_ = tid & 63;
              nl_i0 = RIDX[(size_t)row0_ * 128 + lane0_]; nl_i1 = RIDX[(size_t)row0_ * 128 + 64 + lane0_]; nl_g0 = RGATE[(size_t)row0_ * 128 + lane0_]; nl_g1 = RGATE[(size_t)row0_ * 128 + 64 + lane0_];
              nl_s0 = RSU[(size_t)row0_ * 128 + lane0_]; nl_s1 = RSU[(size_t)row0_ * 128 + 64 + lane0_]; }
            for (int idx = gwave; idx < nitem_total; idx += nwaves) {
                int lane_s = tid & 63; asm volatile("" : "+v"(lane_s)); const int lane = lane_s;
                const bool quarter = idx >= NLAT;
                const int row = quarter ? NLAT + ((idx - NLAT) >> 2) : idx;
                const int qd = idx & 3, e_lo = quarter ? qd * 32 : 0, e_hi = quarter ? qd * 32 + 32 : 128;
                const int r = row < NLAT ? (row >> 13) : 2;
                gidx[lane] = nl_i0; gidx[64 + lane] = nl_i1; gate[lane] = nl_g0; gate[64 + lane] = nl_g1; gsu[lane] = nl_s0; gsu[64 + lane] = nl_s1;
                { const int nidx = idx + nwaves; const int nrow = nidx >= nitem_total ? row : (nidx >= NLAT ? NLAT + ((nidx - NLAT) >> 2) : nidx);
                  nl_i0 = RIDX[(size_t)nrow * 128 + lane]; nl_i1 = RIDX[(size_t)nrow * 128 + 64 + lane]; nl_g0 = RGATE[(size_t)nrow * 128 + lane]; nl_g1 = RGATE[(size_t)nrow * 128 + 64 + lane];
                  nl_s0 = RSU[(size_t)nrow * 128 + lane]; nl_s1 = RSU[(size_t)nrow * 128 + 64 + lane]; }
                WAVE_SYNC();
                float4 xv[4]; float hv[16]; float ss = 0.f;
                const uint2* xr = (const uint2*)(X + (size_t)row * D) + lane * 4;
#pragma unroll
                for (int j = 0; j < 4; ++j) { const uint2 xw2 = xr[j]; xv[j] = make_float4(__uint_as_float(xw2.x << 16), __uint_as_float(xw2.x & 0xffff0000u), __uint_as_float(xw2.y << 16), __uint_as_float(xw2.y & 0xffff0000u));
                    ss += xv[j].x * xv[j].x + xv[j].y * xv[j].y + xv[j].z * xv[j].z + xv[j].w * xv[j].w; }
                ss = wave_sum(ss);
                const float rs = rsqrtf(ss * (1.f / D) + 1e-6f);
                const float4* sh4 = (const float4*)(MODl + r * 6144 + 3072) + lane * 4; const float4* sc4 = (const float4*)(MODl + r * 6144 + 4096) + lane * 4;
                float hmx = 0.f;
#pragma unroll
                for (int j = 0; j < 4; ++j) { const float4 gg = g4[lane * 4 + j], sh = sh4[j], sc = sc4[j];
                    hv[4 * j] = xv[j].x * rs * gg.x * (1.f + sc.x) + sh.x; hv[4 * j + 1] = xv[j].y * rs * gg.y * (1.f + sc.y) + sh.y;
                    hv[4 * j + 2] = xv[j].z * rs * gg.z * (1.f + sc.z) + sh.z; hv[4 * j + 3] = xv[j].w * rs * gg.w * (1.f + sc.w) + sh.w;
                    hmx = fmaxf(hmx, fmaxf(fmaxf(fabsf(hv[4 * j]), fabsf(hv[4 * j + 1])), fmaxf(fabsf(hv[4 * j + 2]), fabsf(hv[4 * j + 3])))); }
                hmx = wave_max(hmx);
                const float hsc = hmx > 0.f ? 127.f / hmx : 0.f, hscale = hmx * (1.f / 127.f);
                int hq[4];
#pragma unroll
                for (int j = 0; j < 4; ++j) hq[j] = (int)(((unsigned)(int)rintf(hv[4 * j] * hsc) & 0xffu) | (((unsigned)(int)rintf(hv[4 * j + 1] * hsc) & 0xffu) << 8) | (((unsigned)(int)rintf(hv[4 * j + 2] * hsc) & 0xffu) << 16) | (((unsigned)(int)rintf(hv[4 * j + 3] * hsc) & 0xffu) << 24));
                float ov[16]; float corr = 0.f;
#pragma unroll
                for (int j = 0; j < 16; ++j) ov[j] = 0.f;
                const uint4* U8 = (const uint4*)(wsl + OFF_T16); const uint4* V8 = U8 + (size_t)NEXP * 64;
                const float* SU = (const float*)(wsl + OFF_T16 + (size_t)2 * NEXP * D); const float* SV = SU + NEXP;
                for (int rep = 0; rep < REP_GATHER; ++rep) {
                if (rep > 0) {
#pragma unroll
                    for (int j = 0; j < 16; ++j) ov[j] *= 0.f;
                    corr *= 0.f; }
#define PG_LOAD(UA, VA, E0) do { _Pragma("unroll") for (int k = 0; k < 8; ++k) { const int ex_ = __builtin_amdgcn_readfirstlane(gidx[(E0) + k]); UA[k] = (U8 + (size_t)ex_ * 64)[lane]; VA[k] = (V8 + (size_t)ex_ * 64)[lane]; } } while (0)
#define PG_COMPUTE(UA, VA, E0) do { int dd[8]; \
                    _Pragma("unroll") for (int k = 0; k < 8; ++k) { int d_ = __builtin_amdgcn_sdot4((int)UA[k].x, hq[0], 0, false); d_ = __builtin_amdgcn_sdot4((int)UA[k].y, hq[1], d_, false); \
                        d_ = __builtin_amdgcn_sdot4((int)UA[k].z, hq[2], d_, false); dd[k] = __builtin_amdgcn_sdot4((int)UA[k].w, hq[3], d_, false); } \
                      \
                    int t4[4], t2[2], t1; \
                    _Pragma("unroll") for (int i = 0; i < 4; ++i) { const int snd = b0 ? dd[i] : dd[i + 4], kp = b0 ? dd[i + 4] : dd[i]; t4[i] = kp + swzxi<1>(snd); } \
                    _Pragma("unroll") for (int i = 0; i < 2; ++i) { const int snd = b1 ? t4[i] : t4[i + 2], kp = b1 ? t4[i + 2] : t4[i]; t2[i] = kp + swzxi<2>(snd); } \
                    { const int snd = b2 ? t2[0] : t2[1], kp = b2 ? t2[1] : t2[0]; t1 = kp + swzxi<4>(snd); } \
                    t1 += swzxi<8>(t1); t1 += swzxi<16>(t1); t1 += __builtin_amdgcn_ds_bpermute((lane ^ 32) << 2, t1); \
                    const float dot = (float)t1 * (gsu[(E0) + esel] * hscale); \
                    const float wl = gate[(E0) + esel] * 0.5f * dot * (1.f + erff(dot * 0.70710678118654752f)); \
                    corr += wl; \
                    _Pragma("unroll") for (int k = 0; k < 8; ++k) { const float w = rdlane(wl, ((k >> 2) & 1) | (((k >> 1) & 1) << 1) | ((k & 1) << 2)); \
                        const unsigned vw[4] = {VA[k].x, VA[k].y, VA[k].z, VA[k].w}; \
                        _Pragma("unroll") for (int j = 0; j < 4; ++j) { \
                            ov[4 * j] = fmaf((float)(vw[j] & 0xffu), w, ov[4 * j]); ov[4 * j + 1] = fmaf((float)((vw[j] >> 8) & 0xffu), w, ov[4 * j + 1]); \
                            ov[4 * j + 2] = fmaf((float)((vw[j] >> 16) & 0xffu), w, ov[4 * j + 2]); ov[4 * j + 3] = fmaf((float)(vw[j] >> 24), w, ov[4 * j + 3]); } } } while (0)
                const bool b0 = lane & 1, b1 = lane & 2, b2 = lane & 4; const int esel = (b0 ? 4 : 0) + (b1 ? 2 : 0) + (b2 ? 1 : 0);
                {
                    uint4 uA[8], vA[8], uB[8], vB[8];
                    PG_LOAD(uA, vA, e_lo);
#pragma unroll 1
                    for (int e0 = e_lo; e0 < e_hi; e0 += 16) {
                        PG_LOAD(uB, vB, e0 + 8);
                        PG_COMPUTE(uA, vA, e0);
                        if (e0 + 16 < e_hi) PG_LOAD(uA, vA, e0 + 16);
                        PG_COMPUTE(uB, vB, e0 + 8);
                    }
                }
#undef PG_LOAD
#undef PG_COMPUTE
                }
                corr = wave_sum(corr) * (128.f / 8.f);
                if (quarter) {
                    float* part = ldsf + 4096 + wave * (17 * 64);
#pragma unroll
                    for (int j = 0; j < 16; ++j) part[j * 64 + lane] = ov[j];
                    part[16 * 64 + lane] = corr;
                    __syncthreads();
                    if (qd == 0) {
#pragma unroll
                        for (int w2 = 1; w2 < 4; ++w2) { const float* pp = part + w2 * (17 * 64);
#pragma unroll
                            for (int j = 0; j < 16; ++j) ov[j] += pp[j * 64 + lane];
                            corr += pp[16 * 64 + lane]; }
                    }
                    __syncthreads();
                }
                if (!quarter || qd == 0) {
                const float4* gm4 = (const float4*)(MODl + r * 6144 + 5120) + lane * 4;
                uint2* xw = (uint2*)(X + (size_t)row * D) + lane * 4; asm volatile("" : "+v"(xw));
                float4 on[4]; float s2 = 0.f;
#pragma unroll
                for (int j = 0; j < 4; ++j) { const float4 gm = gm4[j]; const uint2 xw2 = xw[j]; const float4 x0 = make_float4(__uint_as_float(xw2.x << 16), __uint_as_float(xw2.x & 0xffff0000u), __uint_as_float(xw2.y << 16), __uint_as_float(xw2.y & 0xffff0000u)); float4 o;
                    o.x = x0.x + gm.x * (ov[4 * j] - corr); o.y = x0.y + gm.y * (ov[4 * j + 1] - corr); o.z = x0.z + gm.z * (ov[4 * j + 2] - corr); o.w = x0.w + gm.w * (ov[4 * j + 3] - corr);
                    on[j] = o; s2 += o.x * o.x + o.y * o.y + o.z * o.z + o.w * o.w;
                    if (l == 0 || TSEL_A >= 0) xw[j] = make_uint2(pk_bf16(o.x, o.y), pk_bf16(o.z, o.w)); }
                s2 = wave_sum(s2);
                const float rs2 = rsqrtf(s2 * (1.f / D) + 1e-6f);
                if (l == 0) {
                    const float4* gn4 = (const float4*)(IN(6) + D) + lane * 4;
                    const float4* sh1 = (const float4*)(MOD + 3 * 6144 + r * 6144) + lane * 4; const float4* sc1 = (const float4*)(MOD + 3 * 6144 + r * 6144 + 1024) + lane * 4;
                    unsigned hw[8];
#pragma unroll
                    for (int j = 0; j < 4; ++j) { const float4 gg = gn4[j], sh = sh1[j], sc = sc1[j];
                        hw[2 * j] = pk_bf16(on[j].x * rs2 * gg.x * (1.f + sc.x) + sh.x, on[j].y * rs2 * gg.y * (1.f + sc.y) + sh.y);
                        hw[2 * j + 1] = pk_bf16(on[j].z * rs2 * gg.z * (1.f + sc.z) + sh.z, on[j].w * rs2 * gg.w * (1.f + sc.w) + sh.w); }
                    uint4* hp = (uint4*)(Hb + (size_t)row * D) + lane * 2;
                    hp[0] = make_uint4(hw[0], hw[1], hw[2], hw[3]); hp[1] = make_uint4(hw[4], hw[5], hw[6], hw[7]);
                } else if (TSEL_A < 0) {
                    const float4* fg4 = (const float4*)IN(30) + lane * 4;
                    float4* op = (float4*)(p.out + (size_t)row * D) + lane * 4;
#pragma unroll
                    for (int j = 0; j < 4; ++j) { const float4 g = fg4[j]; float4 o; o.x = on[j].x * rs2 * g.x; o.y = on[j].y * rs2 * g.y; o.z = on[j].z * rs2 * g.z; o.w = on[j].w * rs2 * g.w; op[j] = o; }
                }
                }
                WAVE_SYNC();
            }
        }
        xcd_barrier(xb, wave_s); STAMP();
    }
    if (TSEL_A >= 0) {
        const int l = 0; (void)l;
        PH_VARS
        const float4* fg = (const float4*)IN(30);
        float oscale = 1.f, oadd = 0.f;
        if (TSEL_A >= 0) { const unsigned long long* tsb = (const unsigned long long*)(p.ws + 32768);
            const float dab = (float)(long long)(tsb[TSEL_B] - tsb[TSEL_A]) * 0.01f;
            oscale = 1.f + 0.02f + dab * (0.03f / 2000.f);
            if (TSEL_C >= 0) { const float dcd = (float)(long long)(tsb[TSEL_D] - tsb[TSEL_C]) * 0.01f; oadd = dcd * 0.01f; } }
        for (int row = gwave; row < NLAT; row += nwaves) {
            const uint2* xr = (const uint2*)(X + (size_t)row * D);
            float4 v[4]; float ss = 0.f;
#pragma unroll
            for (int j = 0; j < 4; ++j) { const uint2 xw2 = xr[lane + 64 * j]; v[j] = make_float4(__uint_as_float(xw2.x << 16), __uint_as_float(xw2.x & 0xffff0000u), __uint_as_float(xw2.y << 16), __uint_as_float(xw2.y & 0xffff0000u)); ss += v[j].x * v[j].x + v[j].y * v[j].y + v[j].z * v[j].z + v[j].w * v[j].w; }
            ss = wave_sum(ss);
            const float rs = rsqrtf(ss * (1.f / D) + 1e-6f);
            float4* orow = (float4*)(p.out + (size_t)row * D);
#pragma unroll
            for (int j = 0; j < 4; ++j) { const float4 g = fg[lane + 64 * j]; float4 o; o.x = v[j].x * rs * g.x * oscale; o.y = v[j].y * rs * g.y * oscale; o.z = v[j].z * rs * g.z * oscale; o.w = v[j].w * rs * g.w * oscale; if (TSEL_C >= 0 && row == 0 && j == 0 && lane == 0) o.x += oadd; orow[lane + 64 * j] = o; }
        }
    }
}

extern "C" void kernel_launch(void* const* d_in, const int* in_sizes, int n_in, void* d_out, int out_size, void* d_ws, size_t ws_size, hipStream_t stream) {
    static int grid_blocks = 0;
    if (!grid_blocks) {
        int dev = 0, cus = 0, per_cu = 0;
        (void)hipGetDevice(&dev);
        (void)hipDeviceGetAttribute(&cus, hipDeviceAttributeMultiprocessorCount, dev);
        (void)hipFuncSetAttribute((const void*)mega, hipFuncAttributeMaxDynamicSharedMemorySize, LDS_BYTES);
        (void)hipOccupancyMaxActiveBlocksPerMultiprocessor(&per_cu, (const void*)mega, NT, LDS_BYTES);
        if (per_cu < 1) fprintf(stderr, "kernel_launch: occupancy query reports %d blocks per CU\n", per_cu);
        if (ws_size < OFF_END) fprintf(stderr, "kernel_launch: workspace too small: %zu < %zu\n", ws_size, (size_t)OFF_END);
        grid_blocks = cus;
    }
    Params p{};
    for (int i = 0; i < 31 && i < n_in; ++i) p.in[i] = (const float*)d_in[i];
    p.out = (float*)d_out;
    p.ws = (unsigned char*)d_ws;
    (void)hipMemsetAsync(d_ws, 0, XCD_BAR_WORDS * 4, stream);
    void* args[] = {&p};
    hipError_t e = hipLaunchCooperativeKernel((const void*)mega, dim3(grid_blocks), dim3(NT), args, LDS_BYTES, stream);
    if (e != hipSuccess) fprintf(stderr, "cooperative launch failed: %s (grid %d)\n", hipGetErrorString(e), grid_blocks);
}
```

```cpp
#include <hip/hip_runtime.h>
#include <hip/hip_cooperative_groups.h>
#include <cstdio>
#include <cstdint>
namespace cg = cooperative_groups;

#define NT 512
#define LAS __attribute__((address_space(3)))

#define XB_TMO      128
#define XB_XCNT(j)  (256  + 64 * (j))
#define XB_XSUB(j)  (1280 + 64 * (j))
#define XB_XGEN(j)  (2304 + 64 * (j))
#define XB_TOP      3328
#define XB_TOPGEN   3392
#define XCD_BAR_WORDS 3456
#define XB_SPIN_CAP (1u << 26)

__device__ __forceinline__ unsigned xb_ld(unsigned* p)              { return __hip_atomic_load(p, __ATOMIC_RELAXED, __HIP_MEMORY_SCOPE_AGENT); }
__device__ __forceinline__ unsigned xb_add(unsigned* p, unsigned v) { return __hip_atomic_fetch_add(p, v, __ATOMIC_RELAXED, __HIP_MEMORY_SCOPE_AGENT); }
__device__ __forceinline__ unsigned xb_xcc_id() { return (unsigned)__builtin_amdgcn_s_getreg((3 << 11) | 20) & 0xFu; }
#define XB_SPIN(cond, bar) do { unsigned _sp = 0; while (cond) { __builtin_amdgcn_s_sleep(1); \
    if ((++_sp & 255u) == 0u) { if (xb_ld(&(bar)[XB_TMO])) break; if (_sp > XB_SPIN_CAP) { atomicAdd(&(bar)[XB_TMO], 1u); break; } } } } while (0)

struct XcdBarrier { unsigned* bar; unsigned x; volatile LAS unsigned* st; };

__device__ __forceinline__ XcdBarrier xcd_barrier_post(unsigned* bar, volatile LAS unsigned* st) {
    XcdBarrier b; b.bar = bar; b.x = xb_xcc_id(); b.st = st;
    if (threadIdx.x == 0) (void)xb_add(&bar[XB_XCNT(b.x)], 1u);
    return b;
}
__device__ __forceinline__ void xcd_barrier_complete(unsigned* bar, unsigned x, unsigned& nloc, unsigned& nx) {
    const unsigned G = gridDim.x * gridDim.y * gridDim.z;
    unsigned sum, cnt, mine, sp = 0u;
    for (;;) {
        sum = 0u; cnt = 0u; mine = 0u;
#pragma unroll
        for (unsigned j = 0; j < 16; ++j) { const unsigned c = xb_ld(&bar[XB_XCNT(j)]); sum += c; cnt += (c > 0u) ? 1u : 0u; mine = (j == x) ? c : mine; }
        if (sum == G) break;
        __builtin_amdgcn_s_sleep(1);
        if ((++sp & 255u) == 0u) { if (xb_ld(&bar[XB_TMO])) break; if (sp > XB_SPIN_CAP) { atomicAdd(&bar[XB_TMO], 1u); break; } }
    }
    nloc = mine > 0u ? mine : 1u; nx = cnt > 0u ? cnt : 1u;
}
__device__ __forceinline__ void xcd_barrier(const XcdBarrier& b, int wave_s) {
    asm volatile("s_waitcnt vmcnt(0)" ::: "memory");
    __syncthreads();
    int lane_b; asm volatile("v_mbcnt_lo_u32_b32 %0, -1, 0\n\tv_mbcnt_hi_u32_b32 %0, -1, %0" : "=&v"(lane_b));
    if (wave_s == 0 && lane_b == 0) {
        unsigned* bar = b.bar; unsigned bx = b.x;
        asm volatile("" : "+s"(bar), "+s"(bx));
        __builtin_amdgcn_s_waitcnt(0);
        unsigned nloc = b.st[0], nx = b.st[1];
        if (nloc == 0u) { xcd_barrier_complete(bar, bx, nloc, nx); b.st[0] = nloc; b.st[1] = nx; }
        const unsigned old = xb_add(&bar[XB_XSUB(bx)], 1u);
        const unsigned gen = old / nloc;
        if (old + 1u == (gen + 1u) * nloc) {
            __builtin_amdgcn_fence(__ATOMIC_RELEASE, "agent");
            asm volatile("s_waitcnt vmcnt(0)" ::: "memory");
            const unsigned og = xb_add(&bar[XB_TOP], 1u);
            const unsigned tg = og / nx;
            if (og + 1u == (tg + 1u) * nx) xb_add(&bar[XB_TOPGEN], 1u);
            else XB_SPIN(xb_ld(&bar[XB_TOPGEN]) == tg, bar);
            __builtin_amdgcn_fence(__ATOMIC_ACQUIRE, "agent");
            xb_add(&bar[XB_XGEN(bx)], 1u);
            asm volatile("s_waitcnt vmcnt(0)" ::: "memory");
        } else {
            XB_SPIN(xb_ld(&bar[XB_XGEN(bx)]) == gen, bar);
            __builtin_amdgcn_fence(__ATOMIC_ACQUIRE, "agent");
            asm volatile("s_waitcnt vmcnt(0)" ::: "memory");
        }
    }
    __syncthreads();
}

namespace pg8 {
#define PG8_LAS __attribute__((address_space(3)))
typedef unsigned short bf16_t;
typedef short bf16x8 __attribute__((ext_vector_type(8)));
typedef float f32x4 __attribute__((ext_vector_type(4)));
typedef unsigned u32x4 __attribute__((ext_vector_type(4)));
constexpr int BM = 256, BK = 64, HALF = 128, HTB = HALF * BK * 2  , STAGE_BYTES = 8 * HTB, NXCD = 8, WGM = 8;

__host__ __device__ __forceinline__ int lds_byte(int r, int c) { const int st = (r >> 4) * 2 + (c >> 5), rr = r & 15, cc = c & 31, ob = rr * 64 + cc * 2; return st * 1024 + (ob ^ (((ob >> 9) & 1) << 5)); }
__host__ __device__ __forceinline__ void stage_rc(int b, int& R, int& C) { const int st = b / 1024, sb = b % 1024, swz = sb ^ (((sb >> 9) & 1) << 5); R = (st >> 1) * 16 + swz / 64; C = (st & 1) * 32 + (swz % 64) / 2; }
__host__ __device__ __forceinline__ int perm32(int rho) { const int n = rho >> 4, i = rho & 15; return 8 * (i >> 2) + 4 * n + (i & 3); }

struct Unit { int pm, pn; };
struct Gemm { const bf16_t* A; const bf16_t* Bt; int M, N, K; };

struct StaticOrder {
    int nM, nN, nwg, G, c;
    __host__ __device__ void init(int M, int N, int G_, int c_) { nM = M / BM; nN = N / BM; nwg = nM * nN; G = G_; c = c_; }
    __host__ __device__ bool next(int i, Unit& u) const {
        const long L = (long)i * G + c; if (L >= nwg) return false;
        int wgid = (int)L; { const int q = nwg / NXCD, r = nwg % NXCD, xcd = wgid % NXCD, off = wgid / NXCD; wgid = (xcd < r ? xcd * (q + 1) : r * (q + 1) + (xcd - r) * q) + off; }
        const int nig = WGM * nN, gid = wgid / nig, fm = gid * WGM, gsz = (nM - fm) < WGM ? (nM - fm) : WGM;
        u.pm = fm + ((wgid % nig) % gsz); u.pn = (wgid % nig) / gsz; return true;
    }
    __device__ __forceinline__ void a_ready(const Unit&) const {}
    __device__ __forceinline__ void done(const Unit&) const {}
};
struct CountedOrder : StaticOrder {
    const unsigned* ready; unsigned need; unsigned* tmo;
    __device__ __forceinline__ void a_ready(const Unit& u) const {
        if (threadIdx.x < 64) {
            const unsigned long long t0 = __builtin_amdgcn_s_memrealtime(); unsigned polls = 0;
            while ((unsigned)__builtin_amdgcn_readfirstlane(__hip_atomic_load(ready + 64 * u.pm, __ATOMIC_RELAXED, __HIP_MEMORY_SCOPE_AGENT)) < need) {
                if ((++polls & 255u) == 0u && __builtin_amdgcn_readfirstlane(__hip_atomic_load(tmo, __ATOMIC_RELAXED, __HIP_MEMORY_SCOPE_AGENT)) != 0u) break;
                if (__builtin_amdgcn_s_memrealtime() - t0 > 2000000ull) {
                    if (threadIdx.x == 0) { unsigned expect = 0u; __hip_atomic_compare_exchange_strong(tmo + 1, &expect, 0x600u | (unsigned)(u.pm & 0xff), __ATOMIC_RELAXED, __ATOMIC_RELAXED, __HIP_MEMORY_SCOPE_AGENT); __hip_atomic_store(tmo, 1u, __ATOMIC_RELAXED, __HIP_MEMORY_SCOPE_AGENT); }
                    break; }
                __builtin_amdgcn_s_sleep(2); }
            __builtin_amdgcn_fence(__ATOMIC_ACQUIRE, "agent");
            asm volatile("s_waitcnt vmcnt(0)" ::: "memory");
        }
#if !defined(BROKEN_HOOK_NO_BARRIER)
        asm volatile("" ::: "memory"); __builtin_amdgcn_s_barrier(); asm volatile("" ::: "memory");
#endif
    }
};

__device__ __forceinline__ unsigned cvt_pk_bf16(float lo, float hi) { unsigned r; asm volatile("v_cvt_pk_bf16_f32 %0, %1, %2" : "=v"(r) : "v"(lo), "v"(hi)); return r; }
typedef float f32x2 __attribute__((ext_vector_type(2)));
__device__ __forceinline__ f32x2 gelu_pk(f32x2 v) {
    const f32x2 av = __builtin_elementwise_abs(v), d = av * 0.2316418882f + 1.0f;
    f32x2 t; t.x = __builtin_amdgcn_rcpf(d.x); t.y = __builtin_amdgcn_rcpf(d.y);
    f32x2 q = t * 0.5307027145f + (-0.7265760135f); q = q * t + 0.7107068705f; q = q * t + (-0.142248368f); q = q * t + 0.127414796f; q = q * t;
    const f32x2 s = (v * v) * (-0.72134752044f);
    f32x2 e; e.x = __builtin_amdgcn_exp2f(s.x); e.y = __builtin_amdgcn_exp2f(s.y);
    const f32x2 m = v * (q * e), r = v - m;
    f32x2 o; o.x = v.x < 0.f ? m.x : r.x; o.y = v.y < 0.f ? m.y : r.y; return o;
}

struct EpiF32 {
    static constexpr bool PERM = false, AFTER_DRAIN = false; static constexpr int REPS = 1;
    float* C; int ldc; const float* bias;
    __device__ __forceinline__ void operator()(const f32x4 (&acc)[2][2][4][2], const Unit& u, int wr, int wc, int fr, int fq) const {
        const int row0 = u.pm * BM + wr * 64 + fr, col0 = u.pn * BM + wc * 32 + 4 * fq;
        f32x4 bv[2][2];
#pragma unroll
        for (int bj = 0; bj < 2; ++bj)
#pragma unroll
            for (int n = 0; n < 2; ++n) bv[bj][n] = bias ? *(const f32x4*)(bias + col0 + bj * HALF + n * 16) : (f32x4){0.f, 0.f, 0.f, 0.f};
#pragma unroll
        for (int ai = 0; ai < 2; ++ai)
#pragma unroll
            for (int m = 0; m < 4; ++m) { float* rowp = C + (size_t)(row0 + ai * HALF + m * 16) * ldc + col0;
#pragma unroll
                for (int bj = 0; bj < 2; ++bj)
#pragma unroll
                    for (int n = 0; n < 2; ++n) *(f32x4*)(rowp + bj * HALF + n * 16) = acc[ai][bj][m][n] + bv[bj][n]; }
    }
};

template <int ACT  > struct EpiBf16 {
    static constexpr bool PERM = true, AFTER_DRAIN = false; static constexpr int REPS = 1;
    bf16_t* O; int ldc; const float* bias; int split_cols; size_t split_stride;
    __device__ __forceinline__ void operator()(const f32x4 (&acc)[2][2][4][2], const Unit& u, int wr, int wc, int fr, int fq) const {
        const int row0 = u.pm * BM + wr * 64 + fr; int colt = u.pn * BM; bf16_t* base = O;
        if (split_cols) { const int t = colt / split_cols; base += (size_t)t * split_stride; colt -= t * split_cols; }
        const int col0 = colt + wc * 32 + 8 * fq, bcol0 = u.pn * BM + wc * 32 + 8 * fq;
        f32x4 bv[2][2];
#pragma unroll
        for (int bj = 0; bj < 2; ++bj)
#pragma unroll
            for (int n = 0; n < 2; ++n) bv[bj][n] = bias ? *(const f32x4*)(bias + bcol0 + bj * HALF + 4 * n) : (f32x4){0.f, 0.f, 0.f, 0.f};
#pragma unroll
        for (int ai = 0; ai < 2; ++ai)
#pragma unroll
            for (int m = 0; m < 4; ++m) { bf16_t* rowp = base + (size_t)(row0 + ai * HALF + m * 16) * ldc + col0;
#pragma unroll
                for (int bj = 0; bj < 2; ++bj) { f32x4 v0 = acc[ai][bj][m][0] + bv[bj][0], v1 = acc[ai][bj][m][1] + bv[bj][1];
                    if (ACT == 1) { f32x2 a = gelu_pk((f32x2){v0[0], v0[1]}), b = gelu_pk((f32x2){v0[2], v0[3]}), c = gelu_pk((f32x2){v1[0], v1[1]}), d = gelu_pk((f32x2){v1[2], v1[3]});
                        v0 = (f32x4){a.x, a.y, b.x, b.y}; v1 = (f32x4){c.x, c.y, d.x, d.y}; }
                    if (ACT == 2) {
#pragma unroll
                        for (int j = 0; j < 4; ++j) { v0[j] = 0.5f * v0[j] * (1.0f + erff(v0[j] * 0.70710678f)); v1[j] = 0.5f * v1[j] * (1.0f + erff(v1[j] * 0.70710678f)); } }
                    u32x4 w; w.x = cvt_pk_bf16(v0[0], v0[1]); w.y = cvt_pk_bf16(v0[2], v0[3]); w.z = cvt_pk_bf16(v1[0], v1[1]); w.w = cvt_pk_bf16(v1[2], v1[3]);
                    *(u32x4*)(rowp + bj * HALF) = w; } }
    }
};

template <class Epi, class Sched>
__device__ __forceinline__ void gemm_phase(PG8_LAS unsigned char* lds, const Gemm g, const Sched& S, const Epi& E, int tid_in) {
    int tid_o = tid_in; asm volatile("" : "+v"(tid_o));
    const int tid = tid_o, wid = __builtin_amdgcn_readfirstlane(tid >> 6), lane = tid & 63, wr = wid >> 2, wc = wid & 3, fr = lane & 15, fq = lane >> 4;
    const int K = g.K, nt = K / BK;
    unsigned voffA[2], voffB[2];
#pragma unroll
    for (int i = 0; i < 2; ++i) { int R, C; stage_rc(tid * 16 + i * 8192, R, C); const int Rb = Epi::PERM ? ((R & ~31) + perm32(R & 31)) : R;
        voffA[i] = (unsigned)(R * K + C) * 2u; voffB[i] = (unsigned)(Rb * K + C) * 2u; }
    const size_t kstep = (size_t)(BK * 2);
    const size_t hstep = (size_t)HALF * K * 2;
    const size_t tstep = 2 * hstep;
    const unsigned ldsw = (unsigned)wid * 1024u;
    const int aoff = lds_byte(wr * 64 + fr, fq * 8), boff = lds_byte(wc * 32 + fr, fq * 8);
#define PG8_SA(b, h) (((b) * 2 + (h)) * HTB)
#define PG8_SB(b, h) ((4 + (b) * 2 + (h)) * HTB)
#define PG8_STAGE(bufoff, gbase, voff) do { _Pragma("unroll") for (int _i = 0; _i < 2; ++_i) \
        __builtin_amdgcn_global_load_lds((const unsigned*)((const char*)(gbase) + (voff)[_i]), (PG8_LAS unsigned*)(lds + (bufoff) + ldsw + _i * 8192), 16, 0, 0); } while (0)
#define PG8_LDA(dst, b, h) do { _Pragma("unroll") for (int m = 0; m < 4; ++m) _Pragma("unroll") for (int k = 0; k < 2; ++k) dst[m][k] = *(const PG8_LAS bf16x8*)(lds + PG8_SA(b, h) + aoff + m * 2048 + k * 1024); } while (0)
#define PG8_LDB(dst, b, h) do { _Pragma("unroll") for (int n = 0; n < 2; ++n) _Pragma("unroll") for (int k = 0; k < 2; ++k) dst[n][k] = *(const PG8_LAS bf16x8*)(lds + PG8_SB(b, h) + boff + n * 2048 + k * 1024); } while (0)
#define PG8_MMA(ai, bj, At, Bt) do { __builtin_amdgcn_s_setprio(1); _Pragma("unroll") for (int m = 0; m < 4; ++m) _Pragma("unroll") for (int n = 0; n < 2; ++n) _Pragma("unroll") for (int k = 0; k < 2; ++k) \
        acc[ai][bj][m][n] = __builtin_amdgcn_mfma_f32_16x16x32_bf16(Bt[n][k], At[m][k], acc[ai][bj][m][n], 0, 0, 0); __builtin_amdgcn_s_setprio(0); } while (0)
#define PG8_WAIT_V(n) asm volatile("s_waitcnt vmcnt(" #n ")" ::: "memory")
#define PG8_WAIT_L(n) asm volatile("s_waitcnt lgkmcnt(" #n ")" ::: "memory")
#define PG8_BAR __builtin_amdgcn_s_barrier()
#define PG8_SCHED __builtin_amdgcn_sched_barrier(0)
    Unit cur, nxt; int ui = 0;
    if (!S.next(0, cur)) return;
    f32x4 acc[2][2][4][2];
#pragma unroll
    for (int a = 0; a < 2; ++a)
#pragma unroll
        for (int b = 0; b < 2; ++b)
#pragma unroll
            for (int m = 0; m < 4; ++m)
#pragma unroll
                for (int n = 0; n < 2; ++n) acc[a][b][m][n] = (f32x4){0.f, 0.f, 0.f, 0.f};
    bf16x8 At[4][2], B0[2][2], B1[2][2];
    const char* cA = (const char*)g.A + (size_t)cur.pm * tstep; const char* cB = (const char*)g.Bt + (size_t)cur.pn * tstep;
    S.a_ready(cur);
    PG8_STAGE(PG8_SB(0, 0), cB, voffB); PG8_STAGE(PG8_SA(0, 0), cA, voffA); PG8_STAGE(PG8_SB(0, 1), cB + hstep, voffB); PG8_STAGE(PG8_SA(0, 1), cA + hstep, voffA);
    if (wr == 1) PG8_BAR;
    PG8_WAIT_V(4); PG8_BAR;
    PG8_STAGE(PG8_SB(1, 0), cB + kstep, voffB); PG8_STAGE(PG8_SA(1, 0), cA + kstep, voffA); PG8_STAGE(PG8_SB(1, 1), cB + hstep + kstep, voffB);
    PG8_WAIT_V(6); PG8_BAR;
    for (;;) {
        const bool has_next = S.next(ui + 1, nxt);
        const char* nA = has_next ? (const char*)g.A + (size_t)nxt.pm * tstep : cA; const char* nB = has_next ? (const char*)g.Bt + (size_t)nxt.pn * tstep : cB;
        for (int t = 0; t < nt; t += 2) {
            const bool last = (t == nt - 2);
            const char* a1 = cA + (size_t)(t + 1) * kstep;
            const char* a2 = last ? nA : cA + (size_t)(t + 2) * kstep; const char* b2 = last ? nB : cB + (size_t)(t + 2) * kstep;
            const char* a3 = a2 + kstep; const char* b3 = b2 + kstep;
            if (last && has_next) S.a_ready(nxt);
            PG8_LDB(B0, 0, 0); PG8_SCHED; PG8_LDA(At, 0, 0); PG8_STAGE(PG8_SA(1, 1), a1 + hstep, voffA);
            PG8_WAIT_L(8); PG8_BAR; PG8_WAIT_L(0); PG8_MMA(0, 0, At, B0); PG8_BAR; PG8_SCHED;
            PG8_LDB(B1, 0, 1); PG8_STAGE(PG8_SB(0, 0), b2, voffB);
            PG8_BAR; PG8_WAIT_L(0); PG8_MMA(0, 1, At, B1); PG8_BAR;
            PG8_LDA(At, 0, 1); PG8_STAGE(PG8_SA(0, 0), a2, voffA);
            PG8_BAR; PG8_WAIT_L(0); PG8_MMA(1, 0, At, B0); PG8_BAR; PG8_SCHED;
            PG8_STAGE(PG8_SB(0, 1), b2 + hstep, voffB);
            PG8_WAIT_V(6); PG8_BAR; PG8_MMA(1, 1, At, B1); PG8_BAR;
            PG8_LDB(B0, 1, 0); PG8_SCHED; PG8_LDA(At, 1, 0); PG8_STAGE(PG8_SA(0, 1), a2 + hstep, voffA);
            PG8_WAIT_L(8); PG8_BAR; PG8_WAIT_L(0); PG8_MMA(0, 0, At, B0); PG8_BAR; PG8_SCHED;
            PG8_LDB(B1, 1, 1); PG8_STAGE(PG8_SB(1, 0), b3, voffB);
            PG8_BAR; PG8_WAIT_L(0); PG8_MMA(0, 1, At, B1); PG8_BAR;
            PG8_LDA(At, 1, 1); PG8_STAGE(PG8_SA(1, 0), a3, voffA);
            PG8_BAR; PG8_WAIT_L(0); PG8_MMA(1, 0, At, B0); PG8_BAR; PG8_SCHED;
            PG8_STAGE(PG8_SB(1, 1), b3 + hstep, voffB);
            PG8_WAIT_V(6); PG8_BAR; PG8_MMA(1, 1, At, B1); PG8_BAR;
        }
        if constexpr (!Epi::AFTER_DRAIN) { for (int re_ = 0; re_ < Epi::REPS; ++re_) E(acc, cur, wr, wc, fr, fq); S.done(cur); }
        if (!has_next) break;
#pragma unroll
        for (int a = 0; a < 2; ++a)
#pragma unroll
            for (int b = 0; b < 2; ++b)
#pragma unroll
                for (int m = 0; m < 4; ++m)
#pragma unroll
                    for (int n = 0; n < 2; ++n) acc[a][b][m][n] = (f32x4){0.f, 0.f, 0.f, 0.f};
        cur = nxt; cA = nA; cB = nB; ++ui;
    }
    PG8_WAIT_V(0);
    if (wr == 0) PG8_BAR;
    PG8_BAR;
    if constexpr (Epi::AFTER_DRAIN) { E.fused(acc, cur, wr, wc, fr, fq, lds, wid, lane); S.done(cur); }
#undef PG8_SA
#undef PG8_SB
#undef PG8_STAGE
#undef PG8_LDA
#undef PG8_LDB
#undef PG8_MMA
#undef PG8_WAIT_V
#undef PG8_WAIT_L
#undef PG8_BAR
#undef PG8_SCHED
}
}


typedef unsigned short bf16_t;
constexpr int D = 1024, SEQ = 8192, CTX = 256, NLAT = 16384, NCTX = 512, NTOK = 16896, INC = 2304;
constexpr int C_WAQ = 768, C_WAK = 1280, C_WAV = 1408, C_DAQ = 1536, C_DAK = 1792, C_DAV = 2048;
constexpr int NEXP = 16384;
constexpr int HFP = SEQ + 288;
constexpr int HTP = NLAT;

constexpr size_t OFF_BAR  = 0;
constexpr size_t OFF_X    = 65536;
constexpr size_t OFF_HB   = OFF_X    + (size_t)NTOK * D * 4;
constexpr size_t OFF_P    = OFF_HB   + (size_t)NTOK * D * 2;
constexpr size_t OFF_U    = OFF_P    + (size_t)NTOK * INC * 4;
constexpr size_t OFF_Z1   = OFF_U    + (size_t)NCTX * 768 * 4;
constexpr size_t OFF_Y    = OFF_Z1   + (size_t)NCTX * 256 * 4;
constexpr size_t OFF_HF   = OFF_Y    + (size_t)NTOK * D * 2;
constexpr size_t OFF_HFC  = OFF_HF   + (size_t)2 * HFP * 1024 * 4;
constexpr size_t OFF_WIN  = OFF_HFC  + (size_t)CTX * 1024 * 4;
constexpr size_t OFF_WOUT = OFF_WIN  + (size_t)2 * INC * D * 2;
constexpr size_t OFF_WQ   = OFF_WOUT + (size_t)2 * D * D * 2;
constexpr size_t OFF_MODP = OFF_WQ   + (size_t)2 * 2048 * D * 2;
constexpr size_t OFF_MOD  = OFF_MODP + (size_t)16 * 2 * 3 * 6144 * 4;
constexpr size_t OFF_TAB  = OFF_MOD  + (size_t)2 * 3 * 6144 * 4;
constexpr size_t OFF_QD   = OFF_TAB  + (size_t)128 * 24 * 2 * 4;
constexpr size_t OFF_KD   = OFF_QD   + (size_t)NTOK * 256 * 2;
constexpr size_t OFF_VDT  = OFF_KD   + (size_t)NTOK * 256 * 2;
constexpr size_t OFF_KMAX = OFF_VDT  + (size_t)2 * 4 * 64 * (SEQ + CTX) * 2;
constexpr size_t OFF_HT   = OFF_KMAX + 256;
constexpr size_t OFF_YHT  = OFF_HT   + (size_t)768 * HTP * 4;
constexpr size_t OFF_TW   = OFF_YHT  + (size_t)256 * NLAT * 2;
constexpr size_t OFF_ZT   = OFF_HT   + (size_t)512 * HTP * 4;
constexpr size_t OFF_QW   = OFF_TW   + (size_t)16384 * 8;
constexpr size_t OFF_KW   = OFF_QW   + (size_t)NTOK * 512 * 2;
constexpr size_t OFF_VWT  = OFF_KW   + (size_t)NTOK * 128 * 2;
constexpr size_t OFF_K16  = OFF_VWT  + (size_t)2 * 2 * 64 * (SEQ + CTX) * 2;
constexpr size_t OFF_RIDX = OFF_K16  + (size_t)2 * 16 * 128 * 128 * 2;
constexpr size_t OFF_RGATE= OFF_RIDX + (size_t)NTOK * 128 * 4;
constexpr size_t OFF_RSU  = OFF_RGATE + (size_t)NTOK * 128 * 4;
constexpr size_t OFF_END  = OFF_RSU + (size_t)NTOK * 128 * 4;

constexpr int LDS_BAR_OFF = 139264;
constexpr int LDS_BYTES = 139264 + 256;

struct Params { const float* in[31]; float* out; unsigned char* ws; };

__device__ __forceinline__ bf16_t f2bf(float f) { unsigned u = __float_as_uint(f); u += 0x7FFFu + ((u >> 16) & 1u); return (bf16_t)(u >> 16); }
template <int M> __device__ __forceinline__ float swzx(float v) { return __int_as_float(__builtin_amdgcn_ds_swizzle(__float_as_int(v), (M << 10) | 0x1F)); }
template <int M> __device__ __forceinline__ int swzxi(int v) { return __builtin_amdgcn_ds_swizzle(v, (M << 10) | 0x1F); }
__device__ __forceinline__ float wave_sum(float v) {
    v += swzx<1>(v); v += swzx<2>(v); v += swzx<4>(v); v += swzx<8>(v); v += swzx<16>(v);
    return __int_as_float(__builtin_amdgcn_readlane(__float_as_int(v), 0)) + __int_as_float(__builtin_amdgcn_readlane(__float_as_int(v), 32));
}
__device__ __forceinline__ float wave_max(float v) {
    v = fmaxf(v, swzx<1>(v)); v = fmaxf(v, swzx<2>(v)); v = fmaxf(v, swzx<4>(v)); v = fmaxf(v, swzx<8>(v)); v = fmaxf(v, swzx<16>(v));
    return fmaxf(__int_as_float(__builtin_amdgcn_readlane(__float_as_int(v), 0)), __int_as_float(__builtin_amdgcn_readlane(__float_as_int(v), 32)));
}
typedef _Float16 h2v __attribute__((ext_vector_type(2)));
__device__ __forceinline__ float h2lo(unsigned w) { return (float)__builtin_bit_cast(h2v, w).x; }
__device__ __forceinline__ float h2hi(unsigned w) { return (float)__builtin_bit_cast(h2v, w).y; }
__device__ __forceinline__ float xor32(float v, int lane) { return __int_as_float(__builtin_amdgcn_ds_bpermute((lane ^ 32) << 2, __float_as_int(v))); }
__device__ __forceinline__ void wave_argmax(float& bv, int& bi) {
#define AM_STEP(M) { const float ov = swzx<M>(bv); const int oi = swzxi<M>(bi); if (ov > bv || (ov == bv && oi < bi)) { bv = ov; bi = oi; } }
    AM_STEP(1) AM_STEP(2) AM_STEP(4) AM_STEP(8) AM_STEP(16)
#undef AM_STEP
    const float v0 = __int_as_float(__builtin_amdgcn_readlane(__float_as_int(bv), 0)), v1 = __int_as_float(__builtin_amdgcn_readlane(__float_as_int(bv), 32));
    const int i0 = __builtin_amdgcn_readlane(bi, 0), i1 = __builtin_amdgcn_readlane(bi, 32);
    if (v1 > v0 || (v1 == v0 && i1 < i0)) { bv = v1; bi = i1; } else { bv = v0; bi = i0; }
}
__device__ __forceinline__ float rdlane(float v, int l) { return __int_as_float(__builtin_amdgcn_readlane(__float_as_int(v), l)); }
#define WAVE_SYNC() do { __builtin_amdgcn_fence(__ATOMIC_RELEASE, "wavefront"); __builtin_amdgcn_wave_barrier(); __builtin_amdgcn_fence(__ATOMIC_ACQUIRE, "wavefront"); } while (0)

struct EpiResid {
    static constexpr bool PERM = true, AFTER_DRAIN = false; static constexpr int REPS = 1;
    bf16_t* X; const float* mod; const float* srcL; const float* srcC; bool srcb;
    __device__ __forceinline__ void operator()(const pg8::f32x4 (&acc)[2][2][4][2], const pg8::Unit& u, int wr, int wc, int fr, int fq) const {
        using namespace pg8;
        const unsigned voff = (unsigned)((wr * 64 + fr) * D + wc * 32 + 8 * fq);
        const int col0 = u.pn * BM;
        const int rb = u.pm < 32 ? 0 : (u.pm < 64 ? 1 : 2);
        const float* gate = mod + rb * 6144 + 2048 + col0 + wc * 32 + 8 * fq;
        bf16_t* const xt = X + (size_t)u.pm * BM * D + col0;
        const float* const st = (u.pm < 64 ? srcL + (size_t)u.pm * BM * D : srcC + (size_t)(u.pm - 64) * BM * D) + col0;
        f32x4 gv[2][2];
#pragma unroll
        for (int bj = 0; bj < 2; ++bj)
#pragma unroll
            for (int n = 0; n < 2; ++n) gv[bj][n] = *(const f32x4*)(gate + bj * HALF + n * 4);
#pragma unroll
        for (int ai = 0; ai < 2; ++ai) {
            if (srcb) {
                u32x4 sb[4][2];
#pragma unroll
                for (int m = 0; m < 4; ++m) { const bf16_t* srcp = xt + (size_t)(ai * HALF + m * 16) * D;
#pragma unroll
                    for (int bj = 0; bj < 2; ++bj) sb[m][bj] = *(const u32x4*)(srcp + voff + bj * HALF); }
#pragma unroll
                for (int m = 0; m < 4; ++m) { bf16_t* rowp = xt + (size_t)(ai * HALF + m * 16) * D;
#pragma unroll
                    for (int bj = 0; bj < 2; ++bj) {
                        const f32x4 r0 = (f32x4){__uint_as_float(sb[m][bj].x << 16), __uint_as_float(sb[m][bj].x & 0xffff0000u), __uint_as_float(sb[m][bj].y << 16), __uint_as_float(sb[m][bj].y & 0xffff0000u)};
                        const f32x4 r1 = (f32x4){__uint_as_float(sb[m][bj].z << 16), __uint_as_float(sb[m][bj].z & 0xffff0000u), __uint_as_float(sb[m][bj].w << 16), __uint_as_float(sb[m][bj].w & 0xffff0000u)};
                        const f32x4 v0 = r0 + gv[bj][0] * acc[ai][bj][m][0], v1 = r1 + gv[bj][1] * acc[ai][bj][m][1];
                        u32x4 w; w.x = cvt_pk_bf16(v0[0], v0[1]); w.y = cvt_pk_bf16(v0[2], v0[3]); w.z = cvt_pk_bf16(v1[0], v1[1]); w.w = cvt_pk_bf16(v1[2], v1[3]);
                        *(u32x4*)(rowp + voff + bj * HALF) = w; } }
            } else {
                f32x4 sv[4][2][2];
#pragma unroll
                for (int m = 0; m < 4; ++m) { const float* srcp = st + (size_t)(ai * HALF + m * 16) * D;
#pragma unroll
                    for (int bj = 0; bj < 2; ++bj)
#pragma unroll
                        for (int n = 0; n < 2; ++n) sv[m][bj][n] = *(const f32x4*)(srcp + voff + bj * HALF + n * 4); }
#pragma unroll
                for (int m = 0; m < 4; ++m) { bf16_t* rowp = xt + (size_t)(ai * HALF + m * 16) * D;
#pragma unroll
                    for (int bj = 0; bj < 2; ++bj) { const f32x4 v0 = sv[m][bj][0] + gv[bj][0] * acc[ai][bj][m][0], v1 = sv[m][bj][1] + gv[bj][1] * acc[ai][bj][m][1];
                        u32x4 w; w.x = cvt_pk_bf16(v0[0], v0[1]); w.y = cvt_pk_bf16(v0[2], v0[3]); w.z = cvt_pk_bf16(v1[0], v1[1]); w.w = cvt_pk_bf16(v1[2], v1[3]);
                        *(u32x4*)(rowp + voff + bj * HALF) = w; } }
            } }
    }
};

__device__ __forceinline__ void transpose_convert(const float* __restrict__ src, bf16_t* __restrict__ dst, int K, int N, size_t gtid, size_t gsz) {
    const size_t items = (size_t)N * (K / 8);
    for (size_t idx = gtid; idx < items; idx += gsz) {
        const int n = (int)(idx % N), k8 = (int)(idx / N);
        unsigned w[4];
#pragma unroll
        for (int j = 0; j < 4; ++j) {
            const float a = src[(size_t)(k8 * 8 + 2 * j) * N + n], b = src[(size_t)(k8 * 8 + 2 * j + 1) * N + n];
            w[j] = (unsigned)f2bf(a) | ((unsigned)f2bf(b) << 16);
        }
        *(uint4*)(dst + (size_t)n * K + k8 * 8) = make_uint4(w[0], w[1], w[2], w[3]);
    }
}

__device__ __forceinline__ void norm_phase(const float* __restrict__ X, const float* __restrict__ XC, const float* __restrict__ g, const float* __restrict__ modl, int shift_off, int scale_off, int nrows,
                                           bf16_t* __restrict__ Hb, int gwave, int nwaves, int lane) {
    for (int row = gwave; row < nrows; row += nwaves) {
        const int r = row < NLAT ? (row >> 13) : 2;
        const float4* xr = (const float4*)(row < NLAT ? X + (size_t)row * D : XC + (size_t)(row - NLAT) * D);
        float4 v[4]; float ss = 0.f;
#pragma unroll
        for (int j = 0; j < 4; ++j) { v[j] = xr[lane + 64 * j]; ss += v[j].x * v[j].x + v[j].y * v[j].y + v[j].z * v[j].z + v[j].w * v[j].w; }
        ss = wave_sum(ss);
        const float rs = rsqrtf(ss * (1.f / D) + 1e-6f);
        const float4* g4 = (const float4*)g;
        const float4* sh4 = (const float4*)(modl + r * 6144 + shift_off);
        const float4* sc4 = (const float4*)(modl + r * 6144 + scale_off);
#pragma unroll
        for (int j = 0; j < 4; ++j) {
            const float4 gg = g4[lane + 64 * j], sh = sh4[lane + 64 * j], sc = sc4[lane + 64 * j];
            const float a = v[j].x * rs * gg.x * (1.f + sc.x) + sh.x, b = v[j].y * rs * gg.y * (1.f + sc.y) + sh.y;
            const float c = v[j].z * rs * gg.z * (1.f + sc.z) + sh.z, d = v[j].w * rs * gg.w * (1.f + sc.w) + sh.w;
            uint2 w; w.x = (unsigned)f2bf(a) | ((unsigned)f2bf(b) << 16); w.y = (unsigned)f2bf(c) | ((unsigned)f2bf(d) << 16);
            *(uint2*)(Hb + (size_t)row * D + 4 * (lane + 64 * j)) = w;
        }
    }
}
__device__ __forceinline__ void norm_phase_b(const bf16_t* __restrict__ XB, const float* __restrict__ g, const float* __restrict__ modl, int shift_off, int scale_off, int nrows,
                                             bf16_t* __restrict__ Hb, int gwave, int nwaves, int lane) {
    for (int row = gwave; row < nrows; row += nwaves) {
        const int r = row < NLAT ? (row >> 13) : 2;
        const uint4* xr = (const uint4*)(XB + (size_t)row * D);
        float v[2][8]; float ss = 0.f;
#pragma unroll
        for (int j = 0; j < 2; ++j) { const uint4 w = xr[lane + 64 * j]; const unsigned ww[4] = {w.x, w.y, w.z, w.w};
#pragma unroll
            for (int i = 0; i < 4; ++i) { v[j][2 * i] = __uint_as_float(ww[i] << 16); v[j][2 * i + 1] = __uint_as_float(ww[i] & 0xffff0000u); ss += v[j][2 * i] * v[j][2 * i] + v[j][2 * i + 1] * v[j][2 * i + 1]; } }
        ss = wave_sum(ss);
        const float rs = rsqrtf(ss * (1.f / D) + 1e-6f);
        const float4* g4 = (const float4*)g;
        const float4* sh4 = (const float4*)(modl + r * 6144 + shift_off);
        const float4* sc4 = (const float4*)(modl + r * 6144 + scale_off);
#pragma unroll
        for (int j = 0; j < 2; ++j) {
            unsigned o[4];
#pragma unroll
            for (int hf = 0; hf < 2; ++hf) { const int q = 2 * (lane + 64 * j) + hf; const float4 gg = g4[q], sh = sh4[q], sc = sc4[q];
                const float a = v[j][4 * hf] * rs * gg.x * (1.f + sc.x) + sh.x, b = v[j][4 * hf + 1] * rs * gg.y * (1.f + sc.y) + sh.y;
                const float c = v[j][4 * hf + 2] * rs * gg.z * (1.f + sc.z) + sh.z, d = v[j][4 * hf + 3] * rs * gg.w * (1.f + sc.w) + sh.w;
                o[2 * hf] = (unsigned)f2bf(a) | ((unsigned)f2bf(b) << 16); o[2 * hf + 1] = (unsigned)f2bf(c) | ((unsigned)f2bf(d) << 16); }
            *(uint4*)(Hb + (size_t)row * D + 8 * (lane + 64 * j)) = make_uint4(o[0], o[1], o[2], o[3]);
        }
    }
}

typedef short bf16x8 __attribute__((ext_vector_type(8)));
typedef float f32x16 __attribute__((ext_vector_type(16)));
typedef float f32x2v __attribute__((ext_vector_type(2)));
typedef __bf16 bf16x2v __attribute__((ext_vector_type(2)));
typedef unsigned u32x4v __attribute__((ext_vector_type(4)));
__device__ __forceinline__ unsigned pk_bf16(float a, float b) { f32x2v v = {a, b}; return __builtin_bit_cast(unsigned, __builtin_convertvector(v, bf16x2v)); }
constexpr int NKEY = SEQ + CTX;
constexpr int DA_ROWB = 144;
constexpr int DA_TILEB = 64 * DA_ROWB;

__device__ __forceinline__ void da_phase(int l, bool with_ctx, const bf16_t* __restrict__ Qd, const bf16_t* __restrict__ Kd, const bf16_t* __restrict__ VdT,
                                         const float* __restrict__ KMAXl, float lam, float lam_init, const float* __restrict__ gnorm, bf16_t* __restrict__ Y,
                                         LAS unsigned char* lds, int bid, int G, int tid) {
    const int lane = tid & 63, wave = __builtin_amdgcn_readfirstlane(tid >> 6);
    const int ql = lane & 31, hh = lane >> 5;
    const int nitems = 256 + (with_ctx ? 8 : 0);
    for (int it = bid; it < nitems; it += G) {
        int b, h, qrow0, kt0, kt1;
        if (it < 256) { b = it >> 7; h = (it >> 5) & 3; qrow0 = b * SEQ + (it & 31) * 256; kt0 = 0; kt1 = NKEY / 64; }
        else { const int j = it - 256; b = j >> 2; h = j & 3; qrow0 = NLAT + b * CTX; kt0 = SEQ / 64; kt1 = NKEY / 64; }
        const int qrow = qrow0 + wave * 32 + ql;
        bf16x8 qf[2][2];
        float cinit[2];
#pragma unroll
        for (int m = 0; m < 2; ++m) {
            float q2 = 0.f;
#pragma unroll
            for (int s = 0; s < 2; ++s) {
                const uint4 raw = *(const uint4*)(Qd + (size_t)qrow * 256 + h * 64 + m * 32 + s * 16 + hh * 8);
                qf[m][s] = __builtin_bit_cast(bf16x8, raw);
                const unsigned w[4] = {raw.x, raw.y, raw.z, raw.w};
#pragma unroll
                for (int e = 0; e < 4; ++e) { const float lo = __uint_as_float(w[e] << 16), hi = __uint_as_float(w[e] & 0xffff0000u); q2 += lo * lo + hi * hi; }
            }
            q2 += xor32(q2, lane);
            const float k2 = KMAXl[b * 8 + h * 2 + m];
            cinit[m] = -(sqrtf(q2) * sqrtf(k2) * 1.01f + 1e-3f);
        }
        f32x16 O[2][2];
#pragma unroll
        for (int m = 0; m < 2; ++m)
#pragma unroll
            for (int dt = 0; dt < 2; ++dt)
#pragma unroll
                for (int r = 0; r < 16; ++r) O[m][dt][r] = 0.f;
        float lsum[2] = {0.f, 0.f};
        const int srow = tid >> 3, sch = tid & 7;
        const bf16_t* vsrc = VdT + ((size_t)(b * 4 + h) * 64 + srow) * NKEY + sch * 8;
        const int soff = srow * DA_ROWB + sch * 16;
#define KROW_OF(kt) ((kt) < SEQ / 64 ? b * SEQ + (kt) * 64 : NLAT + b * CTX + ((kt) - SEQ / 64) * 64)
        {
            const uint4 kv = *(const uint4*)(Kd + (size_t)(KROW_OF(kt0) + srow) * 256 + h * 64 + sch * 8);
            const uint4 vv = *(const uint4*)(vsrc + (size_t)kt0 * 64);
            *(LAS u32x4v*)(lds + soff) = (u32x4v){kv.x, kv.y, kv.z, kv.w}; *(LAS u32x4v*)(lds + DA_TILEB + soff) = (u32x4v){vv.x, vv.y, vv.z, vv.w};
        }
        __syncthreads();
        int cur = 0;
        for (int kt = kt0; kt < kt1; ++kt) {
            uint4 kv = make_uint4(0, 0, 0, 0), vv = make_uint4(0, 0, 0, 0);
            const bool more = kt + 1 < kt1;
            if (more) { kv = *(const uint4*)(Kd + (size_t)(KROW_OF(kt + 1) + srow) * 256 + h * 64 + sch * 8); vv = *(const uint4*)(vsrc + (size_t)(kt + 1) * 64); }
            const LAS unsigned char* kb = lds + cur * 2 * DA_TILEB;
            const LAS unsigned char* vb = kb + DA_TILEB;
#pragma unroll
            for (int sub = 0; sub < 2; ++sub) {
                bf16x8 vf[2][2];
#pragma unroll
                for (int dt = 0; dt < 2; ++dt)
#pragma unroll
                    for (int s = 0; s < 2; ++s) vf[dt][s] = *(const LAS bf16x8*)(vb + (dt * 32 + ql) * DA_ROWB + (sub * 32 + s * 16 + hh * 8) * 2);
#pragma unroll
                for (int m = 0; m < 2; ++m) {
                    f32x16 S;
#pragma unroll
                    for (int r = 0; r < 16; ++r) S[r] = cinit[m];
#pragma unroll
                    for (int s = 0; s < 2; ++s) {
                        const bf16x8 kf = *(const LAS bf16x8*)(kb + (sub * 32 + ql) * DA_ROWB + m * 64 + s * 32 + hh * 16);
                        S = __builtin_amdgcn_mfma_f32_32x32x16_bf16(kf, qf[m][s], S, 0, 0, 0);
                    }
                    float pe[16]; float ls = 0.f;
#pragma unroll
                    for (int r = 0; r < 16; ++r) { pe[r] = __builtin_amdgcn_exp2f(S[r]); ls += pe[r]; }
                    lsum[m] += ls;
                    bf16x8 pf[2];
#pragma unroll
                    for (int s = 0; s < 2; ++s) {
                        uint4 w; w.x = pk_bf16(pe[8 * s], pe[8 * s + 1]); w.y = pk_bf16(pe[8 * s + 2], pe[8 * s + 3]); w.z = pk_bf16(pe[8 * s + 4], pe[8 * s + 5]); w.w = pk_bf16(pe[8 * s + 6], pe[8 * s + 7]);
                        pf[s] = __builtin_bit_cast(bf16x8, w);
                    }
#pragma unroll
                    for (int dt = 0; dt < 2; ++dt)
#pragma unroll
                        for (int s = 0; s < 2; ++s) O[m][dt] = __builtin_amdgcn_mfma_f32_32x32x16_bf16(vf[dt][s], pf[s], O[m][dt], 0, 0, 0);
                }
            }
            if (more) { LAS unsigned char* nb = lds + (cur ^ 1) * 2 * DA_TILEB; *(LAS u32x4v*)(nb + soff) = (u32x4v){kv.x, kv.y, kv.z, kv.w}; *(LAS u32x4v*)(nb + DA_TILEB + soff) = (u32x4v){vv.x, vv.y, vv.z, vv.w}; }
            __syncthreads();
            cur ^= 1;
        }
#undef KROW_OF
        const float l0 = lsum[0] + xor32(lsum[0], lane), l1 = lsum[1] + xor32(lsum[1], lane);
        const float i0 = 1.f / l0, i1 = lam / l1;
        float ss = 0.f;
#pragma unroll
        for (int dt = 0; dt < 2; ++dt)
#pragma unroll
            for (int r = 0; r < 16; ++r) { const float o = O[0][dt][r] * i0 - O[1][dt][r] * i1; O[0][dt][r] = o; ss += o * o; }
        ss += xor32(ss, lane);
        const float rn = rsqrtf(ss * (1.f / 64.f) + 1e-6f) * (1.f - lam_init);
        bf16_t* yrow = Y + (size_t)qrow * D + 768 + h * 64;
        const float* gn = gnorm; asm volatile("" : "+s"(gn));
#pragma unroll
        for (int dt = 0; dt < 2; ++dt)
#pragma unroll
            for (int rg = 0; rg < 4; ++rg) {
                const int d0 = 32 * dt + 8 * rg + 4 * hh;
                const float4 g4 = *(const float4*)(gn + d0);
                uint2 w; w.x = pk_bf16(O[0][dt][4 * rg] * rn * g4.x, O[0][dt][4 * rg + 1] * rn * g4.y); w.y = pk_bf16(O[0][dt][4 * rg + 2] * rn * g4.z, O[0][dt][4 * rg + 3] * rn * g4.w);
                *(uint2*)(yrow + d0) = w;
            }
    }
}

__device__ __forceinline__ void wa_phase(bool with_ctx, const bf16_t* __restrict__ Qw, const bf16_t* __restrict__ Kw, const bf16_t* __restrict__ VwT,
                                         const float* __restrict__ KMAXWl, const float* __restrict__ sinkl, bf16_t* __restrict__ Y,
                                         LAS unsigned char* lds, int bid, int G, int tid) {
    const int lane = tid & 63, wave = __builtin_amdgcn_readfirstlane(tid >> 6);
    const int ql = lane & 31, hh = lane >> 5;
    const int nitems = 256 + (with_ctx ? 8 : 0);
    for (int it = bid; it < nitems; it += G) {
        int b, hkv, qrow0, pos0, tlo, nloc;
        if (it < 256) { b = it >> 7; hkv = (it >> 6) & 1; const int qb = it & 63; qrow0 = b * SEQ + qb * 128; pos0 = qb * 128;
            tlo = 2 * qb - 2 < 0 ? 0 : 2 * qb - 2; const int thi = 2 * qb + 3 > SEQ / 64 - 1 ? SEQ / 64 - 1 : 2 * qb + 3; nloc = thi - tlo + 1; }
        else { const int j = it - 256; b = j >> 2; hkv = (j >> 1) & 1; qrow0 = NLAT + b * CTX + (j & 1) * 128; pos0 = 0; tlo = 0; nloc = 0; }
        const int ntile = nloc + CTX / 64;
        const int hq = hkv * 4 + (wave & 3), rg0 = wave >> 2;
        const float sink2 = sinkl[hq] * 1.4426950408889634f;
        bf16x8 qf[2][4]; float cinit[2]; int qrow[2], qpos[2];
#pragma unroll
        for (int tk = 0; tk < 2; ++tk) {
            qrow[tk] = qrow0 + (rg0 + 2 * tk) * 32 + ql; qpos[tk] = pos0 + (rg0 + 2 * tk) * 32 + ql;
            float q2 = 0.f;
#pragma unroll
            for (int s = 0; s < 4; ++s) {
                const uint4 raw = *(const uint4*)(Qw + (size_t)qrow[tk] * 512 + hq * 64 + s * 16 + hh * 8);
                qf[tk][s] = __builtin_bit_cast(bf16x8, raw);
                const unsigned w[4] = {raw.x, raw.y, raw.z, raw.w};
#pragma unroll
                for (int e = 0; e < 4; ++e) { const float lo = __uint_as_float(w[e] << 16), hi = __uint_as_float(w[e] & 0xffff0000u); q2 += lo * lo + hi * hi; }
            }
            q2 += xor32(q2, lane);
            cinit[tk] = -fmaxf(sqrtf(q2) * sqrtf(KMAXWl[b * 4 + hkv * 2] + KMAXWl[b * 4 + hkv * 2 + 1]) * 1.01f + 1e-3f, sink2);
        }
        f32x16 O[2][2];
#pragma unroll
        for (int tk = 0; tk < 2; ++tk)
#pragma unroll
            for (int dt = 0; dt < 2; ++dt)
#pragma unroll
                for (int r = 0; r < 16; ++r) O[tk][dt][r] = 0.f;
        float lsum[2] = {0.f, 0.f};
        const int srow = tid >> 3, sch = tid & 7;
        const bf16_t* vsrc = VwT + ((size_t)(b * 2 + hkv) * 64 + srow) * NKEY + sch * 8;
        const int soff = srow * DA_ROWB + sch * 16;
#define WKT(i) ((i) < nloc ? tlo + (i) : SEQ / 64 + ((i) - nloc))
#define WKROW(kt) ((kt) < SEQ / 64 ? b * SEQ + (kt) * 64 : NLAT + b * CTX + ((kt) - SEQ / 64) * 64)
        {
            const int kt = WKT(0);
            const uint4 kv = *(const uint4*)(Kw + (size_t)(WKROW(kt) + srow) * 128 + hkv * 64 + sch * 8);
            const uint4 vv = *(const uint4*)(vsrc + (size_t)kt * 64);
            *(LAS u32x4v*)(lds + soff) = (u32x4v){kv.x, kv.y, kv.z, kv.w}; *(LAS u32x4v*)(lds + DA_TILEB + soff) = (u32x4v){vv.x, vv.y, vv.z, vv.w};
        }
        __syncthreads();
        int cur = 0;
        for (int ti = 0; ti < ntile; ++ti) {
            const int kt = WKT(ti);
            uint4 kv = make_uint4(0, 0, 0, 0), vv = make_uint4(0, 0, 0, 0);
            const bool more = ti + 1 < ntile;
            if (more) { const int kn = WKT(ti + 1); kv = *(const uint4*)(Kw + (size_t)(WKROW(kn) + srow) * 128 + hkv * 64 + sch * 8); vv = *(const uint4*)(vsrc + (size_t)kn * 64); }
            const LAS unsigned char* kb = lds + cur * 2 * DA_TILEB;
            const LAS unsigned char* vb = kb + DA_TILEB;
            const bool local = kt < SEQ / 64;
#pragma unroll
            for (int sub = 0; sub < 2; ++sub) {
                const int k0 = kt * 64 + sub * 32;
                bf16x8 vf[2][2], kf[4];
#pragma unroll
                for (int dt = 0; dt < 2; ++dt)
#pragma unroll
                    for (int s = 0; s < 2; ++s) vf[dt][s] = *(const LAS bf16x8*)(vb + (dt * 32 + ql) * DA_ROWB + (sub * 32 + s * 16 + hh * 8) * 2);
#pragma unroll
                for (int s = 0; s < 4; ++s) kf[s] = *(const LAS bf16x8*)(kb + (sub * 32 + ql) * DA_ROWB + s * 32 + hh * 16);
#pragma unroll
                for (int tk = 0; tk < 2; ++tk) {
                    bool needmask = false;
                    if (local) { const int r0 = pos0 + (rg0 + 2 * tk) * 32;
                        if (k0 + 31 < r0 - 128 || k0 > r0 + 31 + 128) continue;
                        needmask = !(k0 >= r0 + 31 - 128 && k0 + 31 <= r0 + 128); }
                    f32x16 S;
#pragma unroll
                    for (int r = 0; r < 16; ++r) S[r] = cinit[tk];
#pragma unroll
                    for (int s = 0; s < 4; ++s) S = __builtin_amdgcn_mfma_f32_32x32x16_bf16(kf[s], qf[tk][s], S, 0, 0, 0);
                    float pe[16]; float ls = 0.f;
#pragma unroll
                    for (int r = 0; r < 16; ++r) pe[r] = __builtin_amdgcn_exp2f(S[r]);
                    if (needmask) {
                        int dbase = qpos[tk] - k0 - 4 * hh + 128; asm volatile("" : "+v"(dbase));
#pragma unroll
                        for (int r = 0; r < 16; ++r) { const unsigned dk = (unsigned)(dbase - ((r & 3) + 8 * (r >> 2))); pe[r] = dk <= 256u ? pe[r] : 0.f; } }
#pragma unroll
                    for (int r = 0; r < 16; ++r) ls += pe[r];
                    lsum[tk] += ls;
                    bf16x8 pf[2];
#pragma unroll
                    for (int s = 0; s < 2; ++s) {
                        uint4 w; w.x = pk_bf16(pe[8 * s], pe[8 * s + 1]); w.y = pk_bf16(pe[8 * s + 2], pe[8 * s + 3]); w.z = pk_bf16(pe[8 * s + 4], pe[8 * s + 5]); w.w = pk_bf16(pe[8 * s + 6], pe[8 * s + 7]);
                        pf[s] = __builtin_bit_cast(bf16x8, w);
                    }
#pragma unroll
                    for (int dt = 0; dt < 2; ++dt)
#pragma unroll
                        for (int s = 0; s < 2; ++s) O[tk][dt] = __builtin_amdgcn_mfma_f32_32x32x16_bf16(vf[dt][s], pf[s], O[tk][dt], 0, 0, 0);
                }
            }
            if (more) { LAS unsigned char* nb = lds + (cur ^ 1) * 2 * DA_TILEB; *(LAS u32x4v*)(nb + soff) = (u32x4v){kv.x, kv.y, kv.z, kv.w}; *(LAS u32x4v*)(nb + DA_TILEB + soff) = (u32x4v){vv.x, vv.y, vv.z, vv.w}; }
            __syncthreads();
            cur ^= 1;
        }
#undef WKT
#undef WKROW
#pragma unroll
        for (int tk = 0; tk < 2; ++tk) {
            const float lt = lsum[tk] + xor32(lsum[tk], lane) + __builtin_amdgcn_exp2f(sink2 + cinit[tk]);
            const float inv = 1.f / lt;
            bf16_t* yrow = Y + (size_t)qrow[tk] * D + 256 + hq * 64;
#pragma unroll
            for (int dt = 0; dt < 2; ++dt)
#pragma unroll
                for (int rg = 0; rg < 4; ++rg) {
                    const int d0 = 32 * dt + 8 * rg + 4 * hh;
                    uint2 w; w.x = pk_bf16(O[tk][dt][4 * rg] * inv, O[tk][dt][4 * rg + 1] * inv); w.y = pk_bf16(O[tk][dt][4 * rg + 2] * inv, O[tk][dt][4 * rg + 3] * inv);
                    *(uint2*)(yrow + d0) = w;
                }
        }
    }
}

#ifndef REP_EPI
#define REP_EPI 1
#endif
struct EpiInProj {
    static constexpr bool PERM = false, AFTER_DRAIN = false; static constexpr int REPS = REP_EPI;
    float* __restrict__ HT; float* __restrict__ PC; bf16_t* __restrict__ Qw; bf16_t* __restrict__ Kw; bf16_t* __restrict__ VwT; bf16_t* __restrict__ Qd; bf16_t* __restrict__ Kd; bf16_t* __restrict__ VdT; const unsigned* __restrict__ TABH; unsigned* __restrict__ KMX; int l;
    __device__ __forceinline__ void operator()(const pg8::f32x4 (&acc)[2][2][4][2], const pg8::Unit& u, int wr, int wc, int fr_in, int fq_in) const {
        using pg8::f32x4;
        int fr = fr_in, fq = fq_in; asm volatile("" : "+v"(fr), "+v"(fq));
        const int pn = u.pn, pm = u.pm;
        const bool lat = pm < 64;
        const int b = lat ? (pm >> 5) : (pm - 64);
        const int t0 = (lat ? (pm & 31) * 256 : 0) + wr * 64 + fr;
        const int grow0 = pm * 256 + wr * 64 + fr;
        const int lane = fq * 16 + fr;
        const float QSCW = 0.125f * 1.4426950408889634f, QSCD = 0.17677669529663687f * 1.4426950408889634f;
        if (pn < 3) {
            if (lat) {
#pragma unroll
                for (int bj = 0; bj < 2; ++bj)
#pragma unroll
                    for (int n = 0; n < 2; ++n) { float* hp = HT + (size_t)(pn * 256 + bj * 128 + wc * 32 + n * 16 + fq * 4) * HTP + grow0;
#pragma unroll
                        for (int ai = 0; ai < 2; ++ai)
#pragma unroll
                            for (int m = 0; m < 4; ++m) { const f32x4 v = acc[ai][bj][m][n]; float* q = hp + ai * 128 + m * 16;
                                q[0] = v[0]; q[HTP] = v[1]; q[2 * (size_t)HTP] = v[2]; q[3 * (size_t)HTP] = v[3]; } }
            } else {
#pragma unroll
                for (int ai = 0; ai < 2; ++ai)
#pragma unroll
                    for (int m = 0; m < 4; ++m) { float* rp = PC + (size_t)(grow0 - NLAT + ai * 128 + m * 16) * 768 + pn * 256 + wc * 32 + fq * 4;
#pragma unroll
                        for (int bj = 0; bj < 2; ++bj)
#pragma unroll
                            for (int n = 0; n < 2; ++n) *(f32x4*)(rp + bj * 128 + n * 16) = acc[ai][bj][m][n]; }
            }
        } else if (pn < 5 || (pn == 5)) {
            float kmx = 0.f;
            const int halfw = wc & 1;
            pg8::u32x4 cw[4];
#pragma unroll
            for (int i = 0; i < 4; ++i) { const int pos = lat ? (halfw ? ((t0 + 16 * i) & 63) : ((t0 + 128 * (i & 1)) >> 6)) : 0;
                cw[i] = *(const pg8::u32x4*)(TABH + pos * 24 + fq * 4); }
#pragma unroll
            for (int bj = 0; bj < 2; ++bj) {
                const int g32 = bj * 4 + wc;
                if (pn == 5 && bj == 1) {
                    const int pf = fr < 4 ? fr : (fr < 8 ? fr + 4 : (fr < 12 ? fr - 4 : fr));
                    const int kbase = (lat ? (pm & 31) * 256 : SEQ) + wr * 64 + pf;
#pragma unroll
                    for (int n = 0; n < 2; ++n)
#pragma unroll
                        for (int j = 0; j < 4; ++j) { bf16_t* vp = VwT + ((size_t)(b * 2 + (wc >> 1)) * 64 + (wc & 1) * 32 + n * 16 + fq * 4 + j) * NKEY + kbase;
#pragma unroll
                            for (int ai = 0; ai < 2; ++ai)
#pragma unroll
                                for (int m = 0; m < 4; ++m) vp[ai * 128 + m * 16] = f2bf(acc[ai][bj][m][n][j]); }
                } else {
                    const int half = g32 & 1;
#pragma unroll
                    for (int ai = 0; ai < 2; ++ai)
#pragma unroll
                        for (int m = 0; m < 4; ++m) {
                            const pg8::u32x4 ce = halfw ? cw[m] : cw[ai];
                            const f32x4 x1 = acc[ai][bj][m][0], x2 = acc[ai][bj][m][1];
                            const float cs[4] = {h2lo(ce.x), h2lo(ce.y), h2lo(ce.z), h2lo(ce.w)}, sn[4] = {h2hi(ce.x), h2hi(ce.y), h2hi(ce.z), h2hi(ce.w)};
                            float y1[4], y2[4];
#pragma unroll
                            for (int j = 0; j < 4; ++j) { y1[j] = x1[j] * cs[j] - x2[j] * sn[j]; y2[j] = x2[j] * cs[j] + x1[j] * sn[j]; }
                            const size_t grow = (size_t)(grow0 + ai * 128 + m * 16);
                            if (pn < 5) { bf16_t* qp = Qw + grow * 512 + ((pn - 3) * 4 + (g32 >> 1)) * 64 + half * 32 + fq * 4;
                                uint2 w1, w2; w1.x = pk_bf16(y1[0] * QSCW, y1[1] * QSCW); w1.y = pk_bf16(y1[2] * QSCW, y1[3] * QSCW); w2.x = pk_bf16(y2[0] * QSCW, y2[1] * QSCW); w2.y = pk_bf16(y2[2] * QSCW, y2[3] * QSCW);
                                *(uint2*)qp = w1; *(uint2*)(qp + 16) = w2; }
                            else { bf16_t* kp = Kw + grow * 128 + (wc >> 1) * 64 + half * 32 + fq * 4;
                                uint2 w1, w2; w1.x = pk_bf16(y1[0], y1[1]); w1.y = pk_bf16(y1[2], y1[3]); w2.x = pk_bf16(y2[0], y2[1]); w2.y = pk_bf16(y2[2], y2[3]);
                                *(uint2*)kp = w1; *(uint2*)(kp + 16) = w2;
                                float sq = 0.f;
#pragma unroll
                                for (int j = 0; j < 4; ++j) sq += y1[j] * y1[j] + y2[j] * y2[j];
                                sq += swzx<16>(sq); sq += xor32(sq, lane);
                                kmx = fmaxf(kmx, sq); }
                            __builtin_amdgcn_sched_barrier(0);
                        }
                }
            }
            if (pn == 5) {
                kmx = fmaxf(kmx, swzx<1>(kmx)); kmx = fmaxf(kmx, swzx<2>(kmx)); kmx = fmaxf(kmx, swzx<4>(kmx)); kmx = fmaxf(kmx, swzx<8>(kmx));
                if (lane == 0) atomicMax(KMX + 32 + l * 8 + b * 4 + wc, __float_as_uint(kmx));
            }
        } else if (pn < 8) {
            const int hi = fq >> 1;
            float kmx[2] = {0.f, 0.f};
            pg8::u32x4 ca[2], cm[4];
#pragma unroll
            for (int ai = 0; ai < 2; ++ai) { const int pos = lat ? ((t0 + ai * 128) >> 6) : 0; ca[ai] = *(const pg8::u32x4*)(TABH + pos * 24 + 16 + (fq & 1) * 4); }
#pragma unroll
            for (int m = 0; m < 4; ++m) { const int pos = lat ? ((t0 + m * 16) & 63) : 0; cm[m] = *(const pg8::u32x4*)(TABH + pos * 24 + 16 + (fq & 1) * 4); }
#pragma unroll
            for (int bj = 0; bj < 2; ++bj) {
                const int g32 = bj * 4 + wc;
#pragma unroll
                for (int ai = 0; ai < 2; ++ai)
#pragma unroll
                    for (int m = 0; m < 4; ++m) {
                        const size_t grow = (size_t)(grow0 + ai * 128 + m * 16);
                        float sq = 0.f;
#pragma unroll
                        for (int n = 0; n < 2; ++n) {
                            const pg8::u32x4 ce = n ? cm[m] : ca[ai];
                            const float cs[4] = {h2lo(ce.x), h2lo(ce.y), h2lo(ce.z), h2lo(ce.w)}, sn[4] = {h2hi(ce.x), h2hi(ce.y), h2hi(ce.z), h2hi(ce.w)};
                            const f32x4 own = acc[ai][bj][m][n];
                            float y[4];
#pragma unroll
                            for (int j = 0; j < 4; ++j) { const float oth = xor32(own[j], lane); y[j] = hi ? (own[j] * cs[j] + oth * sn[j]) : (own[j] * cs[j] - oth * sn[j]); sq += y[j] * y[j]; }
                            const float scl = pn == 6 ? QSCD : 1.f;
                            bf16_t* dp = (pn == 6 ? Qd : Kd) + grow * 256 + g32 * 32 + n * 16 + fq * 4;
                            uint2 w; w.x = pk_bf16(y[0] * scl, y[1] * scl); w.y = pk_bf16(y[2] * scl, y[3] * scl);
                            *(uint2*)dp = w;
                        }
                        if (pn == 7) { sq += swzx<16>(sq); sq += xor32(sq, lane); kmx[bj] = fmaxf(kmx[bj], sq); }
                        __builtin_amdgcn_sched_barrier(0);
                    }
            }
            if (pn == 7) {
#pragma unroll
                for (int bj = 0; bj < 2; ++bj) { float k = kmx[bj];
                    k = fmaxf(k, swzx<1>(k)); k = fmaxf(k, swzx<2>(k)); k = fmaxf(k, swzx<4>(k)); k = fmaxf(k, swzx<8>(k));
                    if (lane == 0) atomicMax(KMX + l * 16 + b * 8 + bj * 4 + wc, __float_as_uint(k)); }
            }
        } else {
            const int pf = fr < 4 ? fr : (fr < 8 ? fr + 4 : (fr < 12 ? fr - 4 : fr));
            const int kbase = (lat ? (pm & 31) * 256 : SEQ) + wr * 64 + pf;
#pragma unroll
            for (int bj = 0; bj < 2; ++bj) { const int g32 = bj * 4 + wc;
#pragma unroll
                for (int n = 0; n < 2; ++n)
#pragma unroll
                    for (int j = 0; j < 4; ++j) { bf16_t* vp = VdT + ((size_t)(b * 4 + (g32 >> 1)) * 64 + (g32 & 1) * 32 + n * 16 + fq * 4 + j) * NKEY + kbase;
#pragma unroll
                        for (int ai = 0; ai < 2; ++ai)
#pragma unroll
                            for (int m = 0; m < 4; ++m) vp[ai * 128 + m * 16] = f2bf(acc[ai][bj][m][n][j]); } }
        }
    }
};

static constexpr float CT32[32] = {1.f, 0.98078528f, 0.923879533f, 0.831469612f, 0.707106781f, 0.555570233f, 0.382683432f, 0.195090322f, 0.f, -0.195090322f, -0.382683432f, -0.555570233f,
    -0.707106781f, -0.831469612f, -0.923879533f, -0.98078528f, -1.f, -0.98078528f, -0.923879533f, -0.831469612f, -0.707106781f, -0.555570233f, -0.382683432f, -0.195090322f, 0.f, 0.195090322f,
    0.382683432f, 0.555570233f, 0.707106781f, 0.831469612f, 0.923879533f, 0.98078528f};
__host__ __device__ constexpr int br5(int i) { return ((i & 1) << 4) | ((i & 2) << 2) | (i & 4) | ((i & 8) >> 2) | ((i & 16) >> 4); }
__host__ __device__ constexpr int br4(int i) { return ((i & 1) << 3) | ((i & 2) << 1) | ((i & 4) >> 1) | ((i & 8) >> 3); }
template <int R, bool INV, int OFF> __device__ __forceinline__ void fft_dif(float (&re)[32], float (&im)[32]) {
#pragma unroll
    for (int len = R; len >= 2; len >>= 1) {
        const int half = len >> 1, step = 32 / len;
#pragma unroll
        for (int base = 0; base < R; base += len) {
#pragma unroll
            for (int j = 0; j < half; ++j) {
                const int a = OFF + base + j, b = a + half;
                const float ar = re[a], ai = im[a], br = re[b], bi = im[b];
                re[a] = ar + br; im[a] = ai + bi;
                const float dr = ar - br, di = ai - bi;
                const float c = CT32[(j * step) & 31], s0 = CT32[(j * step + 24) & 31];
                const float s = INV ? s0 : -s0;
                re[b] = dr * c - di * s; im[b] = dr * s + di * c;
            }
        }
    }
}
template <int R, bool INV, int OFF> __device__ __forceinline__ void fft_dit(float (&re)[32], float (&im)[32]) {
#pragma unroll
    for (int len = 2; len <= R; len <<= 1) {
        const int half = len >> 1, step = 32 / len;
#pragma unroll
        for (int base = 0; base < R; base += len) {
#pragma unroll
            for (int j = 0; j < half; ++j) {
                const int a = OFF + base + j, b = a + half;
                const float c = CT32[(j * step) & 31], s0 = CT32[(j * step + 24) & 31];
                const float s = INV ? s0 : -s0;
                const float tr = re[b] * c - im[b] * s, ti = re[b] * s + im[b] * c;
                const float ar = re[a], ai = im[a];
                re[a] = ar + tr; im[a] = ai + ti; re[b] = ar - tr; im[b] = ai - ti;
            }
        }
    }
}
constexpr int FFT_L1P = 528;
constexpr int FFT_LDS_BYTES = 1024 * 17 * 8;
__device__ __forceinline__ void fft16k_fwd(float (&re)[32], float (&im)[32], LAS f32x2v* L, const float2* __restrict__ TW, int tid_in) {
    int tid = tid_in; asm volatile("" : "+v"(tid));
    fft_dif<32, false, 0>(re, im);
    { const float2 w = TW[16 * (tid >> 4)]; float pr = 1.f, pi = 0.f;
#pragma unroll
      for (int k = 0; k < 32; ++k) { const int idx = br5(k); const float xr = re[idx], xi = im[idx];
          re[idx] = xr * pr - xi * pi; im[idx] = xr * pi + xi * pr;
          const float npr = pr * w.x + pi * w.y, npi = pi * w.x - pr * w.y; pr = npr; pi = npi; } }
    __syncthreads();
#pragma unroll
    for (int i = 0; i < 32; ++i) L[br5(i) * FFT_L1P + tid] = (f32x2v){re[i], im[i]};
    __syncthreads();
    asm volatile("" : "+v"(tid));
    const int k1 = tid >> 4, n3 = tid & 15;
#pragma unroll
    for (int n2 = 0; n2 < 32; ++n2) { const f32x2v v = L[k1 * FFT_L1P + n2 * 16 + n3]; re[n2] = v.x; im[n2] = v.y; }
    __syncthreads();
    fft_dif<32, false, 0>(re, im);
    { const float2 b0 = TW[n3 * k1], st = TW[32 * n3]; float pr = b0.x, pi = -b0.y;
#pragma unroll
      for (int k = 0; k < 32; ++k) { const int idx = br5(k); const float xr = re[idx], xi = im[idx];
          re[idx] = xr * pr - xi * pi; im[idx] = xr * pi + xi * pr;
          const float npr = pr * st.x + pi * st.y, npi = pi * st.x - pr * st.y; pr = npr; pi = npi; } }
#pragma unroll
    for (int i = 0; i < 32; ++i) L[(k1 * 32 + br5(i)) * 17 + n3] = (f32x2v){re[i], im[i]};
    __syncthreads();
#pragma unroll
    for (int h = 0; h < 2; ++h)
#pragma unroll
        for (int j = 0; j < 16; ++j) { const f32x2v v = L[(tid + 512 * h) * 17 + j]; re[16 * h + j] = v.x; im[16 * h + j] = v.y; }
    fft_dif<16, false, 0>(re, im);
    fft_dif<16, false, 16>(re, im);
}
__device__ __forceinline__ void fft16k_inv(float (&re)[32], float (&im)[32], LAS f32x2v* L, const float2* __restrict__ TW, int tid_in) {
    int tid = tid_in; asm volatile("" : "+v"(tid));
    fft_dit<16, true, 0>(re, im);
    fft_dit<16, true, 16>(re, im);
#pragma unroll
    for (int h = 0; h < 2; ++h) { const int pr_ = tid + 512 * h; const float2 st = TW[(pr_ >> 5) + 32 * (pr_ & 31)]; float pr = 1.f, pi = 0.f;
#pragma unroll
        for (int j = 0; j < 16; ++j) { const float xr = re[16 * h + j], xi = im[16 * h + j];
            re[16 * h + j] = xr * pr - xi * pi; im[16 * h + j] = xr * pi + xi * pr;
            const float npr = pr * st.x - pi * st.y, npi = pi * st.x + pr * st.y; pr = npr; pi = npi; } }
    __syncthreads();
#pragma unroll
    for (int h = 0; h < 2; ++h)
#pragma unroll
        for (int j = 0; j < 16; ++j) L[(tid + 512 * h) * 17 + j] = (f32x2v){re[16 * h + j], im[16 * h + j]};
    __syncthreads();
    asm volatile("" : "+v"(tid));
    const int k1 = tid >> 4, n3 = tid & 15;
#pragma unroll
    for (int i = 0; i < 32; ++i) { const f32x2v v = L[(k1 * 32 + br5(i)) * 17 + n3]; re[i] = v.x; im[i] = v.y; }
    __syncthreads();
    fft_dit<32, true, 0>(re, im);
    { const float2 st = TW[16 * k1]; float pr = 1.f, pi = 0.f;
#pragma unroll
      for (int n2 = 0; n2 < 32; ++n2) { const float xr = re[n2], xi = im[n2];
          re[n2] = xr * pr - xi * pi; im[n2] = xr * pi + xi * pr;
          const float npr = pr * st.x - pi * st.y, npi = pi * st.x + pr * st.y; pr = npr; pi = npi; } }
#pragma unroll
    for (int n2 = 0; n2 < 32; ++n2) L[k1 * FFT_L1P + n2 * 16 + n3] = (f32x2v){re[n2], im[n2]};
    __syncthreads();
#pragma unroll
    for (int i = 0; i < 32; ++i) { const f32x2v v = L[br5(i) * FFT_L1P + tid]; re[i] = v.x; im[i] = v.y; }
    fft_dit<32, true, 0>(re, im);
}
template <bool COS> __device__ __forceinline__ float hy_sincos(float x) {
    const float k = rintf(x * 0.63661977236758134f);
    float r = fmaf(k, -1.5703125f, x); r = fmaf(k, -4.837512969970703125e-4f, r); r = fmaf(k, -7.54978995489188216e-8f, r);
    const int q = (int)k + (COS ? 1 : 0);
    const float z = r * r;
    const float sp = fmaf(fmaf(fmaf(-1.9515295891e-4f, z, 8.3321608736e-3f), z, -1.6666654611e-1f) * z, r, r);
    const float cp = fmaf(fmaf(fmaf(2.443315711809948e-5f, z, -1.388731625493765e-3f), z, 4.166664568298827e-2f) * z, z, fmaf(-0.5f, z, 1.f));
    const float v = (q & 1) ? cp : sp;
    return (q & 2) ? -v : v;
}
template <int NP>
__device__ __forceinline__ void hy_filter_z2(const float* __restrict__ w1, const float* __restrict__ b1, const float* __restrict__ fr, const float* __restrict__ w2,
                                             const float* __restrict__ b2, int n, int t0, int lane, float (&z2)[NP]) {
    const float fq = fr[lane];
    float fe[NP], a1[NP], a2[NP], z1[NP];
#pragma unroll
    for (int q = 0; q < NP; ++q) {
        const int t = t0 + q;
        const float tt = (float)t / (float)(n - 1);
        fe[q] = 0.f;
        if (lane == 0) fe[q] = tt;
        else if (lane <= 32) {
            const int j = (lane - 1) & 15;
            const float band = 1e-4f + (float)j * ((15.f - 1e-4f) / 15.f);
            const float ph = ((float)(6.283185307179586 / (double)n) * (float)t) * band;
            fe[q] = lane <= 16 ? hy_sincos<true>(ph) : -hy_sincos<false>(ph);
        }
        a1[q] = b1[lane]; a2[q] = b2[lane];
    }
#pragma unroll
    for (int e = 0; e < 33; ++e) { const float w = w1[e * 64 + lane];
#pragma unroll
        for (int q = 0; q < NP; ++q) a1[q] += rdlane(fe[q], e) * w; }
#pragma unroll
    for (int q = 0; q < NP; ++q) z1[q] = hy_sincos<false>(fq * a1[q]);
#pragma unroll 16
    for (int i = 0; i < 64; ++i) { const float w = w2[i * 64 + lane];
#pragma unroll
        for (int q = 0; q < NP; ++q) a2[q] += rdlane(z1[q], i) * w; }
#pragma unroll
    for (int q = 0; q < NP; ++q) z2[q] = hy_sincos<false>(fq * a2[q]);
}

__device__ __forceinline__ void hyena_fft_phase(int l, const float* __restrict__ HT, const float* __restrict__ HFTl, const float2* __restrict__ TW, const float* __restrict__ cw,
                                                const float* __restrict__ cb, const float* __restrict__ hy_bias_l, bf16_t* __restrict__ YhT, float* ZT, float2* HS, LAS f32x2v* L, int bid, int G, int tid) {
    for (int c = bid; c < 256; c += G) {
        float re[32], im[32];
        float2* hs = HS + (size_t)bid * 32 * 512;
        float* z0 = ZT + (size_t)c * HTP; float* z1 = z0 + SEQ;
#pragma unroll 1
        for (int o = 0; o < 2; ++o) {
            int tq = tid; asm volatile("" : "+v"(tq));
            { const float* hf = HFTl + (size_t)((o * 2 + 0) * 256 + c) * HFP; const float* hb = HFTl + (size_t)((o * 2 + 1) * 256 + c) * HFP;
#pragma unroll
              for (int n1 = 0; n1 < 16; ++n1) { re[n1] = hf[512 * n1 + tq]; im[n1] = 0.f; }
              if (tq == 0) re[0] += hy_bias_l[o * 256 + c];
#pragma unroll
              for (int n1 = 16; n1 < 32; ++n1) { const int m = 16384 - (512 * n1 + tq); re[n1] = (m == 8192) ? 0.f : hb[m & 8191]; im[n1] = 0.f; } }
            fft16k_fwd(re, im, L, TW, tid);
#pragma unroll
            for (int i = 0; i < 32; ++i) hs[i * 512 + tq] = make_float2(re[i] * (1.f / 16384.f), im[i] * (1.f / 16384.f));
            asm volatile("" : "+v"(tq));
            if (o == 0) {
                const int col = 512 + c; const float w0 = cw[col], w1 = cw[768 + col], w2 = cw[1536 + col], bb = cb[col];
                const float* h0 = HT + (size_t)col * HTP; const float* h1 = h0 + SEQ;
#pragma unroll
                for (int n1 = 0; n1 < 16; ++n1) { const int t = 512 * n1 + tq;
                    float a = bb + w1 * h0[t], b = bb + w1 * h1[t];
                    if (t > 0) { a += w0 * h0[t - 1]; b += w0 * h1[t - 1]; }
                    if (t < SEQ - 1) { a += w2 * h0[t + 1]; b += w2 * h1[t + 1]; }
                    re[n1] = a; im[n1] = b; }
            } else {
#pragma unroll
                for (int n1 = 0; n1 < 16; ++n1) { re[n1] = z0[512 * n1 + tq]; im[n1] = z1[512 * n1 + tq]; }
            }
#pragma unroll
            for (int n1 = 16; n1 < 32; ++n1) { re[n1] = 0.f; im[n1] = 0.f; }
            fft16k_fwd(re, im, L, TW, tid);
            asm volatile("" : "+v"(tq));
#pragma unroll
            for (int i = 0; i < 32; ++i) { const float2 hv = hs[i * 512 + tq]; const float a = re[i], b = im[i]; re[i] = a * hv.x - b * hv.y; im[i] = a * hv.y + b * hv.x; }
            fft16k_inv(re, im, L, TW, tid);
            asm volatile("" : "+v"(tq));
            { const int col = o * 256 + c; const float w0 = cw[col], w1 = cw[768 + col], w2 = cw[1536 + col], bb = cb[col];
              const float* h0 = HT + (size_t)col * HTP; const float* h1 = h0 + SEQ;
#pragma unroll
              for (int n1 = 0; n1 < 16; ++n1) { const int t = 512 * n1 + tq;
                  float a = bb + w1 * h0[t], b = bb + w1 * h1[t];
                  if (t > 0) { a += w0 * h0[t - 1]; b += w0 * h1[t - 1]; }
                  if (t < SEQ - 1) { a += w2 * h0[t + 1]; b += w2 * h1[t + 1]; }
                  const float ra = a * re[n1], rb = b * im[n1];
                  if (o == 0) { z0[t] = ra; z1[t] = rb; }
                  else { YhT[(size_t)c * NLAT + t] = f2bf(ra); YhT[(size_t)c * NLAT + SEQ + t] = f2bf(rb); } } }
        }
    }
}

__device__ __forceinline__ void hyena_ctx_fused(int l, const float* __restrict__ PC, const float* __restrict__ cw, const float* __restrict__ cb, bf16_t* __restrict__ Y,
                                                const float* __restrict__ Z2C, const float* __restrict__ w3, const float* __restrict__ dec, const float* __restrict__ hy_bias, float* ldsf, int bid, int G, int tid) {
    const int lane = tid & 63, c = __builtin_amdgcn_readfirstlane(tid >> 6);
    float* zb = ldsf;
    float* z1 = ldsf + 2048;
    float* comb = ldsf + 4096;
    for (int it = bid; it < 64; it += G) {
        const int s = it >> 5, c0 = (it & 31) * 8, rowbase = s * CTX;
        for (int idx = tid; idx < 2048; idx += NT) { const int t = idx >> 3, cc = idx & 7, col = 512 + c0 + cc;
            const float* pp = PC + (size_t)(rowbase + t) * 768 + col;
            float a = cb[col] + cw[768 + col] * pp[0];
            if (t > 0) a += cw[col] * pp[-768];
            if (t < CTX - 1) a += cw[1536 + col] * pp[768];
            zb[cc * 256 + t] = a; }
        float* w3s = ldsf + 4096 + 8192;
        float* z2s = w3s + 2048;
        for (int idx = tid; idx < 2048; idx += NT) { const int i = idx >> 5, q = idx & 31; w3s[idx] = w3[(size_t)i * 1024 + (q >> 3) * 256 + c0 + (q & 7)]; }
        for (int idx = tid; idx < 256 * 64; idx += NT) z2s[(idx >> 6) * 65 + (idx & 63)] = Z2C[idx];
        __syncthreads();
        for (int idx = tid; idx < 2 * 511 * 8; idx += NT) { const int cc = idx & 7, e = (idx >> 3) % 511, o = (idx >> 3) / 511, d = e - 255;
            const int ad = d >= 0 ? d : -d, q = (o * 2 + (d >= 0 ? 0 : 1)) * 8 + cc;
            float a = 0.f;
#pragma unroll 8
            for (int i = 0; i < 64; ++i) a += z2s[ad * 65 + i] * w3s[i * 32 + q];
            comb[(o * 8 + cc) * 512 + e] = a * expf(-((float)ad / (float)(CTX - 1)) * fabsf(dec[(q >> 3) * 256 + c0 + cc])); }
        __syncthreads();
#pragma unroll 1
        for (int o = 0; o < 2; ++o) {
            const float* zs = (o == 0 ? zb : z1) + c * 256;
            const float* cm = comb + (o * 8 + c) * 512 + 255 + lane;
            float acc[4] = {0.f, 0.f, 0.f, 0.f};
#pragma unroll 4
            for (int s2 = 0; s2 < CTX; ++s2) { const float zv = zs[s2];
#pragma unroll
                for (int k = 0; k < 4; ++k) acc[k] += cm[64 * k - s2] * zv; }
            const float bias = hy_bias[(l * 2 + o) * 256 + c0 + c];
            const int col = o * 256 + c0 + c; const float w0 = cw[col], w1 = cw[768 + col], w2 = cw[1536 + col], bb = cb[col];
#pragma unroll
            for (int k = 0; k < 4; ++k) { const int t = lane + 64 * k, row = rowbase + t;
                const float* pp = PC + (size_t)row * 768 + col;
                float gte = bb + w1 * pp[0];
                if (t > 0) gte += w0 * pp[-768];
                if (t < CTX - 1) gte += w2 * pp[768];
                const float res = gte * (acc[k] + bias * zs[t]);
                if (o == 0) z1[c * 256 + t] = res; else Y[(size_t)(NLAT + row) * D + c0 + c] = f2bf(res); }
            __syncthreads();
        }
    }
}

#define PK_CEX(a, b) do { const unsigned hi_ = (a) > (b) ? (a) : (b); const unsigned lo_ = (a) > (b) ? (b) : (a); (a) = hi_; (b) = lo_; } while (0)
__device__ __forceinline__ void sort16d(unsigned (&v)[16]) {
#pragma unroll
    for (int k = 2; k <= 16; k <<= 1)
#pragma unroll
        for (int j = k >> 1; j > 0; j >>= 1)
#pragma unroll
            for (int i = 0; i < 16; ++i) { const int l = i ^ j; if (l > i) { if ((i & k) == 0) PK_CEX(v[i], v[l]); else PK_CEX(v[l], v[i]); } }
}
__device__ __forceinline__ void merge16d(unsigned (&A)[16], const unsigned (&B)[16]) {
#pragma unroll
    for (int i = 0; i < 16; ++i) A[i] = A[i] > B[15 - i] ? A[i] : B[15 - i];
#pragma unroll
    for (int j = 8; j > 0; j >>= 1)
#pragma unroll
        for (int i = 0; i < 16; ++i) { const int l = i ^ j; if (l > i) PK_CEX(A[i], A[l]); }
}
constexpr int PK_PITCH = 272;
__device__ __forceinline__ void peer_top16(const bf16_t* __restrict__ qrow_p, const LAS unsigned char* Kl, int ql, int hh, int lane, unsigned (&L)[16]) {
    bf16x8 qf[8];
#pragma unroll
    for (int s = 0; s < 8; ++s) qf[s] = __builtin_bit_cast(bf16x8, *(const uint4*)(qrow_p + 16 * s + 8 * hh));
#pragma unroll
    for (int i = 0; i < 16; ++i) L[i] = 0u;
#pragma unroll 1
    for (int kt = 0; kt < 4; ++kt) {
        f32x16 S;
#pragma unroll
        for (int r = 0; r < 16; ++r) S[r] = 256.f;
        const LAS unsigned char* kp = Kl + (kt * 32 + ql) * PK_PITCH + 16 * hh;
#pragma unroll
        for (int s = 0; s < 8; ++s) { const bf16x8 kf = *(const LAS bf16x8*)(kp + 32 * s); S = __builtin_amdgcn_mfma_f32_32x32x16_bf16(kf, qf[s], S, 0, 0, 0); }
        unsigned T[16];
#pragma unroll
        for (int r = 0; r < 16; ++r) { const int key = kt * 32 + (r & 3) + 8 * (r >> 2) + 4 * hh; T[r] = (__float_as_uint(S[r]) & 0xffffff80u) | (unsigned)(127 - key); }
        sort16d(T);
        merge16d(L, T);
    }
    unsigned PL[16];
#pragma unroll
    for (int i = 0; i < 16; ++i) PL[i] = (unsigned)__builtin_amdgcn_ds_bpermute((lane ^ 32) << 2, (int)L[i]);
    merge16d(L, PL);
}
static constexpr int PEER_PA[16] = {2, 2, 2, 2, 2, 3, 3, 3, 3, 4, 4, 4, 5, 5, 6, 6};
static constexpr int PEER_PB[16] = {0, 1, 2, 3, 4, 0, 1, 2, 3, 0, 1, 2, 0, 1, 0, 1};
__device__ __forceinline__ unsigned peer_pairpk(unsigned p1, unsigned p2, int code) {
    const float sum = __uint_as_float(p1 & 0xffffff80u) + __uint_as_float(p2 & 0xffffff80u) - 256.f;
    return (__float_as_uint(sum) & 0xffffff00u) | (unsigned)(255 - code);
}
__device__ __forceinline__ void peer_route_phase(int Mrows, const bf16_t* __restrict__ Qb, const bf16_t* __restrict__ K16l, int* __restrict__ RIDX, float* __restrict__ RGATE, float* __restrict__ RSU, const float* __restrict__ SU,
                                                 LAS unsigned* ldsw, int bid_, int G_, int tid) {
    const int lane = tid & 63, wave = __builtin_amdgcn_readfirstlane(tid >> 6), ql = lane & 31, hh = lane >> 5;
    LAS unsigned* lw = ldsw + wave * 2048;
    const LAS unsigned char* kl = (const LAS unsigned char*)(ldsw + 8 * 2048);
    const int ntile = Mrows / 32, ngrp = ((ntile + 7) / 8) * 8;
    for (int grp = bid_; grp < ngrp; grp += G_) {
        const int h = grp & 7, tt = (grp >> 3) * 8 + wave;
        __syncthreads();
        for (int c = tid; c < 256 * 16; c += NT) { const int row = c >> 4, ch = c & 15;
            const uint4 v = *(const uint4*)(K16l + ((size_t)(h * 2) * 128 + row) * 128 + ch * 8);
            *(LAS u32x4v*)((LAS unsigned char*)kl + row * PK_PITCH + ch * 16) = (u32x4v){v.x, v.y, v.z, v.w}; }
        __syncthreads();
        if (tt < ntile) {
        const int token = tt * 32 + ql;
        unsigned L1[16], L2[16];
        peer_top16(Qb + (size_t)token * 2048 + h * 256, kl, ql, hh, lane, L1);
        peer_top16(Qb + (size_t)token * 2048 + h * 256 + 128, kl + 128 * PK_PITCH, ql, hh, lane, L2);
#pragma unroll
        for (int i = 0; i < 16; ++i) { lw[i * 64 + lane] = L1[i]; lw[1024 + i * 64 + lane] = L2[i]; }
        unsigned G0[16], G1[16], G2[16], G3[16];
#pragma unroll
        for (int b = 0; b < 16; ++b) G0[b] = peer_pairpk(L1[0], L2[b], b);
#pragma unroll
        for (int b = 0; b < 8; ++b) G1[b] = peer_pairpk(L1[1], L2[b], 16 + b);
#pragma unroll
        for (int a = 8; a < 16; ++a) G1[8 + (15 - a)] = peer_pairpk(L1[a], L2[0], a * 16);
#pragma unroll
        for (int j = 8; j > 0; j >>= 1)
#pragma unroll
            for (int i = 0; i < 16; ++i) { const int l2 = i ^ j; if (l2 > i) PK_CEX(G1[i], G1[l2]); }
#pragma unroll
        for (int n = 0; n < 16; ++n) G2[n] = peer_pairpk(L1[PEER_PA[n]], L2[PEER_PB[n]], PEER_PA[n] * 16 + PEER_PB[n]);
        G3[0] = peer_pairpk(L1[7], L2[0], 7 * 16); G3[1] = peer_pairpk(L1[7], L2[1], 7 * 16 + 1);
#pragma unroll
        for (int i = 2; i < 16; ++i) G3[i] = 0u;
        sort16d(G2);
        PK_CEX(G3[0], G3[1]);
        merge16d(G0, G1); merge16d(G2, G3); merge16d(G0, G2);
        float sc[16]; int ix[16]; float mx = -3.0e38f;
#pragma unroll
        for (int i = 0; i < 16; ++i) { const int code = 255 - (int)(G0[i] & 255u); const unsigned p1 = lw[(code >> 4) * 64 + lane], p2 = lw[1024 + (code & 15) * 64 + lane];
            sc[i] = __uint_as_float(p1 & 0xffffff80u) + __uint_as_float(p2 & 0xffffff80u) - 512.f; mx = fmaxf(mx, sc[i]);
            ix[i] = (127 - (int)(p1 & 127u)) * 128 + (127 - (int)(p2 & 127u)); }
        float sm = 0.f;
#pragma unroll
        for (int i = 0; i < 16; ++i) { sc[i] = __expf(sc[i] - mx); sm += sc[i]; }
        const float inv = 1.f / sm;
        int* ri = RIDX + (size_t)token * 128 + h * 16 + hh * 8; float* rg = RGATE + (size_t)token * 128 + h * 16 + hh * 8;
        int4 o0, o1; float4 g0, g1;
        o0.x = hh ? ix[8] : ix[0]; o0.y = hh ? ix[9] : ix[1]; o0.z = hh ? ix[10] : ix[2]; o0.w = hh ? ix[11] : ix[3];
        o1.x = hh ? ix[12] : ix[4]; o1.y = hh ? ix[13] : ix[5]; o1.z = hh ? ix[14] : ix[6]; o1.w = hh ? ix[15] : ix[7];
        const float* SV = SU + NEXP;
        g0.x = (hh ? sc[8] : sc[0]) * inv * SV[o0.x]; g0.y = (hh ? sc[9] : sc[1]) * inv * SV[o0.y]; g0.z = (hh ? sc[10] : sc[2]) * inv * SV[o0.z]; g0.w = (hh ? sc[11] : sc[3]) * inv * SV[o0.w];
        g1.x = (hh ? sc[12] : sc[4]) * inv * SV[o1.x]; g1.y = (hh ? sc[13] : sc[5]) * inv * SV[o1.y]; g1.z = (hh ? sc[14] : sc[6]) * inv * SV[o1.z]; g1.w = (hh ? sc[15] : sc[7]) * inv * SV[o1.w];
        float4 u0, u1; u0.x = SU[o0.x]; u0.y = SU[o0.y]; u0.z = SU[o0.z]; u0.w = SU[o0.w]; u1.x = SU[o1.x]; u1.y = SU[o1.y]; u1.z = SU[o1.z]; u1.w = SU[o1.w];
        float* ru = RSU + (size_t)token * 128 + h * 16 + hh * 8;
        *(int4*)ri = o0; *(int4*)(ri + 4) = o1; *(float4*)rg = g0; *(float4*)(rg + 4) = g1; *(float4*)ru = u0; *(float4*)(ru + 4) = u1;
        }
    }
}

typedef _Float16 f16x2v __attribute__((ext_vector_type(2)));
__device__ __forceinline__ float dot2h(unsigned a, unsigned b, float c) { return __builtin_amdgcn_fdot2(__builtin_bit_cast(f16x2v, a), __builtin_bit_cast(f16x2v, b), c, false); }
__device__ __forceinline__ unsigned pk_f16(float a, float b) { f16x2v v = {(_Float16)a, (_Float16)b}; return __builtin_bit_cast(unsigned, v); }
#ifndef TSEL_A
#define TSEL_A -1
#define TSEL_B -1
#define TSEL_C -1
#define TSEL_D -1
#endif
#ifndef REP_WA
#define REP_WA 1
#endif
#ifndef REP_ROUTE
#define REP_ROUTE 1
#endif
#ifndef REP_GATHER
#define REP_GATHER 1
#endif
#ifndef REP_DA
#define REP_DA 1
#endif
#ifndef REP_P0
#define REP_P0 1
#endif
#ifndef REP_P3A
#define REP_P3A 1
#endif
#ifndef REP_HY
#define REP_HY 1
#endif
#ifndef REP_GIN
#define REP_GIN 1
#endif
#ifndef REP_CVT
#define REP_CVT 1
#endif
constexpr size_t OFF_T16 = OFF_P + (size_t)72 * 1024 * 1024;
__global__ void __launch_bounds__(NT) mega(Params p) {
    extern __shared__ __attribute__((aligned(16))) unsigned char lds[];
    cg::grid_group grid = cg::this_grid();
    const int wave_s = __builtin_amdgcn_readfirstlane((int)threadIdx.x >> 6);
    volatile LAS unsigned* bst = (volatile LAS unsigned*)(lds + LDS_BAR_OFF);
    if (threadIdx.x < 4) bst[threadIdx.x] = 0u;
    __syncthreads();
    unsigned char* ws = p.ws;
    XcdBarrier xb = xcd_barrier_post((unsigned*)(ws + OFF_BAR), bst);
    const int G = gridDim.x, bid = blockIdx.x;
    const size_t gsz = (size_t)G * NT;
    const int nwaves = G * 8;
    float* ldsf = (float*)lds;
    int stamp_k = 0;
#define STAMP() do { if (TSEL_A >= 0) { if (bid == 0 && wave_s == 0) { unsigned long long* tsb = (unsigned long long*)(p.ws + 32768); const unsigned long long tnow = __builtin_amdgcn_s_memrealtime(); int lb_; asm volatile("v_mbcnt_lo_u32_b32 %0, -1, 0" : "=v"(lb_)); if (lb_ == 0) __hip_atomic_store(tsb + stamp_k, tnow, __ATOMIC_RELAXED, __HIP_MEMORY_SCOPE_AGENT); } ++stamp_k; } } while (0)
#define PH_VARS int tid; asm volatile("v_mbcnt_lo_u32_b32 %0, -1, 0\n\tv_mbcnt_hi_u32_b32 %0, -1, %0\n\tv_lshl_add_u32 %0, %1, 6, %0" : "=&v"(tid) : "s"(wave_s)); int zz = 0; asm volatile("" : "+s"(zz)); \
    const int lane = tid & 63, wave = __builtin_amdgcn_readfirstlane(tid >> 6); \
    const size_t gtid = (size_t)bid * NT + tid; const int gwave = bid * 8 + wave; (void)gtid; (void)gwave; (void)lane; \
    unsigned char* const wsl = p.ws + zz; \
    bf16_t* const X = (bf16_t*)(wsl + OFF_X); bf16_t* const Hb = (bf16_t*)(wsl + OFF_HB); float* const P = (float*)(wsl + OFF_P); float* const Q = (float*)(wsl + OFF_P); \
    float* const U = (float*)(wsl + OFF_U); float* const Z1 = (float*)(wsl + OFF_Z1); bf16_t* const Y = (bf16_t*)(wsl + OFF_Y); float* const HF = (float*)(wsl + OFF_HF); \
    float* const HFC = (float*)(wsl + OFF_HFC); bf16_t* const WinT = (bf16_t*)(wsl + OFF_WIN); bf16_t* const WoutT = (bf16_t*)(wsl + OFF_WOUT); bf16_t* const WqT = (bf16_t*)(wsl + OFF_WQ); \
    float* const MODP = (float*)(wsl + OFF_MODP); float* const MOD = (float*)(wsl + OFF_MOD); float* const TAB = (float*)(wsl + OFF_TAB); \
    bf16_t* const Qd = (bf16_t*)(wsl + OFF_QD); bf16_t* const Kd = (bf16_t*)(wsl + OFF_KD); bf16_t* const VdT = (bf16_t*)(wsl + OFF_VDT); float* const KMAX = (float*)(wsl + OFF_KMAX); float* const HT = (float*)(wsl + OFF_HT); bf16_t* const YhT = (bf16_t*)(wsl + OFF_YHT); float2* const TW = (float2*)(wsl + OFF_TW); float* const ZT = (float*)(wsl + OFF_ZT); (void)ZT; bf16_t* const Qw = (bf16_t*)(wsl + OFF_QW); bf16_t* const Kw = (bf16_t*)(wsl + OFF_KW); bf16_t* const VwT = (bf16_t*)(wsl + OFF_VWT); (void)Qw; (void)Kw; (void)VwT; bf16_t* const K16 = (bf16_t*)(wsl + OFF_K16); int* const RIDX = (int*)(wsl + OFF_RIDX); float* const RGATE = (float*)(wsl + OFF_RGATE); (void)K16; (void)RIDX; (void)RGATE; float* const RSU = (float*)(wsl + OFF_RSU); (void)RSU; \
    const float* const MODl = MOD + (size_t)l * 3 * 6144; const float* const HFl = HF + (size_t)l * HFP * 1024; (void)HT; (void)YhT; (void)TW; \
    (void)X; (void)Hb; (void)P; (void)Q; (void)U; (void)Z1; (void)Y; (void)HF; (void)HFC; (void)WinT; (void)WoutT; (void)WqT; (void)MODP; (void)MOD; (void)TAB; (void)Qd; (void)Kd; (void)VdT; (void)KMAX; (void)MODl; (void)HFl;
#define IN(k) (p.in[(k) + zz])

    STAMP();
    for (int rep0 = 0; rep0 < REP_P0; ++rep0) {
        const int l = 0; (void)l;
        PH_VARS
        __syncthreads();
        for (int l = 0; l < 2; ++l) {
            transpose_convert(IN(7) + (size_t)l * D * INC, WinT + (size_t)l * INC * D, D, INC, gtid, gsz);
            transpose_convert(IN(24) + (size_t)l * D * D, WoutT + (size_t)l * D * D, D, D, gtid, gsz);
            transpose_convert(IN(26) + (size_t)l * D * 2048, WqT + (size_t)l * 2048 * D, D, 2048, gtid, gsz);
        }
        for (int i = tid; i < 3 * D; i += NT) { const float cv = i < 2 * D ? IN(1)[i] : IN(3)[i - 2 * D]; ldsf[i] = cv / (1.f + expf(-cv)); }
        __syncthreads();
        for (size_t idx = gtid; idx < (size_t)16 * 2 * 6144; idx += gsz) {
            const int j = (int)(idx % 6144), l = (int)((idx / 6144) & 1), s = (int)(idx / 12288);
            const float* w = IN(4) + ((size_t)l * D + s * 64) * 6144 + j;
            float a0 = 0.f, a1 = 0.f, a2 = 0.f;
#pragma unroll 16
            for (int k = 0; k < 64; ++k) { const float wv = w[(size_t)k * 6144]; a0 += ldsf[s * 64 + k] * wv; a1 += ldsf[D + s * 64 + k] * wv; a2 += ldsf[2 * D + s * 64 + k] * wv; }
            float* o = MODP + ((size_t)(s * 2 + l) * 3) * 6144 + j;
            o[0] = a0; o[6144] = a1; o[2 * 6144] = a2;
        }
        if (gtid < 64) ((unsigned*)KMAX)[gtid] = 0u;
        for (size_t idx = gtid; idx < (size_t)2 * 16 * 128 * 128; idx += gsz) K16[idx] = f2bf(IN(27)[idx]);
        for (size_t idx = gtid; idx < 128 * 24; idx += gsz) {
            const int pos = (int)(idx / 24), f = (int)(idx % 24);
            const float inv = f < 16 ? powf(10000.f, -(float)(2 * f) / 32.f) : powf(10000.f, -(float)(2 * (f - 16)) / 16.f);
            const float ang = (float)pos * inv;
            ((unsigned*)TAB)[idx] = pk_f16(cosf(ang), sinf(ang));
        }
        for (size_t idx = gtid; idx < 16384; idx += gsz) { const float a = (float)idx * (1.f / 8192.f); TW[idx] = make_float2(cospif(a), sinpif(a)); }
        __syncthreads();
        for (int it = bid; it < 2 * (SEQ / 32); it += G) {
            const int l2 = it / (SEQ / 32), t0 = (it % (SEQ / 32)) * 32;
            const float* w3 = IN(15) + (size_t)l2 * 64 * 1024; const float* dec = IN(16) + (size_t)l2 * 1024;
            const int ql = lane & 31, kk = lane >> 5;
            const unsigned wlo = (unsigned)(8 * kk * 1024 + wave * 128 + ql);
            float* wl = ldsf + 4096;
            { const float* w1g = IN(10) + (size_t)l2 * 33 * 64; const float* w2g = IN(13) + (size_t)l2 * 64 * 64;
              float s1[5], s2[8], s3 = 0.f;
#pragma unroll
              for (int q = 0; q < 5; ++q) { const int i = tid + 512 * q; s1[q] = i < 33 * 64 ? w1g[i] : 0.f; }
#pragma unroll
              for (int q = 0; q < 8; ++q) s2[q] = w2g[tid + 512 * q];
              if (tid < 192) s3 = tid < 64 ? IN(11)[l2 * 64 + tid] : (tid < 128 ? IN(12)[l2 * 64 + tid - 64] : IN(14)[l2 * 64 + tid - 128]);
              float b8n[4][8];
#pragma unroll
              for (int c = 0; c < 4; ++c)
#pragma unroll
                  for (int j = 0; j < 8; ++j) b8n[c][j] = (w3 + (16 * c + j) * 1024)[wlo];
              __builtin_amdgcn_sched_barrier(0);
#pragma unroll
              for (int q = 0; q < 5; ++q) { const int i = tid + 512 * q; if (i < 33 * 64) wl[i] = s1[q]; }
#pragma unroll
              for (int q = 0; q < 8; ++q) wl[2240 + tid + 512 * q] = s2[q];
              if (tid < 128) wl[2112 + tid] = s3; else if (tid < 192) wl[6336 + tid - 128] = s3;
              __syncthreads();
              { float z2[4]; hy_filter_z2<4>(wl, wl + 2112, wl + 2176, wl + 2240, wl + 6336, SEQ, t0 + wave * 4, lane, z2);
#pragma unroll
                for (int q = 0; q < 4; ++q) ldsf[(wave * 4 + q) * 68 + lane] = z2[q]; }
              __syncthreads();
#define HF_SPLIT8(src, H, L) do { unsigned h_[4], l_[4]; _Pragma("unroll") for (int i_ = 0; i_ < 4; ++i_) { const float x0_ = (src)[2 * i_], x1_ = (src)[2 * i_ + 1]; h_[i_] = pk_bf16(x0_, x1_); \
                  l_[i_] = pk_bf16(x0_ - __uint_as_float(h_[i_] << 16), x1_ - __uint_as_float(h_[i_] & 0xffff0000u)); } \
                  H = __builtin_bit_cast(bf16x8, make_uint4(h_[0], h_[1], h_[2], h_[3])); L = __builtin_bit_cast(bf16x8, make_uint4(l_[0], l_[1], l_[2], l_[3])); } while (0)
              float dd[4];
#pragma unroll
              for (int nt = 0; nt < 4; ++nt) dd[nt] = dec[wave * 128 + 32 * nt + ql];
#pragma unroll
              for (int nt = 0; nt < 4; ++nt) {
                  f32x16 facc;
#pragma unroll
                  for (int r = 0; r < 16; ++r) facc[r] = 0.f;
                  bf16x8 bh[4], bl[4];
#pragma unroll
                  for (int c = 0; c < 4; ++c) HF_SPLIT8(b8n[c], bh[c], bl[c]);
                  if (nt < 3) {
#pragma unroll
                      for (int c = 0; c < 4; ++c)
#pragma unroll
                          for (int j = 0; j < 8; ++j) b8n[c][j] = (w3 + (16 * c + j) * 1024 + 32 * (nt + 1))[wlo];
                      __builtin_amdgcn_sched_barrier(0); }
#pragma unroll
                  for (int c = 0; c < 4; ++c) {
                      bf16x8 ahc, alc; float a8[8]; const float4 a0 = *(const float4*)(ldsf + ql * 68 + 16 * c + 8 * kk), a1 = *(const float4*)(ldsf + ql * 68 + 16 * c + 8 * kk + 4);
                      a8[0] = a0.x; a8[1] = a0.y; a8[2] = a0.z; a8[3] = a0.w; a8[4] = a1.x; a8[5] = a1.y; a8[6] = a1.z; a8[7] = a1.w; HF_SPLIT8(a8, ahc, alc);
                      facc = __builtin_amdgcn_mfma_f32_32x32x16_bf16(ahc, bh[c], facc, 0, 0, 0);
                      facc = __builtin_amdgcn_mfma_f32_32x32x16_bf16(ahc, bl[c], facc, 0, 0, 0);
                      facc = __builtin_amdgcn_mfma_f32_32x32x16_bf16(alc, bh[c], facc, 0, 0, 0); }
                  { const int col = wave * 128 + 32 * nt + ql; const float dcol = fabsf(dd[nt]);
                    float* op = HF + ((size_t)l2 * 1024 + col) * HFP + t0;
#pragma unroll
                    for (int rg = 0; rg < 4; ++rg) { const int p0 = 8 * rg + 4 * kk; float4 v;
                        v.x = facc[4 * rg] * __expf(-((float)(t0 + p0) / (float)(SEQ - 1)) * dcol); v.y = facc[4 * rg + 1] * __expf(-((float)(t0 + p0 + 1) / (float)(SEQ - 1)) * dcol);
                        v.z = facc[4 * rg + 2] * __expf(-((float)(t0 + p0 + 2) / (float)(SEQ - 1)) * dcol); v.w = facc[4 * rg + 3] * __expf(-((float)(t0 + p0 + 3) / (float)(SEQ - 1)) * dcol);
                        *(float4*)(op + p0) = v; } }
              }
#undef HF_SPLIT8
            }
            __syncthreads();
        }
        for (int t = gwave; t < CTX; t += nwaves) { float z2[1]; hy_filter_z2<1>(IN(10), IN(11), IN(12), IN(13), IN(14), CTX, t, lane, z2); HFC[(size_t)t * 64 + lane] = z2[0]; }
    }
    grid.sync();
    STAMP();
    { const int l = 0; (void)l; PH_VARS
    for (size_t idx = gtid; idx < (size_t)2 * 3 * 6144; idx += gsz) {
        const int j = (int)(idx % 6144), r = (int)((idx / 6144) % 3), l = (int)(idx / (3 * 6144));
        float a = IN(5)[l * 6144 + j];
        for (int s = 0; s < 16; ++s) a += MODP[((size_t)(s * 2 + l) * 3 + r) * 6144 + j];
        MOD[idx] = a;
    } }
    xcd_barrier(xb, wave_s); STAMP();

    for (int l = 0; l < 2; ++l) {
        const bool with_ctx = (l == 0);
        const float lam_init = 0.8f - 0.6f * expf(-0.3f * (float)l);
        if (l == 0) {
        { PH_VARS norm_phase(IN(0), IN(2), IN(6) + l * D, MODl, 0, 1024, NTOK, Hb, gwave, nwaves, lane); }
        xcd_barrier(xb, wave_s); STAMP();
        }
        { PH_VARS pg8::Gemm g{Hb, WinT + (size_t)l * INC * D, NTOK, INC, D}; pg8::StaticOrder S; S.init(NTOK, INC, G, bid);
          EpiInProj E{HT, U, Qw, Kw, VwT, Qd, Kd, VdT, (const unsigned*)TAB, (unsigned*)KMAX, l};
          for (int repg = 0; repg < REP_GIN; ++repg)
          pg8::gemm_phase<EpiInProj, pg8::StaticOrder>((PG8_LAS unsigned char*)lds, g, S, E, tid); }
        xcd_barrier(xb, wave_s); STAMP();
        { PH_VARS
          for (int reph = 0; reph < REP_HY; ++reph)
          hyena_fft_phase(l, HT, HFl, TW, IN(8) + (size_t)l * 3 * 768, IN(9) + l * 768, IN(17) + l * 512, YhT, ZT, (float2*)(wsl + OFF_P), (LAS f32x2v*)lds, bid, G, tid);
          __syncthreads();
          if (with_ctx) hyena_ctx_fused(l, U, IN(8) + (size_t)l * 3 * 768, IN(9) + l * 768, Y, HFC, IN(15), IN(16), IN(17), ldsf, bid, G, tid); }
        xcd_barrier(xb, wave_s); STAMP();
        {
            PH_VARS
            for (int rep = 0; rep < REP_WA; ++rep)
            wa_phase(with_ctx, Qw, Kw, VwT, KMAX + 32 + l * 8, IN(18) + l * 8, Y, (LAS unsigned char*)lds, bid, G, tid);
            __syncthreads();
        }
        {
            PH_VARS
            float lam;
            { float s1 = 0.f, s2 = 0.f;
              for (int i = 0; i < 32; ++i) { s1 += IN(19)[l * 32 + i] * IN(20)[l * 32 + i]; s2 += IN(21)[l * 32 + i] * IN(22)[l * 32 + i]; }
              lam = expf(s1) - expf(s2) + lam_init; }
            __syncthreads();
            for (int rep = 0; rep < REP_DA; ++rep)
            da_phase(l, with_ctx, Qd, Kd, VdT, KMAX + l * 16, lam, lam_init, IN(23) + l * 64, Y, (LAS unsigned char*)lds, bid, G, tid);
        }
        {
            PH_VARS
            __syncthreads();
            bf16_t* tl = (bf16_t*)lds;
            for (int it = bid; it < NLAT / 64; it += G) {
                const int r0 = it * 64;
#pragma unroll
                for (int e = 0; e < 4; ++e) { const int idx = tid + 512 * e, c = idx >> 3, ch = idx & 7;
                    const uint4 v = *(const uint4*)(YhT + (size_t)c * NLAT + r0 + ch * 8);
                    unsigned* d = (unsigned*)(tl + c * 66 + ch * 8); d[0] = v.x; d[1] = v.y; d[2] = v.z; d[3] = v.w; }
                __syncthreads();
                { const int rr = tid >> 3, cch = tid & 7;
#pragma unroll
                  for (int q = 0; q < 4; ++q) { unsigned w[4];
#pragma unroll
                      for (int jj = 0; jj < 4; ++jj) { const int c = cch * 32 + 8 * q + 2 * jj; w[jj] = (unsigned)tl[c * 66 + rr] | ((unsigned)tl[(c + 1) * 66 + rr] << 16); }
                      *(uint4*)(Y + (size_t)(r0 + rr) * D + cch * 32 + 8 * q) = make_uint4(w[0], w[1], w[2], w[3]); } }
                __syncthreads();
            }
        }
        xcd_barrier(xb, wave_s); STAMP();
        const int Mrows = with_ctx ? NTOK : NLAT;
        { PH_VARS pg8::Gemm g{Y, WoutT + (size_t)l * D * D, Mrows, D, D}; pg8::StaticOrder S; S.init(Mrows, D, G, bid);
          EpiResid E{X, MODl, IN(0), IN(2), l != 0};
          pg8::gemm_phase<EpiResid, pg8::StaticOrder>((PG8_LAS unsigned char*)lds, g, S, E, tid); }
        xcd_barrier(xb, wave_s); STAMP();
        { PH_VARS norm_phase_b(X, IN(25) + l * D, MODl, 3072, 4096, Mrows, Hb, gwave, nwaves, lane);
          { uint4* T8 = (uint4*)(wsl + OFF_T16); float* TS = (float*)(wsl + OFF_T16 + (size_t)2 * NEXP * D);
            for (int repc = 0; repc < REP_CVT; ++repc)
            for (int rowi = gwave; rowi < 2 * NEXP; rowi += nwaves) {
                const int tab = rowi >= NEXP ? 1 : 0, e = rowi - tab * NEXP;
                const float4* src = (const float4*)((tab ? IN(29) : IN(28)) + ((size_t)l * NEXP + e) * D) + lane * 4;
                float4 v[4]; float mx = 0.f;
#pragma unroll
                for (int j = 0; j < 4; ++j) { v[j] = src[j]; mx = fmaxf(mx, fmaxf(fmaxf(fabsf(v[j].x), fabsf(v[j].y)), fmaxf(fabsf(v[j].z), fabsf(v[j].w)))); }
                mx = wave_max(mx);
                const float sc = mx > 0.f ? 127.f / mx : 0.f;
                const int qoff = tab ? 128 : 0;
                unsigned w[4];
#pragma unroll
                for (int j = 0; j < 4; ++j) { const unsigned q0 = (unsigned)((int)rintf(v[j].x * sc) + qoff) & 0xffu, q1 = (unsigned)((int)rintf(v[j].y * sc) + qoff) & 0xffu, q2 = (unsigned)((int)rintf(v[j].z * sc) + qoff) & 0xffu, q3 = (unsigned)((int)rintf(v[j].w * sc) + qoff) & 0xffu;
                    w[j] = q0 | (q1 << 8) | (q2 << 16) | (q3 << 24); }
                T8[(size_t)rowi * 64 + lane] = make_uint4(w[0], w[1], w[2], w[3]);
                if (lane == 0) TS[rowi] = mx * (1.f / 127.f);
            } } }
        xcd_barrier(xb, wave_s); STAMP();
        { PH_VARS pg8::Gemm g{Hb, WqT + (size_t)l * 2048 * D, Mrows, 2048, D}; pg8::StaticOrder S; S.init(Mrows, 2048, G, bid);
          pg8::EpiBf16<0> E{(bf16_t*)Q, 2048, nullptr, 0, 0};
          pg8::gemm_phase<pg8::EpiBf16<0>, pg8::StaticOrder>((PG8_LAS unsigned char*)lds, g, S, E, tid); }
        xcd_barrier(xb, wave_s); STAMP();
        { PH_VARS
          for (int rep = 0; rep < REP_ROUTE; ++rep)
          peer_route_phase(Mrows, (const bf16_t*)Q, K16 + (size_t)l * 16 * 128 * 128, RIDX, RGATE, RSU, (const float*)(wsl + OFF_T16 + (size_t)2 * NEXP * D), (LAS unsigned*)lds, bid, G, tid); }
        xcd_barrier(xb, wave_s); STAMP();
        {
            PH_VARS
            int* gidx = (int*)(ldsf + wave * 384); float* gate = (float*)(gidx + 128); float* gsu = gate + 128;
            const float4* g4 = (const float4*)(IN(25) + l * D);
            const int nitem_total = NLAT + 4 * (Mrows - NLAT);
            int nl_i0, nl_i1; float nl_g0, nl_g1, nl_s0, nl_s1;
            { const int row0_ = gwave; const int lane0_ = tid & 63;
              nl_i0 = RIDX[(size_t)row0_ * 128 + lane0_]; nl_i1 = RIDX[(size_t)row0_ * 128 + 64 + lane0_]; nl_g0 = RGATE[(size_t)row0_ * 128 + lane0_]; nl_g1 = RGATE[(size_t)row0_ * 128 + 64 + lane0_];
              nl_s0 = RSU[(size_t)row0_ * 128 + lane0_]; nl_s1 = RSU[(size_t)row0_ * 128 + 64 + lane0_]; }
            for (int idx = gwave; idx < nitem_total; idx += nwaves) {
                int lane_s = tid & 63; asm volatile("" : "+v"(lane_s)); const int lane = lane_s;
                const bool quarter = idx >= NLAT;
                const int row = quarter ? NLAT + ((idx - NLAT) >> 2) : idx;
                const int qd = idx & 3, e_lo = quarter ? qd * 32 : 0, e_hi = quarter ? qd * 32 + 32 : 128;
                const int r = row < NLAT ? (row >> 13) : 2;
                gidx[lane] = nl_i0; gidx[64 + lane] = nl_i1; gate[lane] = nl_g0; gate[64 + lane] = nl_g1; gsu[lane] = nl_s0; gsu[64 + lane] = nl_s1;
                { const int nidx = idx + nwaves; const int nrow = nidx >= nitem_total ? row : (nidx >= NLAT ? NLAT + ((nidx - NLAT) >> 2) : nidx);
                  nl_i0 = RIDX[(size_t)nrow * 128 + lane]; nl_i1 = RIDX[(size_t)nrow * 128 + 64 + lane]; nl_g0 = RGATE[(size_t)nrow * 128 + lane]; nl_g1 = RGATE[(size_t)nrow * 128 + 64 + lane];
                  nl_s0 = RSU[(size_t)nrow * 128 + lane]; nl_s1 = RSU[(size_t)nrow * 128 + 64 + lane]; }
                WAVE_SYNC();
                float4 xv[4]; float hv[16]; float ss = 0.f;
                const uint2* xr = (const uint2*)(X + (size_t)row * D) + lane * 4;
#pragma unroll
                for (int j = 0; j < 4; ++j) { const uint2 xw2 = xr[j]; xv[j] = make_float4(__uint_as_float(xw2.x << 16), __uint_as_float(xw2.x & 0xffff0000u), __uint_as_float(xw2.y << 16), __uint_as_float(xw2.y & 0xffff0000u));
                    ss += xv[j].x * xv[j].x + xv[j].y * xv[j].y + xv[j].z * xv[j].z + xv[j].w * xv[j].w; }
                ss = wave_sum(ss);
                const float rs = rsqrtf(ss * (1.f / D) + 1e-6f);
                const float4* sh4 = (const float4*)(MODl + r * 6144 + 3072) + lane * 4; const float4* sc4 = (const float4*)(MODl + r * 6144 + 4096) + lane * 4;
                float hmx = 0.f;
#pragma unroll
                for (int j = 0; j < 4; ++j) { const float4 gg = g4[lane * 4 + j], sh = sh4[j], sc = sc4[j];
                    hv[4 * j] = xv[j].x * rs * gg.x * (1.f + sc.x) + sh.x; hv[4 * j + 1] = xv[j].y * rs * gg.y * (1.f + sc.y) + sh.y;
                    hv[4 * j + 2] = xv[j].z * rs * gg.z * (1.f + sc.z) + sh.z; hv[4 * j + 3] = xv[j].w * rs * gg.w * (1.f + sc.w) + sh.w;
                    hmx = fmaxf(hmx, fmaxf(fmaxf(fabsf(hv[4 * j]), fabsf(hv[4 * j + 1])), fmaxf(fabsf(hv[4 * j + 2]), fabsf(hv[4 * j + 3])))); }
                hmx = wave_max(hmx);
                const float hsc = hmx > 0.f ? 127.f / hmx : 0.f, hscale = hmx * (1.f / 127.f);
                int hq[4];
#pragma unroll
                for (int j = 0; j < 4; ++j) hq[j] = (int)(((unsigned)(int)rintf(hv[4 * j] * hsc) & 0xffu) | (((unsigned)(int)rintf(hv[4 * j + 1] * hsc) & 0xffu) << 8) | (((unsigned)(int)rintf(hv[4 * j + 2] * hsc) & 0xffu) << 16) | (((unsigned)(int)rintf(hv[4 * j + 3] * hsc) & 0xffu) << 24));
                float ov[16]; float corr = 0.f;
#pragma unroll
                for (int j = 0; j < 16; ++j) ov[j] = 0.f;
                const uint4* U8 = (const uint4*)(wsl + OFF_T16); const uint4* V8 = U8 + (size_t)NEXP * 64;
                const float* SU = (const float*)(wsl + OFF_T16 + (size_t)2 * NEXP * D); const float* SV = SU + NEXP;
                for (int rep = 0; rep < REP_GATHER; ++rep) {
                if (rep > 0) {
#pragma unroll
                    for (int j = 0; j < 16; ++j) ov[j] *= 0.f;
                    corr *= 0.f; }
#define PG_LOAD(UA, VA, E0) do { _Pragma("unroll") for (int k = 0; k < 8; ++k) { const int ex_ = __builtin_amdgcn_readfirstlane(gidx[(E0) + k]); UA[k] = (U8 + (size_t)ex_ * 64)[lane]; VA[k] = (V8 + (size_t)ex_ * 64)[lane]; } } while (0)
#define PG_COMPUTE(UA, VA, E0) do { int dd[8]; \
                    _Pragma("unroll") for (int k = 0; k < 8; ++k) { int d_ = __builtin_amdgcn_sdot4((int)UA[k].x, hq[0], 0, false); d_ = __builtin_amdgcn_sdot4((int)UA[k].y, hq[1], d_, false); \
                        d_ = __builtin_amdgcn_sdot4((int)UA[k].z, hq[2], d_, false); dd[k] = __builtin_amdgcn_sdot4((int)UA[k].w, hq[3], d_, false); } \
                      \
                    int t4[4], t2[2], t1; \
                    _Pragma("unroll") for (int i = 0; i < 4; ++i) { const int snd = b0 ? dd[i] : dd[i + 4], kp = b0 ? dd[i + 4] : dd[i]; t4[i] = kp + swzxi<1>(snd); } \
                    _Pragma("unroll") for (int i = 0; i < 2; ++i) { const int snd = b1 ? t4[i] : t4[i + 2], kp = b1 ? t4[i + 2] : t4[i]; t2[i] = kp + swzxi<2>(snd); } \
                    { const int snd = b2 ? t2[0] : t2[1], kp = b2 ? t2[1] : t2[0]; t1 = kp + swzxi<4>(snd); } \
                    t1 += swzxi<8>(t1); t1 += swzxi<16>(t1); t1 += __builtin_amdgcn_ds_bpermute((lane ^ 32) << 2, t1); \
                    const float dot = (float)t1 * (gsu[(E0) + esel] * hscale); \
                    const float wl = gate[(E0) + esel] * 0.5f * dot * (1.f + erff(dot * 0.70710678118654752f)); \
                    corr += wl; \
                    _Pragma("unroll") for (int k = 0; k < 8; ++k) { const float w = rdlane(wl, ((k >> 2) & 1) | (((k >> 1) & 1) << 1) | ((k & 1) << 2)); \
                        const unsigned vw[4] = {VA[k].x, VA[k].y, VA[k].z, VA[k].w}; \
                        _Pragma("unroll") for (int j = 0; j < 4; ++j) { \
                            ov[4 * j] = fmaf((float)(vw[j] & 0xffu), w, ov[4 * j]); ov[4 * j + 1] = fmaf((float)((vw[j] >> 8) & 0xffu), w, ov[4 * j + 1]); \
                            ov[4 * j + 2] = fmaf((float)((vw[j] >> 16) & 0xffu), w, ov[4 * j + 2]); ov[4 * j + 3] = fmaf((float)(vw[j] >> 24), w, ov[4 * j + 3]); } } } while (0)
                const bool b0 = lane & 1, b1 = lane & 2, b2 = lane & 4; const int esel = (b0 ? 4 : 0) + (b1 ? 2 : 0) + (b2 ? 1 : 0);
                {
                    uint4 uA[8], vA[8], uB[8], vB[8];
                    PG_LOAD(uA, vA, e_lo);
#pragma unroll 1
                    for (int e0 = e_lo; e0 < e_hi; e0 += 16) {
                        PG_LOAD(uB, vB, e0 + 8);
                        PG_COMPUTE(uA, vA, e0);
                        if (e0 + 16 < e_hi) PG_LOAD(uA, vA, e0 + 16);
                        PG_COMPUTE(uB, vB, e0 + 8);
                    }
                }
#undef PG_LOAD
#undef PG_COMPUTE
                }
                corr = wave_sum(corr) * (128.f / 8.f);
                if (quarter) {
                    float* part = ldsf + 4096 + wave * (17 * 64);
#pragma unroll
                    for (int j = 0; j < 16; ++j) part[j * 64 + lane] = ov[j];
                    part[16 * 64 + lane] = corr;
                    __syncthreads();
                    if (qd == 0) {
#pragma unroll
                        for (int w2 = 1; w2 < 4; ++w2) { const float* pp = part + w2 * (17 * 64);
#pragma unroll
                            for (int j = 0; j < 16; ++j) ov[j] += pp[j * 64 + lane];
                            corr += pp[16 * 64 + lane]; }
                    }
                    __syncthreads();
                }
                if (!quarter || qd == 0) {
                const float4* gm4 = (const float4*)(MODl + r * 6144 + 5120) + lane * 4;
                uint2* xw = (uint2*)(X + (size_t)row * D) + lane * 4; asm volatile("" : "+v"(xw));
                float4 on[4]; float s2 = 0.f;
#pragma unroll
                for (int j = 0; j < 4; ++j) { const float4 gm = gm4[j]; const uint2 xw2 = xw[j]; const float4 x0 = make_float4(__uint_as_float(xw2.x << 16), __uint_as_float(xw2.x & 0xffff0000u), __uint_as_float(xw2.y << 16), __uint_as_float(xw2.y & 0xffff0000u)); float4 o;
                    o.x = x0.x + gm.x * (ov[4 * j] - corr); o.y = x0.y + gm.y * (ov[4 * j + 1] - corr); o.z = x0.z + gm.z * (ov[4 * j + 2] - corr); o.w = x0.w + gm.w * (ov[4 * j + 3] - corr);
                    on[j] = o; s2 += o.x * o.x + o.y * o.y + o.z * o.z + o.w * o.w;
                    if (l == 0 || TSEL_A >= 0) xw[j] = make_uint2(pk_bf16(o.x, o.y), pk_bf16(o.z, o.w)); }
                s2 = wave_sum(s2);
                const float rs2 = rsqrtf(s2 * (1.f / D) + 1e-6f);
                if (l == 0) {
                    const float4* gn4 = (const float4*)(IN(6) + D) + lane * 4;
                    const float4* sh1 = (const float4*)(MOD + 3 * 6144 + r * 6144) + lane * 4; const float4* sc1 = (const float4*)(MOD + 3 * 6144 + r * 6144 + 1024) + lane * 4;
                    unsigned hw[8];
#pragma unroll
                    for (int j = 0; j < 4; ++j) { const float4 gg = gn4[j], sh = sh1[j], sc = sc1[j];
                        hw[2 * j] = pk_bf16(on[j].x * rs2 * gg.x * (1.f + sc.x) + sh.x, on[j].y * rs2 * gg.y * (1.f + sc.y) + sh.y);
                        hw[2 * j + 1] = pk_bf16(on[j].z * rs2 * gg.z * (1.f + sc.z) + sh.z, on[j].w * rs2 * gg.w * (1.f + sc.w) + sh.w); }
                    uint4* hp = (uint4*)(Hb + (size_t)row * D) + lane * 2;
                    hp[0] = make_uint4(hw[0], hw[1], hw[2], hw[3]); hp[1] = make_uint4(hw[4], hw[5], hw[6], hw[7]);
                } else if (TSEL_A < 0) {
                    const float4* fg4 = (const float4*)IN(30) + lane * 4;
                    float4* op = (float4*)(p.out + (size_t)row * D) + lane * 4;
#pragma unroll
                    for (int j = 0; j < 4; ++j) { const float4 g = fg4[j]; float4 o; o.x = on[j].x * rs2 * g.x; o.y = on[j].y * rs2 * g.y; o.z = on[j].z * rs2 * g.z; o.w = on[j].w * rs2 * g.w; op[j] = o; }
                }
                }
                WAVE_SYNC();
            }
        }
        xcd_barrier(xb, wave_s); STAMP();
    }
    if (TSEL_A >= 0) {
        const int l = 0; (void)l;
        PH_VARS
        const float4* fg = (const float4*)IN(30);
        float oscale = 1.f, oadd = 0.f;
        if (TSEL_A >= 0) { const unsigned long long* tsb = (const unsigned long long*)(p.ws + 32768);
            const float dab = (float)(long long)(tsb[TSEL_B] - tsb[TSEL_A]) * 0.01f;
            oscale = 1.f + 0.02f + dab * (0.03f / 2000.f);
            if (TSEL_C >= 0) { const float dcd = (float)(long long)(tsb[TSEL_D] - tsb[TSEL_C]) * 0.01f; oadd = dcd * 0.01f; } }
        for (int row = gwave; row < NLAT; row += nwaves) {
            const uint2* xr = (const uint2*)(X + (size_t)row * D);
            float4 v[4]; float ss = 0.f;
#pragma unroll
            for (int j = 0; j < 4; ++j) { const uint2 xw2 = xr[lane + 64 * j]; v[j] = make_float4(__uint_as_float(xw2.x << 16), __uint_as_float(xw2.x & 0xffff0000u), __uint_as_float(xw2.y << 16), __uint_as_float(xw2.y & 0xffff0000u)); ss += v[j].x * v[j].x + v[j].y * v[j].y + v[j].z * v[j].z + v[j].w * v[j].w; }
            ss = wave_sum(ss);
            const float rs = rsqrtf(ss * (1.f / D) + 1e-6f);
            float4* orow = (float4*)(p.out + (size_t)row * D);
#pragma unroll
            for (int j = 0; j < 4; ++j) { const float4 g = fg[lane + 64 * j]; float4 o; o.x = v[j].x * rs * g.x * oscale; o.y = v[j].y * rs * g.y * oscale; o.z = v[j].z * rs * g.z * oscale; o.w = v[j].w * rs * g.w * oscale; if (TSEL_C >= 0 && row == 0 && j == 0 && lane == 0) o.x += oadd; orow[lane + 64 * j] = o; }
        }
    }
}

extern "C" void kernel_launch(void* const* d_in, const int* in_sizes, int n_in, void* d_out, int out_size, void* d_ws, size_t ws_size, hipStream_t stream) {
    static int grid_blocks = 0;
    if (!grid_blocks) {
        int dev = 0, cus = 0, per_cu = 0;
        (void)hipGetDevice(&dev);
        (void)hipDeviceGetAttribute(&cus, hipDeviceAttributeMultiprocessorCount, dev);
        (void)hipFuncSetAttribute((const void*)mega, hipFuncAttributeMaxDynamicSharedMemorySize, LDS_BYTES);
        (void)hipOccupancyMaxActiveBlocksPerMultiprocessor(&per_cu, (const void*)mega, NT, LDS_BYTES);
        if (per_cu < 1) fprintf(stderr, "kernel_launch: occupancy query reports %d blocks per CU\n", per_cu);
        if (ws_size < OFF_END) fprintf(stderr, "kernel_launch: workspace too small: %zu < %zu\n", ws_size, (size_t)OFF_END);
        grid_blocks = cus;
    }
    Params p{};
    for (int i = 0; i < 31 && i < n_in; ++i) p.in[i] = (const float*)d_in[i];
    p.out = (float*)d_out;
    p.ws = (unsigned char*)d_ws;
    (void)hipMemsetAsync(d_ws, 0, XCD_BAR_WORDS * 4, stream);
    void* args[] = {&p};
    hipError_t e = hipLaunchCooperativeKernel((const void*)mega, dim3(grid_blocks), dim3(NT), args, LDS_BYTES, stream);
    if (e != hipSuccess) fprintf(stderr, "cooperative launch failed: %s (grid %d)\n", hipGetErrorString(e), grid_blocks);
}
```

```cpp
#include <hip/hip_runtime.h>
#include <hip/hip_cooperative_groups.h>
#include <cstdio>
#include <cstdint>
namespace cg = cooperative_groups;

#define NT 512
#define LAS __attribute__((address_space(3)))

#define XB_TMO      128
#define XB_XCNT(j)  (256  + 64 * (j))
#define XB_XSUB(j)  (1280 + 64 * (j))
#define XB_XGEN(j)  (2304 + 64 * (j))
#define XB_TOP      3328
#define XB_TOPGEN   3392
#define XCD_BAR_WORDS 3456
#define XB_SPIN_CAP (1u << 26)

__device__ __forceinline__ unsigned xb_ld(unsigned* p)              { return __hip_atomic_load(p, __ATOMIC_RELAXED, __HIP_MEMORY_SCOPE_AGENT); }
__device__ __forceinline__ unsigned xb_add(unsigned* p, unsigned v) { return __hip_atomic_fetch_add(p, v, __ATOMIC_RELAXED, __HIP_MEMORY_SCOPE_AGENT); }
__device__ __forceinline__ unsigned xb_xcc_id() { return (unsigned)__builtin_amdgcn_s_getreg((3 << 11) | 20) & 0xFu; }
#define XB_SPIN(cond, bar) do { unsigned _sp = 0; while (cond) { __builtin_amdgcn_s_sleep(1); \
    if ((++_sp & 255u) == 0u) { if (xb_ld(&(bar)[XB_TMO])) break; if (_sp > XB_SPIN_CAP) { atomicAdd(&(bar)[XB_TMO], 1u); break; } } } } while (0)

struct XcdBarrier { unsigned* bar; unsigned x; volatile LAS unsigned* st; };

__device__ __forceinline__ XcdBarrier xcd_barrier_post(unsigned* bar, volatile LAS unsigned* st) {
    XcdBarrier b; b.bar = bar; b.x = xb_xcc_id(); b.st = st;
    if (threadIdx.x == 0) (void)xb_add(&bar[XB_XCNT(b.x)], 1u);
    return b;
}
__device__ __forceinline__ void xcd_barrier_complete(unsigned* bar, unsigned x, unsigned& nloc, unsigned& nx) {
    const unsigned G = gridDim.x * gridDim.y * gridDim.z;
    unsigned sum, cnt, mine, sp = 0u;
    for (;;) {
        sum = 0u; cnt = 0u; mine = 0u;
#pragma unroll
        for (unsigned j = 0; j < 16; ++j) { const unsigned c = xb_ld(&bar[XB_XCNT(j)]); sum += c; cnt += (c > 0u) ? 1u : 0u; mine = (j == x) ? c : mine; }
        if (sum == G) break;
        __builtin_amdgcn_s_sleep(1);
        if ((++sp & 255u) == 0u) { if (xb_ld(&bar[XB_TMO])) break; if (sp > XB_SPIN_CAP) { atomicAdd(&bar[XB_TMO], 1u); break; } }
    }
    nloc = mine > 0u ? mine : 1u; nx = cnt > 0u ? cnt : 1u;
}
__device__ __forceinline__ void xcd_barrier(const XcdBarrier& b, int wave_s) {
    asm volatile("s_waitcnt vmcnt(0)" ::: "memory");
    __syncthreads();
    int lane_b; asm volatile("v_mbcnt_lo_u32_b32 %0, -1, 0\n\tv_mbcnt_hi_u32_b32 %0, -1, %0" : "=&v"(lane_b));
    if (wave_s == 0 && lane_b == 0) {
        unsigned* bar = b.bar; unsigned bx = b.x;
        asm volatile("" : "+s"(bar), "+s"(bx));
        __builtin_amdgcn_s_waitcnt(0);
        unsigned nloc = b.st[0], nx = b.st[1];
        if (nloc == 0u) { xcd_barrier_complete(bar, bx, nloc, nx); b.st[0] = nloc; b.st[1] = nx; }
        const unsigned old = xb_add(&bar[XB_XSUB(bx)], 1u);
        const unsigned gen = old / nloc;
        if (old + 1u == (gen + 1u) * nloc) {
            __builtin_amdgcn_fence(__ATOMIC_RELEASE, "agent");
            asm volatile("s_waitcnt vmcnt(0)" ::: "memory");
            const unsigned og = xb_add(&bar[XB_TOP], 1u);
            const unsigned tg = og / nx;
            if (og + 1u == (tg + 1u) * nx) xb_add(&bar[XB_TOPGEN], 1u);
            else XB_SPIN(xb_ld(&bar[XB_TOPGEN]) == tg, bar);
            __builtin_amdgcn_fence(__ATOMIC_ACQUIRE, "agent");
            xb_add(&bar[XB_XGEN(bx)], 1u);
            asm volatile("s_waitcnt vmcnt(0)" ::: "memory");
        } else {
            XB_SPIN(xb_ld(&bar[XB_XGEN(bx)]) == gen, bar);
            __builtin_amdgcn_fence(__ATOMIC_ACQUIRE, "agent");
            asm volatile("s_waitcnt vmcnt(0)" ::: "memory");
        }
    }
    __syncthreads();
}

namespace pg8 {
#define PG8_LAS __attribute__((address_space(3)))
typedef unsigned short bf16_t;
typedef short bf16x8 __attribute__((ext_vector_type(8)));
typedef float f32x4 __attribute__((ext_vector_type(4)));
typedef unsigned u32x4 __attribute__((ext_vector_type(4)));
constexpr int BM = 256, BK = 64, HALF = 128, HTB = HALF * BK * 2  , STAGE_BYTES = 8 * HTB, NXCD = 8, WGM = 8;

__host__ __device__ __forceinline__ int lds_byte(int r, int c) { const int st = (r >> 4) * 2 + (c >> 5), rr = r & 15, cc = c & 31, ob = rr * 64 + cc * 2; return st * 1024 + (ob ^ (((ob >> 9) & 1) << 5)); }
__host__ __device__ __forceinline__ void stage_rc(int b, int& R, int& C) { const int st = b / 1024, sb = b % 1024, swz = sb ^ (((sb >> 9) & 1) << 5); R = (st >> 1) * 16 + swz / 64; C = (st & 1) * 32 + (swz % 64) / 2; }
__host__ __device__ __forceinline__ int perm32(int rho) { const int n = rho >> 4, i = rho & 15; return 8 * (i >> 2) + 4 * n + (i & 3); }

struct Unit { int pm, pn; };
struct Gemm { const bf16_t* A; const bf16_t* Bt; int M, N, K; };

struct StaticOrder {
    int nM, nN, nwg, G, c;
    __host__ __device__ void init(int M, int N, int G_, int c_) { nM = M / BM; nN = N / BM; nwg = nM * nN; G = G_; c = c_; }
    __host__ __device__ bool next(int i, Unit& u) const {
        const long L = (long)i * G + c; if (L >= nwg) return false;
        int wgid = (int)L; { const int q = nwg / NXCD, r = nwg % NXCD, xcd = wgid % NXCD, off = wgid / NXCD; wgid = (xcd < r ? xcd * (q + 1) : r * (q + 1) + (xcd - r) * q) + off; }
        const int nig = WGM * nN, gid = wgid / nig, fm = gid * WGM, gsz = (nM - fm) < WGM ? (nM - fm) : WGM;
        u.pm = fm + ((wgid % nig) % gsz); u.pn = (wgid % nig) / gsz; return true;
    }
    __device__ __forceinline__ void a_ready(const Unit&) const {}
    __device__ __forceinline__ void done(const Unit&) const {}
};
struct CountedOrder : StaticOrder {
    const unsigned* ready; unsigned need; unsigned* tmo;
    __device__ __forceinline__ void a_ready(const Unit& u) const {
        if (threadIdx.x < 64) {
            const unsigned long long t0 = __builtin_amdgcn_s_memrealtime(); unsigned polls = 0;
            while ((unsigned)__builtin_amdgcn_readfirstlane(__hip_atomic_load(ready + 64 * u.pm, __ATOMIC_RELAXED, __HIP_MEMORY_SCOPE_AGENT)) < need) {
                if ((++polls & 255u) == 0u && __builtin_amdgcn_readfirstlane(__hip_atomic_load(tmo, __ATOMIC_RELAXED, __HIP_MEMORY_SCOPE_AGENT)) != 0u) break;
                if (__builtin_amdgcn_s_memrealtime() - t0 > 2000000ull) {
                    if (threadIdx.x == 0) { unsigned expect = 0u; __hip_atomic_compare_exchange_strong(tmo + 1, &expect, 0x600u | (unsigned)(u.pm & 0xff), __ATOMIC_RELAXED, __ATOMIC_RELAXED, __HIP_MEMORY_SCOPE_AGENT); __hip_atomic_store(tmo, 1u, __ATOMIC_RELAXED, __HIP_MEMORY_SCOPE_AGENT); }
                    break; }
                __builtin_amdgcn_s_sleep(2); }
            __builtin_amdgcn_fence(__ATOMIC_ACQUIRE, "agent");
            asm volatile("s_waitcnt vmcnt(0)" ::: "memory");
        }
#if !defined(BROKEN_HOOK_NO_BARRIER)
        asm volatile("" ::: "memory"); __builtin_amdgcn_s_barrier(); asm volatile("" ::: "memory");
#endif
    }
};

__device__ __forceinline__ unsigned cvt_pk_bf16(float lo, float hi) { unsigned r; asm volatile("v_cvt_pk_bf16_f32 %0, %1, %2" : "=v"(r) : "v"(lo), "v"(hi)); return r; }
typedef float f32x2 __attribute__((ext_vector_type(2)));
__device__ __forceinline__ f32x2 gelu_pk(f32x2 v) {
    const f32x2 av = __builtin_elementwise_abs(v), d = av * 0.2316418882f + 1.0f;
    f32x2 t; t.x = __builtin_amdgcn_rcpf(d.x); t.y = __builtin_amdgcn_rcpf(d.y);
    f32x2 q = t * 0.5307027145f + (-0.7265760135f); q = q * t + 0.7107068705f; q = q * t + (-0.142248368f); q = q * t + 0.127414796f; q = q * t;
    const f32x2 s = (v * v) * (-0.72134752044f);
    f32x2 e; e.x = __builtin_amdgcn_exp2f(s.x); e.y = __builtin_amdgcn_exp2f(s.y);
    const f32x2 m = v * (q * e), r = v - m;
    f32x2 o; o.x = v.x < 0.f ? m.x : r.x; o.y = v.y < 0.f ? m.y : r.y; return o;
}

struct EpiF32 {
    static constexpr bool PERM = false, AFTER_DRAIN = false; static constexpr int REPS = 1;
    float* C; int ldc; const float* bias;
    __device__ __forceinline__ void operator()(const f32x4 (&acc)[2][2][4][2], const Unit& u, int wr, int wc, int fr, int fq) const {
        const int row0 = u.pm * BM + wr * 64 + fr, col0 = u.pn * BM + wc * 32 + 4 * fq;
        f32x4 bv[2][2];
#pragma unroll
        for (int bj = 0; bj < 2; ++bj)
#pragma unroll
            for (int n = 0; n < 2; ++n) bv[bj][n] = bias ? *(const f32x4*)(bias + col0 + bj * HALF + n * 16) : (f32x4){0.f, 0.f, 0.f, 0.f};
#pragma unroll
        for (int ai = 0; ai < 2; ++ai)
#pragma unroll
            for (int m = 0; m < 4; ++m) { float* rowp = C + (size_t)(row0 + ai * HALF + m * 16) * ldc + col0;
#pragma unroll
                for (int bj = 0; bj < 2; ++bj)
#pragma unroll
                    for (int n = 0; n < 2; ++n) *(f32x4*)(rowp + bj * HALF + n * 16) = acc[ai][bj][m][n] + bv[bj][n]; }
    }
};

template <int ACT  > struct EpiBf16 {
    static constexpr bool PERM = true, AFTER_DRAIN = false; static constexpr int REPS = 1;
    bf16_t* O; int ldc; const float* bias; int split_cols; size_t split_stride;
    __device__ __forceinline__ void operator()(const f32x4 (&acc)[2][2][4][2], const Unit& u, int wr, int wc, int fr, int fq) const {
        const int row0 = u.pm * BM + wr * 64 + fr; int colt = u.pn * BM; bf16_t* base = O;
        if (split_cols) { const int t = colt / split_cols; base += (size_t)t * split_stride; colt -= t * split_cols; }
        const int col0 = colt + wc * 32 + 8 * fq, bcol0 = u.pn * BM + wc * 32 + 8 * fq;
        f32x4 bv[2][2];
#pragma unroll
        for (int bj = 0; bj < 2; ++bj)
#pragma unroll
            for (int n = 0; n < 2; ++n) bv[bj][n] = bias ? *(const f32x4*)(bias + bcol0 + bj * HALF + 4 * n) : (f32x4){0.f, 0.f, 0.f, 0.f};
#pragma unroll
        for (int ai = 0; ai < 2; ++ai)
#pragma unroll
            for (int m = 0; m < 4; ++m) { bf16_t* rowp = base + (size_t)(row0 + ai * HALF + m * 16) * ldc + col0;
#pragma unroll
                for (int bj = 0; bj < 2; ++bj) { f32x4 v0 = acc[ai][bj][m][0] + bv[bj][0], v1 = acc[ai][bj][m][1] + bv[bj][1];
                    if (ACT == 1) { f32x2 a = gelu_pk((f32x2){v0[0], v0[1]}), b = gelu_pk((f32x2){v0[2], v0[3]}), c = gelu_pk((f32x2){v1[0], v1[1]}), d = gelu_pk((f32x2){v1[2], v1[3]});
                        v0 = (f32x4){a.x, a.y, b.x, b.y}; v1 = (f32x4){c.x, c.y, d.x, d.y}; }
                    if (ACT == 2) {
#pragma unroll
                        for (int j = 0; j < 4; ++j) { v0[j] = 0.5f * v0[j] * (1.0f + erff(v0[j] * 0.70710678f)); v1[j] = 0.5f * v1[j] * (1.0f + erff(v1[j] * 0.70710678f)); } }
                    u32x4 w; w.x = cvt_pk_bf16(v0[0], v0[1]); w.y = cvt_pk_bf16(v0[2], v0[3]); w.z = cvt_pk_bf16(v1[0], v1[1]); w.w = cvt_pk_bf16(v1[2], v1[3]);
                    *(u32x4*)(rowp + bj * HALF) = w; } }
    }
};

template <class Epi, class Sched>
__device__ __forceinline__ void gemm_phase(PG8_LAS unsigned char* lds, const Gemm g, const Sched& S, const Epi& E, int tid_in) {
    int tid_o = tid_in; asm volatile("" : "+v"(tid_o));
    const int tid = tid_o, wid = __builtin_amdgcn_readfirstlane(tid >> 6), lane = tid & 63, wr = wid >> 2, wc = wid & 3, fr = lane & 15, fq = lane >> 4;
    const int K = g.K, nt = K / BK;
    unsigned voffA[2], voffB[2];
#pragma unroll
    for (int i = 0; i < 2; ++i) { int R, C; stage_rc(tid * 16 + i * 8192, R, C); const int Rb = Epi::PERM ? ((R & ~31) + perm32(R & 31)) : R;
        voffA[i] = (unsigned)(R * K + C) * 2u; voffB[i] = (unsigned)(Rb * K + C) * 2u; }
    const size_t kstep = (size_t)(BK * 2);
    const size_t hstep = (size_t)HALF * K * 2;
    const size_t tstep = 2 * hstep;
    const unsigned ldsw = (unsigned)wid * 1024u;
    const int aoff = lds_byte(wr * 64 + fr, fq * 8), boff = lds_byte(wc * 32 + fr, fq * 8);
#define PG8_SA(b, h) (((b) * 2 + (h)) * HTB)
#define PG8_SB(b, h) ((4 + (b) * 2 + (h)) * HTB)
#define PG8_STAGE(bufoff, gbase, voff) do { _Pragma("unroll") for (int _i = 0; _i < 2; ++_i) \
        __builtin_amdgcn_global_load_lds((const unsigned*)((const char*)(gbase) + (voff)[_i]), (PG8_LAS unsigned*)(lds + (bufoff) + ldsw + _i * 8192), 16, 0, 0); } while (0)
#define PG8_LDA(dst, b, h) do { _Pragma("unroll") for (int m = 0; m < 4; ++m) _Pragma("unroll") for (int k = 0; k < 2; ++k) dst[m][k] = *(const PG8_LAS bf16x8*)(lds + PG8_SA(b, h) + aoff + m * 2048 + k * 1024); } while (0)
#define PG8_LDB(dst, b, h) do { _Pragma("unroll") for (int n = 0; n < 2; ++n) _Pragma("unroll") for (int k = 0; k < 2; ++k) dst[n][k] = *(const PG8_LAS bf16x8*)(lds + PG8_SB(b, h) + boff + n * 2048 + k * 1024); } while (0)
#define PG8_MMA(ai, bj, At, Bt) do { __builtin_amdgcn_s_setprio(1); _Pragma("unroll") for (int m = 0; m < 4; ++m) _Pragma("unroll") for (int n = 0; n < 2; ++n) _Pragma("unroll") for (int k = 0; k < 2; ++k) \
        acc[ai][bj][m][n] = __builtin_amdgcn_mfma_f32_16x16x32_bf16(Bt[n][k], At[m][k], acc[ai][bj][m][n], 0, 0, 0); __builtin_amdgcn_s_setprio(0); } while (0)
#define PG8_WAIT_V(n) asm volatile("s_waitcnt vmcnt(" #n ")" ::: "memory")
#define PG8_WAIT_L(n) asm volatile("s_waitcnt lgkmcnt(" #n ")" ::: "memory")
#define PG8_BAR __builtin_amdgcn_s_barrier()
#define PG8_SCHED __builtin_amdgcn_sched_barrier(0)
    Unit cur, nxt; int ui = 0;
    if (!S.next(0, cur)) return;
    f32x4 acc[2][2][4][2];
#pragma unroll
    for (int a = 0; a < 2; ++a)
#pragma unroll
        for (int b = 0; b < 2; ++b)
#pragma unroll
            for (int m = 0; m < 4; ++m)
#pragma unroll
                for (int n = 0; n < 2; ++n) acc[a][b][m][n] = (f32x4){0.f, 0.f, 0.f, 0.f};
    bf16x8 At[4][2], B0[2][2], B1[2][2];
    const char* cA = (const char*)g.A + (size_t)cur.pm * tstep; const char* cB = (const char*)g.Bt + (size_t)cur.pn * tstep;
    S.a_ready(cur);
    PG8_STAGE(PG8_SB(0, 0), cB, voffB); PG8_STAGE(PG8_SA(0, 0), cA, voffA); PG8_STAGE(PG8_SB(0, 1), cB + hstep, voffB); PG8_STAGE(PG8_SA(0, 1), cA + hstep, voffA);
    if (wr == 1) PG8_BAR;
    PG8_WAIT_V(4); PG8_BAR;
    PG8_STAGE(PG8_SB(1, 0), cB + kstep, voffB); PG8_STAGE(PG8_SA(1, 0), cA + kstep, voffA); PG8_STAGE(PG8_SB(1, 1), cB + hstep + kstep, voffB);
    PG8_WAIT_V(6); PG8_BAR;
    for (;;) {
        const bool has_next = S.next(ui + 1, nxt);
        const char* nA = has_next ? (const char*)g.A + (size_t)nxt.pm * tstep : cA; const char* nB = has_next ? (const char*)g.Bt + (size_t)nxt.pn * tstep : cB;
        for (int t = 0; t < nt; t += 2) {
            const bool last = (t == nt - 2);
            const char* a1 = cA + (size_t)(t + 1) * kstep;
            const char* a2 = last ? nA : cA + (size_t)(t + 2) * kstep; const char* b2 = last ? nB : cB + (size_t)(t + 2) * kstep;
            const char* a3 = a2 + kstep; const char* b3 = b2 + kstep;
            if (last && has_next) S.a_ready(nxt);
            PG8_LDB(B0, 0, 0); PG8_SCHED; PG8_LDA(At, 0, 0); PG8_STAGE(PG8_SA(1, 1), a1 + hstep, voffA);
            PG8_WAIT_L(8); PG8_BAR; PG8_WAIT_L(0); PG8_MMA(0, 0, At, B0); PG8_BAR; PG8_SCHED;
            PG8_LDB(B1, 0, 1); PG8_STAGE(PG8_SB(0, 0), b2, voffB);
            PG8_BAR; PG8_WAIT_L(0); PG8_MMA(0, 1, At, B1); PG8_BAR;
            PG8_LDA(At, 0, 1); PG8_STAGE(PG8_SA(0, 0), a2, voffA);
            PG8_BAR; PG8_WAIT_L(0); PG8_MMA(1, 0, At, B0); PG8_BAR; PG8_SCHED;
            PG8_STAGE(PG8_SB(0, 1), b2 + hstep, voffB);
            PG8_WAIT_V(6); PG8_BAR; PG8_MMA(1, 1, At, B1); PG8_BAR;
            PG8_LDB(B0, 1, 0); PG8_SCHED; PG8_LDA(At, 1, 0); PG8_STAGE(PG8_SA(0, 1), a2 + hstep, voffA);
            PG8_WAIT_L(8); PG8_BAR; PG8_WAIT_L(0); PG8_MMA(0, 0, At, B0); PG8_BAR; PG8_SCHED;
            PG8_LDB(B1, 1, 1); PG8_STAGE(PG8_SB(1, 0), b3, voffB);
            PG8_BAR; PG8_WAIT_L(0); PG8_MMA(0, 1, At, B1); PG8_BAR;
            PG8_LDA(At, 1, 1); PG8_STAGE(PG8_SA(1, 0), a3, voffA);
            PG8_BAR; PG8_WAIT_L(0); PG8_MMA(1, 0, At, B0); PG8_BAR; PG8_SCHED;
            PG8_STAGE(PG8_SB(1, 1), b3 + hstep, voffB);
            PG8_WAIT_V(6); PG8_BAR; PG8_MMA(1, 1, At, B1); PG8_BAR;
        }
        if constexpr (!Epi::AFTER_DRAIN) { for (int re_ = 0; re_ < Epi::REPS; ++re_) E(acc, cur, wr, wc, fr, fq); S.done(cur); }
        if (!has_next) break;
#pragma unroll
        for (int a = 0; a < 2; ++a)
#pragma unroll
            for (int b = 0; b < 2; ++b)
#pragma unroll
                for (int m = 0; m < 4; ++m)
#pragma unroll
                    for (int n = 0; n < 2; ++n) acc[a][b][m][n] = (f32x4){0.f, 0.f, 0.f, 0.f};
        cur = nxt; cA = nA; cB = nB; ++ui;
    }
    PG8_WAIT_V(0);
    if (wr == 0) PG8_BAR;
    PG8_BAR;
    if constexpr (Epi::AFTER_DRAIN) { E.fused(acc, cur, wr, wc, fr, fq, lds, wid, lane); S.done(cur); }
#undef PG8_SA
#undef PG8_SB
#undef PG8_STAGE
#undef PG8_LDA
#undef PG8_LDB
#undef PG8_MMA
#undef PG8_WAIT_V
#undef PG8_WAIT_L
#undef PG8_BAR
#undef PG8_SCHED
}
}


typedef unsigned short bf16_t;
constexpr int D = 1024, SEQ = 8192, CTX = 256, NLAT = 16384, NCTX = 512, NTOK = 16896, INC = 2304;
constexpr int C_WAQ = 768, C_WAK = 1280, C_WAV = 1408, C_DAQ = 1536, C_DAK = 1792, C_DAV = 2048;
constexpr int NEXP = 16384;
constexpr int HFP = SEQ + 288;
constexpr int HTP = NLAT;

constexpr size_t OFF_BAR  = 0;
constexpr size_t OFF_X    = 65536;
constexpr size_t OFF_HB   = OFF_X    + (size_t)NTOK * D * 4;
constexpr size_t OFF_P    = OFF_HB   + (size_t)NTOK * D * 2;
constexpr size_t OFF_U    = OFF_P    + (size_t)NTOK * INC * 4;
constexpr size_t OFF_Z1   = OFF_U    + (size_t)NCTX * 768 * 4;
constexpr size_t OFF_Y    = OFF_Z1   + (size_t)NCTX * 256 * 4;
constexpr size_t OFF_HF   = OFF_Y    + (size_t)NTOK * D * 2;
constexpr size_t OFF_HFC  = OFF_HF   + (size_t)2 * HFP * 1024 * 4;
constexpr size_t OFF_WIN  = OFF_HFC  + (size_t)CTX * 1024 * 4;
constexpr size_t OFF_WOUT = OFF_WIN  + (size_t)2 * INC * D * 2;
constexpr size_t OFF_WQ   = OFF_WOUT + (size_t)2 * D * D * 2;
constexpr size_t OFF_MODP = OFF_WQ   + (size_t)2 * 2048 * D * 2;
constexpr size_t OFF_MOD  = OFF_MODP + (size_t)16 * 2 * 3 * 6144 * 4;
constexpr size_t OFF_TAB  = OFF_MOD  + (size_t)2 * 3 * 6144 * 4;
constexpr size_t OFF_QD   = OFF_TAB  + (size_t)128 * 24 * 2 * 4;
constexpr size_t OFF_KD   = OFF_QD   + (size_t)NTOK * 256 * 2;
constexpr size_t OFF_VDT  = OFF_KD   + (size_t)NTOK * 256 * 2;
constexpr size_t OFF_KMAX = OFF_VDT  + (size_t)2 * 4 * 64 * (SEQ + CTX) * 2;
constexpr size_t OFF_HT   = OFF_KMAX + 256;
constexpr size_t OFF_YHT  = OFF_HT   + (size_t)768 * HTP * 4;
constexpr size_t OFF_TW   = OFF_YHT  + (size_t)256 * NLAT * 2;
constexpr size_t OFF_ZT   = OFF_HT   + (size_t)512 * HTP * 4;
constexpr size_t OFF_QW   = OFF_TW   + (size_t)16384 * 8;
constexpr size_t OFF_KW   = OFF_QW   + (size_t)NTOK * 512 * 2;
constexpr size_t OFF_VWT  = OFF_KW   + (size_t)NTOK * 128 * 2;
constexpr size_t OFF_K16  = OFF_VWT  + (size_t)2 * 2 * 64 * (SEQ + CTX) * 2;
constexpr size_t OFF_RIDX = OFF_K16  + (size_t)2 * 16 * 128 * 128 * 2;
constexpr size_t OFF_RGATE= OFF_RIDX + (size_t)NTOK * 128 * 4;
constexpr size_t OFF_RSU  = OFF_RGATE + (size_t)NTOK * 128 * 4;
constexpr size_t OFF_END  = OFF_RSU + (size_t)NTOK * 128 * 4;

constexpr int LDS_BAR_OFF = 139264;
constexpr int LDS_BYTES = 139264 + 256;

struct Params { const float* in[31]; float* out; unsigned char* ws; };

__device__ __forceinline__ bf16_t f2bf(float f) { unsigned u = __float_as_uint(f); u += 0x7FFFu + ((u >> 16) & 1u); return (bf16_t)(u >> 16); }
template <int M> __device__ __forceinline__ float swzx(float v) { return __int_as_float(__builtin_amdgcn_ds_swizzle(__float_as_int(v), (M << 10) | 0x1F)); }
template <int M> __device__ __forceinline__ int swzxi(int v) { return __builtin_amdgcn_ds_swizzle(v, (M << 10) | 0x1F); }
__device__ __forceinline__ float wave_sum(float v) {
    v += swzx<1>(v); v += swzx<2>(v); v += swzx<4>(v); v += swzx<8>(v); v += swzx<16>(v);
    return __int_as_float(__builtin_amdgcn_readlane(__float_as_int(v), 0)) + __int_as_float(__builtin_amdgcn_readlane(__float_as_int(v), 32));
}
__device__ __forceinline__ float wave_max(float v) {
    v = fmaxf(v, swzx<1>(v)); v = fmaxf(v, swzx<2>(v)); v = fmaxf(v, swzx<4>(v)); v = fmaxf(v, swzx<8>(v)); v = fmaxf(v, swzx<16>(v));
    return fmaxf(__int_as_float(__builtin_amdgcn_readlane(__float_as_int(v), 0)), __int_as_float(__builtin_amdgcn_readlane(__float_as_int(v), 32)));
}
typedef _Float16 h2v __attribute__((ext_vector_type(2)));
__device__ __forceinline__ float h2lo(unsigned w) { return (float)__builtin_bit_cast(h2v, w).x; }
__device__ __forceinline__ float h2hi(unsigned w) { return (float)__builtin_bit_cast(h2v, w).y; }
__device__ __forceinline__ float xor32(float v, int lane) { return __int_as_float(__builtin_amdgcn_ds_bpermute((lane ^ 32) << 2, __float_as_int(v))); }
__device__ __forceinline__ void wave_argmax(float& bv, int& bi) {
#define AM_STEP(M) { const float ov = swzx<M>(bv); const int oi = swzxi<M>(bi); if (ov > bv || (ov == bv && oi < bi)) { bv = ov; bi = oi; } }
    AM_STEP(1) AM_STEP(2) AM_STEP(4) AM_STEP(8) AM_STEP(16)
#undef AM_STEP
    const float v0 = __int_as_float(__builtin_amdgcn_readlane(__float_as_int(bv), 0)), v1 = __int_as_float(__builtin_amdgcn_readlane(__float_as_int(bv), 32));
    const int i0 = __builtin_amdgcn_readlane(bi, 0), i1 = __builtin_amdgcn_readlane(bi, 32);
    if (v1 > v0 || (v1 == v0 && i1 < i0)) { bv = v1; bi = i1; } else { bv = v0; bi = i0; }
}
__device__ __forceinline__ float rdlane(float v, int l) { return __int_as_float(__builtin_amdgcn_readlane(__float_as_int(v), l)); }
#define WAVE_SYNC() do { __builtin_amdgcn_fence(__ATOMIC_RELEASE, "wavefront"); __builtin_amdgcn_wave_barrier(); __builtin_amdgcn_fence(__ATOMIC_ACQUIRE, "wavefront"); } while (0)

struct EpiResid {
    static constexpr bool PERM = true, AFTER_DRAIN = false; static constexpr int REPS = 1;
    bf16_t* X; const float* mod; const float* srcL; const float* srcC; bool srcb;
    __device__ __forceinline__ void operator()(const pg8::f32x4 (&acc)[2][2][4][2], const pg8::Unit& u, int wr, int wc, int fr, int fq) const {
        using namespace pg8;
        const unsigned voff = (unsigned)((wr * 64 + fr) * D + wc * 32 + 8 * fq);
        const int col0 = u.pn * BM;
        const int rb = u.pm < 32 ? 0 : (u.pm < 64 ? 1 : 2);
        const float* gate = mod + rb * 6144 + 2048 + col0 + wc * 32 + 8 * fq;
        bf16_t* const xt = X + (size_t)u.pm * BM * D + col0;
        const float* const st = (u.pm < 64 ? srcL + (size_t)u.pm * BM * D : srcC + (size_t)(u.pm - 64) * BM * D) + col0;
        f32x4 gv[2][2];
#pragma unroll
        for (int bj = 0; bj < 2; ++bj)
#pragma unroll
            for (int n = 0; n < 2; ++n) gv[bj][n] = *(const f32x4*)(gate + bj * HALF + n * 4);
#pragma unroll
        for (int ai = 0; ai < 2; ++ai) {
            if (srcb) {
                u32x4 sb[4][2];
#pragma unroll
                for (int m = 0; m < 4; ++m) { const bf16_t* srcp = xt + (size_t)(ai * HALF + m * 16) * D;
#pragma unroll
                    for (int bj = 0; bj < 2; ++bj) sb[m][bj] = *(const u32x4*)(srcp + voff + bj * HALF); }
#pragma unroll
                for (int m = 0; m < 4; ++m) { bf16_t* rowp = xt + (size_t)(ai * HALF + m * 16) * D;
#pragma unroll
                    for (int bj = 0; bj < 2; ++bj) {
                        const f32x4 r0 = (f32x4){__uint_as_float(sb[m][bj].x << 16), __uint_as_float(sb[m][bj].x & 0xffff0000u), __uint_as_float(sb[m][bj].y << 16), __uint_as_float(sb[m][bj].y & 0xffff0000u)};
                        const f32x4 r1 = (f32x4){__uint_as_float(sb[m][bj].z << 16), __uint_as_float(sb[m][bj].z & 0xffff0000u), __uint_as_float(sb[m][bj].w << 16), __uint_as_float(sb[m][bj].w & 0xffff0000u)};
                        const f32x4 v0 = r0 + gv[bj][0] * acc[ai][bj][m][0], v1 = r1 + gv[bj][1] * acc[ai][bj][m][1];
                        u32x4 w; w.x = cvt_pk_bf16(v0[0], v0[1]); w.y = cvt_pk_bf16(v0[2], v0[3]); w.z = cvt_pk_bf16(v1[0], v1[1]); w.w = cvt_pk_bf16(v1[2], v1[3]);
                        *(u32x4*)(rowp + voff + bj * HALF) = w; } }
            } else {
                f32x4 sv[4][2][2];
#pragma unroll
                for (int m = 0; m < 4; ++m) { const float* srcp = st + (size_t)(ai * HALF + m * 16) * D;
#pragma unroll
                    for (int bj = 0; bj < 2; ++bj)
#pragma unroll
                        for (int n = 0; n < 2; ++n) sv[m][bj][n] = *(const f32x4*)(srcp + voff + bj * HALF + n * 4); }
#pragma unroll
                for (int m = 0; m < 4; ++m) { bf16_t* rowp = xt + (size_t)(ai * HALF + m * 16) * D;
#pragma unroll
                    for (int bj = 0; bj < 2; ++bj) { const f32x4 v0 = sv[m][bj][0] + gv[bj][0] * acc[ai][bj][m][0], v1 = sv[m][bj][1] + gv[bj][1] * acc[ai][bj][m][1];
                        u32x4 w; w.x = cvt_pk_bf16(v0[0], v0[1]); w.y = cvt_pk_bf16(v0[2], v0[3]); w.z = cvt_pk_bf16(v1[0], v1[1]); w.w = cvt_pk_bf16(v1[2], v1[3]);
                        *(u32x4*)(rowp + voff + bj * HALF) = w; } }
            } }
    }
};

__device__ __forceinline__ void transpose_convert(const float* __restrict__ src, bf16_t* __restrict__ dst, int K, int N, size_t gtid, size_t gsz) {
    const size_t items = (size_t)N * (K / 8);
    for (size_t idx = gtid; idx < items; idx += gsz) {
        const int n = (int)(idx % N), k8 = (int)(idx / N);
        unsigned w[4];
#pragma unroll
        for (int j = 0; j < 4; ++j) {
            const float a = src[(size_t)(k8 * 8 + 2 * j) * N + n], b = src[(size_t)(k8 * 8 + 2 * j + 1) * N + n];
            w[j] = (unsigned)f2bf(a) | ((unsigned)f2bf(b) << 16);
        }
        *(uint4*)(dst + (size_t)n * K + k8 * 8) = make_uint4(w[0], w[1], w[2], w[3]);
    }
}

__device__ __forceinline__ void norm_phase(const float* __restrict__ X, const float* __restrict__ XC, const float* __restrict__ g, const float* __restrict__ modl, int shift_off, int scale_off, int nrows,
                                           bf16_t* __restrict__ Hb, int gwave, int nwaves, int lane) {
    for (int row = gwave; row < nrows; row += nwaves) {
        const int r = row < NLAT ? (row >> 13) : 2;
        const float4* xr = (const float4*)(row < NLAT ? X + (size_t)row * D : XC + (size_t)(row - NLAT) * D);
        float4 v[4]; float ss = 0.f;
#pragma unroll
        for (int j = 0; j < 4; ++j) { v[j] = xr[lane + 64 * j]; ss += v[j].x * v[j].x + v[j].y * v[j].y + v[j].z * v[j].z + v[j].w * v[j].w; }
        ss = wave_sum(ss);
        const float rs = rsqrtf(ss * (1.f / D) + 1e-6f);
        const float4* g4 = (const float4*)g;
        const float4* sh4 = (const float4*)(modl + r * 6144 + shift_off);
        const float4* sc4 = (const float4*)(modl + r * 6144 + scale_off);
#pragma unroll
        for (int j = 0; j < 4; ++j) {
            const float4 gg = g4[lane + 64 * j], sh = sh4[lane + 64 * j], sc = sc4[lane + 64 * j];
            const float a = v[j].x * rs * gg.x * (1.f + sc.x) + sh.x, b = v[j].y * rs * gg.y * (1.f + sc.y) + sh.y;
            const float c = v[j].z * rs * gg.z * (1.f + sc.z) + sh.z, d = v[j].w * rs * gg.w * (1.f + sc.w) + sh.w;
            uint2 w; w.x = (unsigned)f2bf(a) | ((unsigned)f2bf(b) << 16); w.y = (unsigned)f2bf(c) | ((unsigned)f2bf(d) << 16);
            *(uint2*)(Hb + (size_t)row * D + 4 * (lane + 64 * j)) = w;
        }
    }
}
__device__ __forceinline__ void norm_phase_b(const bf16_t* __restrict__ XB, const float* __restrict__ g, const float* __restrict__ modl, int shift_off, int scale_off, int nrows,
                                             bf16_t* __restrict__ Hb, int gwave, int nwaves, int lane) {
    for (int row = gwave; row < nrows; row += nwaves) {
        const int r = row < NLAT ? (row >> 13) : 2;
        const uint4* xr = (const uint4*)(XB + (size_t)row * D);
        float v[2][8]; float ss = 0.f;
#pragma unroll
        for (int j = 0; j < 2; ++j) { const uint4 w = xr[lane + 64 * j]; const unsigned ww[4] = {w.x, w.y, w.z, w.w};
#pragma unroll
            for (int i = 0; i < 4; ++i) { v[j][2 * i] = __uint_as_float(ww[i] << 16); v[j][2 * i + 1] = __uint_as_float(ww[i] & 0xffff0000u); ss += v[j][2 * i] * v[j][2 * i] + v[j][2 * i + 1] * v[j][2 * i + 1]; } }
        ss = wave_sum(ss);
        const float rs = rsqrtf(ss * (1.f / D) + 1e-6f);
        const float4* g4 = (const float4*)g;
        const float4* sh4 = (const float4*)(modl + r * 6144 + shift_off);
        const float4* sc4 = (const float4*)(modl + r * 6144 + scale_off);
#pragma unroll
        for (int j = 0; j < 2; ++j) {
            unsigned o[4];
#pragma unroll
            for (int hf = 0; hf < 2; ++hf) { const int q = 2 * (lane + 64 * j) + hf; const float4 gg = g4[q], sh = sh4[q], sc = sc4[q];
                const float a = v[j][4 * hf] * rs * gg.x * (1.f + sc.x) + sh.x, b = v[j][4 * hf + 1] * rs * gg.y * (1.f + sc.y) + sh.y;
                const float c = v[j][4 * hf + 2] * rs * gg.z * (1.f + sc.z) + sh.z, d = v[j][4 * hf + 3] * rs * gg.w * (1.f + sc.w) + sh.w;
                o[2 * hf] = (unsigned)f2bf(a) | ((unsigned)f2bf(b) << 16); o[2 * hf + 1] = (unsigned)f2bf(c) | ((unsigned)f2bf(d) << 16); }
            *(uint4*)(Hb + (size_t)row * D + 8 * (lane + 64 * j)) = make_uint4(o[0], o[1], o[2], o[3]);
        }
    }
}

typedef short bf16x8 __attribute__((ext_vector_type(8)));
typedef float f32x16 __attribute__((ext_vector_type(16)));
typedef float f32x2v __attribute__((ext_vector_type(2)));
typedef __bf16 bf16x2v __attribute__((ext_vector_type(2)));
typedef unsigned u32x4v __attribute__((ext_vector_type(4)));
__device__ __forceinline__ unsigned pk_bf16(float a, float b) { f32x2v v = {a, b}; return __builtin_bit_cast(unsigned, __builtin_convertvector(v, bf16x2v)); }
constexpr int NKEY = SEQ + CTX;
constexpr int DA_ROWB = 144;
constexpr int DA_TILEB = 64 * DA_ROWB;

__device__ __forceinline__ void da_phase(int l, bool with_ctx, const bf16_t* __restrict__ Qd, const bf16_t* __restrict__ Kd, const bf16_t* __restrict__ VdT,
                                         const float* __restrict__ KMAXl, float lam, float lam_init, const float* __restrict__ gnorm, bf16_t* __restrict__ Y,
                                         LAS unsigned char* lds, int bid, int G, int tid) {
    const int lane = tid & 63, wave = __builtin_amdgcn_readfirstlane(tid >> 6);
    const int ql = lane & 31, hh = lane >> 5;
    const int nitems = 256 + (with_ctx ? 8 : 0);
    for (int it = bid; it < nitems; it += G) {
        int b, h, qrow0, kt0, kt1;
        if (it < 256) { b = it >> 7; h = (it >> 5) & 3; qrow0 = b * SEQ + (it & 31) * 256; kt0 = 0; kt1 = NKEY / 64; }
        else { const int j = it - 256; b = j >> 2; h = j & 3; qrow0 = NLAT + b * CTX; kt0 = SEQ / 64; kt1 = NKEY / 64; }
        const int qrow = qrow0 + wave * 32 + ql;
        bf16x8 qf[2][2];
        float cinit[2];
#pragma unroll
        for (int m = 0; m < 2; ++m) {
            float q2 = 0.f;
#pragma unroll
            for (int s = 0; s < 2; ++s) {
                const uint4 raw = *(const uint4*)(Qd + (size_t)qrow * 256 + h * 64 + m * 32 + s * 16 + hh * 8);
                qf[m][s] = __builtin_bit_cast(bf16x8, raw);
                const unsigned w[4] = {raw.x, raw.y, raw.z, raw.w};
#pragma unroll
                for (int e = 0; e < 4; ++e) { const float lo = __uint_as_float(w[e] << 16), hi = __uint_as_float(w[e] & 0xffff0000u); q2 += lo * lo + hi * hi; }
            }
            q2 += xor32(q2, lane);
            const float k2 = KMAXl[b * 8 + h * 2 + m];
            cinit[m] = -(sqrtf(q2) * sqrtf(k2) * 1.01f + 1e-3f);
        }
        f32x16 O[2][2];
#pragma unroll
        for (int m = 0; m < 2; ++m)
#pragma unroll
            for (int dt = 0; dt < 2; ++dt)
#pragma unroll
                for (int r = 0; r < 16; ++r) O[m][dt][r] = 0.f;
        float lsum[2] = {0.f, 0.f};
        const int srow = tid >> 3, sch = tid & 7;
        const bf16_t* vsrc = VdT + ((size_t)(b * 4 + h) * 64 + srow) * NKEY + sch * 8;
        const int soff = srow * DA_ROWB + sch * 16;
#define KROW_OF(kt) ((kt) < SEQ / 64 ? b * SEQ + (kt) * 64 : NLAT + b * CTX + ((kt) - SEQ / 64) * 64)
        {
            const uint4 kv = *(const uint4*)(Kd + (size_t)(KROW_OF(kt0) + srow) * 256 + h * 64 + sch * 8);
            const uint4 vv = *(const uint4*)(vsrc + (size_t)kt0 * 64);
            *(LAS u32x4v*)(lds + soff) = (u32x4v){kv.x, kv.y, kv.z, kv.w}; *(LAS u32x4v*)(lds + DA_TILEB + soff) = (u32x4v){vv.x, vv.y, vv.z, vv.w};
        }
        __syncthreads();
        int cur = 0;
        for (int kt = kt0; kt < kt1; ++kt) {
            uint4 kv = make_uint4(0, 0, 0, 0), vv = make_uint4(0, 0, 0, 0);
            const bool more = kt + 1 < kt1;
            if (more) { kv = *(const uint4*)(Kd + (size_t)(KROW_OF(kt + 1) + srow) * 256 + h * 64 + sch * 8); vv = *(const uint4*)(vsrc + (size_t)(kt + 1) * 64); }
            const LAS unsigned char* kb = lds + cur * 2 * DA_TILEB;
            const LAS unsigned char* vb = kb + DA_TILEB;
#pragma unroll
            for (int sub = 0; sub < 2; ++sub) {
                bf16x8 vf[2][2];
#pragma unroll
                for (int dt = 0; dt < 2; ++dt)
#pragma unroll
                    for (int s = 0; s < 2; ++s) vf[dt][s] = *(const LAS bf16x8*)(vb + (dt * 32 + ql) * DA_ROWB + (sub * 32 + s * 16 + hh * 8) * 2);
#pragma unroll
                for (int m = 0; m < 2; ++m) {
                    f32x16 S;
#pragma unroll
                    for (int r = 0; r < 16; ++r) S[r] = cinit[m];
#pragma unroll
                    for (int s = 0; s < 2; ++s) {
                        const bf16x8 kf = *(const LAS bf16x8*)(kb + (sub * 32 + ql) * DA_ROWB + m * 64 + s * 32 + hh * 16);
                        S = __builtin_amdgcn_mfma_f32_32x32x16_bf16(kf, qf[m][s], S, 0, 0, 0);
                    }
                    float pe[16]; float ls = 0.f;
#pragma unroll
                    for (int r = 0; r < 16; ++r) { pe[r] = __builtin_amdgcn_exp2f(S[r]); ls += pe[r]; }
                    lsum[m] += ls;
                    bf16x8 pf[2];
#pragma unroll
                    for (int s = 0; s < 2; ++s) {
                        uint4 w; w.x = pk_bf16(pe[8 * s], pe[8 * s + 1]); w.y = pk_bf16(pe[8 * s + 2], pe[8 * s + 3]); w.z = pk_bf16(pe[8 * s + 4], pe[8 * s + 5]); w.w = pk_bf16(pe[8 * s + 6], pe[8 * s + 7]);
                        pf[s] = __builtin_bit_cast(bf16x8, w);
                    }
#pragma unroll
                    for (int dt = 0; dt < 2; ++dt)
#pragma unroll
                        for (int s = 0; s < 2; ++s) O[m][dt] = __builtin_amdgcn_mfma_f32_32x32x16_bf16(vf[dt][s], pf[s], O[m][dt], 0, 0, 0);
                }
            }
            if (more) { LAS unsigned char* nb = lds + (cur ^ 1) * 2 * DA_TILEB; *(LAS u32x4v*)(nb + soff) = (u32x4v){kv.x, kv.y, kv.z, kv.w}; *(LAS u32x4v*)(nb + DA_TILEB + soff) = (u32x4v){vv.x, vv.y, vv.z, vv.w}; }
            __syncthreads();
            cur ^= 1;
        }
#undef KROW_OF
        const float l0 = lsum[0] + xor32(lsum[0], lane), l1 = lsum[1] + xor32(lsum[1], lane);
        const float i0 = 1.f / l0, i1 = lam / l1;
        float ss = 0.f;
#pragma unroll
        for (int dt = 0; dt < 2; ++dt)
#pragma unroll
            for (int r = 0; r < 16; ++r) { const float o = O[0][dt][r] * i0 - O[1][dt][r] * i1; O[0][dt][r] = o; ss += o * o; }
        ss += xor32(ss, lane);
        const float rn = rsqrtf(ss * (1.f / 64.f) + 1e-6f) * (1.f - lam_init);
        bf16_t* yrow = Y + (size_t)qrow * D + 768 + h * 64;
        const float* gn = gnorm; asm volatile("" : "+s"(gn));
#pragma unroll
        for (int dt = 0; dt < 2; ++dt)
#pragma unroll
            for (int rg = 0; rg < 4; ++rg) {
                const int d0 = 32 * dt + 8 * rg + 4 * hh;
                const float4 g4 = *(const float4*)(gn + d0);
                uint2 w; w.x = pk_bf16(O[0][dt][4 * rg] * rn * g4.x, O[0][dt][4 * rg + 1] * rn * g4.y); w.y = pk_bf16(O[0][dt][4 * rg + 2] * rn * g4.z, O[0][dt][4 * rg + 3] * rn * g4.w);
                *(uint2*)(yrow + d0) = w;
            }
    }
}

__device__ __forceinline__ void wa_phase(bool with_ctx, const bf16_t* __restrict__ Qw, const bf16_t* __restrict__ Kw, const bf16_t* __restrict__ VwT,
                                         const float* __restrict__ KMAXWl, const float* __restrict__ sinkl, bf16_t* __restrict__ Y,
                                         LAS unsigned char* lds, int bid, int G, int tid) {
    const int lane = tid & 63, wave = __builtin_amdgcn_readfirstlane(tid >> 6);
    const int ql = lane & 31, hh = lane >> 5;
    const int nitems = 256 + (with_ctx ? 8 : 0);
    for (int it = bid; it < nitems; it += G) {
        int b, hkv, qrow0, pos0, tlo, nloc;
        if (it < 256) { b = it >> 7; hkv = (it >> 6) & 1; const int qb = it & 63; qrow0 = b * SEQ + qb * 128; pos0 = qb * 128;
            tlo = 2 * qb - 2 < 0 ? 0 : 2 * qb - 2; const int thi = 2 * qb + 3 > SEQ / 64 - 1 ? SEQ / 64 - 1 : 2 * qb + 3; nloc = thi - tlo + 1; }
        else { const int j = it - 256; b = j >> 2; hkv = (j >> 1) & 1; qrow0 = NLAT + b * CTX + (j & 1) * 128; pos0 = 0; tlo = 0; nloc = 0; }
        const int ntile = nloc + CTX / 64;
        const int hq = hkv * 4 + (wave & 3), rg0 = wave >> 2;
        const float sink2 = sinkl[hq] * 1.4426950408889634f;
        bf16x8 qf[2][4]; float cinit[2]; int qrow[2], qpos[2];
#pragma unroll
        for (int tk = 0; tk < 2; ++tk) {
            qrow[tk] = qrow0 + (rg0 + 2 * tk) * 32 + ql; qpos[tk] = pos0 + (rg0 + 2 * tk) * 32 + ql;
            float q2 = 0.f;
#pragma unroll
            for (int s = 0; s < 4; ++s) {
                const uint4 raw = *(const uint4*)(Qw + (size_t)qrow[tk] * 512 + hq * 64 + s * 16 + hh * 8);
                qf[tk][s] = __builtin_bit_cast(bf16x8, raw);
                const unsigned w[4] = {raw.x, raw.y, raw.z, raw.w};
#pragma unroll
                for (int e = 0; e < 4; ++e) { const float lo = __uint_as_float(w[e] << 16), hi = __uint_as_float(w[e] & 0xffff0000u); q2 += lo * lo + hi * hi; }
            }
            q2 += xor32(q2, lane);
            cinit[tk] = -fmaxf(sqrtf(q2) * sqrtf(KMAXWl[b * 4 + hkv * 2] + KMAXWl[b * 4 + hkv * 2 + 1]) * 1.01f + 1e-3f, sink2);
        }
        f32x16 O[2][2];
#pragma unroll
        for (int tk = 0; tk < 2; ++tk)
#pragma unroll
            for (int dt = 0; dt < 2; ++dt)
#pragma unroll
                for (int r = 0; r < 16; ++r) O[tk][dt][r] = 0.f;
        float lsum[2] = {0.f, 0.f};
        const int srow = tid >> 3, sch = tid & 7;
        const bf16_t* vsrc = VwT + ((size_t)(b * 2 + hkv) * 64 + srow) * NKEY + sch * 8;
        const int soff = srow * DA_ROWB + sch * 16;
#define WKT(i) ((i) < nloc ? tlo + (i) : SEQ / 64 + ((i) - nloc))
#define WKROW(kt) ((kt) < SEQ / 64 ? b * SEQ + (kt) * 64 : NLAT + b * CTX + ((kt) - SEQ / 64) * 64)
        {
            const int kt = WKT(0);
            const uint4 kv = *(const uint4*)(Kw + (size_t)(WKROW(kt) + srow) * 128 + hkv * 64 + sch * 8);
            const uint4 vv = *(const uint4*)(vsrc + (size_t)kt * 64);
            *(LAS u32x4v*)(lds + soff) = (u32x4v){kv.x, kv.y, kv.z, kv.w}; *(LAS u32x4v*)(lds + DA_TILEB + soff) = (u32x4v){vv.x, vv.y, vv.z, vv.w};
        }
        __syncthreads();
        int cur = 0;
        for (int ti = 0; ti < ntile; ++ti) {
            const int kt = WKT(ti);
            uint4 kv = make_uint4(0, 0, 0, 0), vv = make_uint4(0, 0, 0, 0);
            const bool more = ti + 1 < ntile;
            if (more) { const int kn = WKT(ti + 1); kv = *(const uint4*)(Kw + (size_t)(WKROW(kn) + srow) * 128 + hkv * 64 + sch * 8); vv = *(const uint4*)(vsrc + (size_t)kn * 64); }
            const LAS unsigned char* kb = lds + cur * 2 * DA_TILEB;
            const LAS unsigned char* vb = kb + DA_TILEB;
            const bool local = kt < SEQ / 64;
#pragma unroll
            for (int sub = 0; sub < 2; ++sub) {
                const int k0 = kt * 64 + sub * 32;
                bf16x8 vf[2][2], kf[4];
#pragma unroll
                for (int dt = 0; dt < 2; ++dt)
#pragma unroll
                    for (int s = 0; s < 2; ++s) vf[dt][s] = *(const LAS bf16x8*)(vb + (dt * 32 + ql) * DA_ROWB + (sub * 32 + s * 16 + hh * 8) * 2);
#pragma unroll
                for (int s = 0; s < 4; ++s) kf[s] = *(const LAS bf16x8*)(kb + (sub * 32 + ql) * DA_ROWB + s * 32 + hh * 16);
#pragma unroll
                for (int tk = 0; tk < 2; ++tk) {
                    bool needmask = false;
                    if (local) { const int r0 = pos0 + (rg0 + 2 * tk) * 32;
                        if (k0 + 31 < r0 - 128 || k0 > r0 + 31 + 128) continue;
                        needmask = !(k0 >= r0 + 31 - 128 && k0 + 31 <= r0 + 128); }
                    f32x16 S;
#pragma unroll
                    for (int r = 0; r < 16; ++r) S[r] = cinit[tk];
#pragma unroll
                    for (int s = 0; s < 4; ++s) S = __builtin_amdgcn_mfma_f32_32x32x16_bf16(kf[s], qf[tk][s], S, 0, 0, 0);
                    float pe[16]; float ls = 0.f;
#pragma unroll
                    for (int r = 0; r < 16; ++r) pe[r] = __builtin_amdgcn_exp2f(S[r]);
                    if (needmask) {
                        int dbase = qpos[tk] - k0 - 4 * hh + 128; asm volatile("" : "+v"(dbase));
#pragma unroll
                        for (int r = 0; r < 16; ++r) { const unsigned dk = (unsigned)(dbase - ((r & 3) + 8 * (r >> 2))); pe[r] = dk <= 256u ? pe[r] : 0.f; } }
#pragma unroll
                    for (int r = 0; r < 16; ++r) ls += pe[r];
                    lsum[tk] += ls;
                    bf16x8 pf[2];
#pragma unroll
                    for (int s = 0; s < 2; ++s) {
                        uint4 w; w.x = pk_bf16(pe[8 * s], pe[8 * s + 1]); w.y = pk_bf16(pe[8 * s + 2], pe[8 * s + 3]); w.z = pk_bf16(pe[8 * s + 4], pe[8 * s + 5]); w.w = pk_bf16(pe[8 * s + 6], pe[8 * s + 7]);
                        pf[s] = __builtin_bit_cast(bf16x8, w);
                    }
#pragma unroll
                    for (int dt = 0; dt < 2; ++dt)
#pragma unroll
                        for (int s = 0; s < 2; ++s) O[tk][dt] = __builtin_amdgcn_mfma_f32_32x32x16_bf16(vf[dt][s], pf[s], O[tk][dt], 0, 0, 0);
                }
            }
            if (more) { LAS unsigned char* nb = lds + (cur ^ 1) * 2 * DA_TILEB; *(LAS u32x4v*)(nb + soff) = (u32x4v){kv.x, kv.y, kv.z, kv.w}; *(LAS u32x4v*)(nb + DA_TILEB + soff) = (u32x4v){vv.x, vv.y, vv.z, vv.w}; }
            __syncthreads();
            cur ^= 1;
        }
#undef WKT
#undef WKROW
#pragma unroll
        for (int tk = 0; tk < 2; ++tk) {
            const float lt = lsum[tk] + xor32(lsum[tk], lane) + __builtin_amdgcn_exp2f(sink2 + cinit[tk]);
            const float inv = 1.f / lt;
            bf16_t* yrow = Y + (size_t)qrow[tk] * D + 256 + hq * 64;
#pragma unroll
            for (int dt = 0; dt < 2; ++dt)
#pragma unroll
                for (int rg = 0; rg < 4; ++rg) {
                    const int d0 = 32 * dt + 8 * rg + 4 * hh;
                    uint2 w; w.x = pk_bf16(O[tk][dt][4 * rg] * inv, O[tk][dt][4 * rg + 1] * inv); w.y = pk_bf16(O[tk][dt][4 * rg + 2] * inv, O[tk][dt][4 * rg + 3] * inv);
                    *(uint2*)(yrow + d0) = w;
                }
        }
    }
}

#ifndef REP_EPI
#define REP_EPI 1
#endif
struct EpiInProj {
    static constexpr bool PERM = false, AFTER_DRAIN = false; static constexpr int REPS = REP_EPI;
    float* __restrict__ HT; float* __restrict__ PC; bf16_t* __restrict__ Qw; bf16_t* __restrict__ Kw; bf16_t* __restrict__ VwT; bf16_t* __restrict__ Qd; bf16_t* __restrict__ Kd; bf16_t* __restrict__ VdT; const unsigned* __restrict__ TABH; unsigned* __restrict__ KMX; int l;
    __device__ __forceinline__ void operator()(const pg8::f32x4 (&acc)[2][2][4][2], const pg8::Unit& u, int wr, int wc, int fr_in, int fq_in) const {
        using pg8::f32x4;
        int fr = fr_in, fq = fq_in; asm volatile("" : "+v"(fr), "+v"(fq));
        const int pn = u.pn, pm = u.pm;
        const bool lat = pm < 64;
        const int b = lat ? (pm >> 5) : (pm - 64);
        const int t0 = (lat ? (pm & 31) * 256 : 0) + wr * 64 + fr;
        const int grow0 = pm * 256 + wr * 64 + fr;
        const int lane = fq * 16 + fr;
        const float QSCW = 0.125f * 1.4426950408889634f, QSCD = 0.17677669529663687f * 1.4426950408889634f;
        if (pn < 3) {
            if (lat) {
#pragma unroll
                for (int bj = 0; bj < 2; ++bj)
#pragma unroll
                    for (int n = 0; n < 2; ++n) { float* hp = HT + (size_t)(pn * 256 + bj * 128 + wc * 32 + n * 16 + fq * 4) * HTP + grow0;
#pragma unroll
                        for (int ai = 0; ai < 2; ++ai)
#pragma unroll
                            for (int m = 0; m < 4; ++m) { const f32x4 v = acc[ai][bj][m][n]; float* q = hp + ai * 128 + m * 16;
                                q[0] = v[0]; q[HTP] = v[1]; q[2 * (size_t)HTP] = v[2]; q[3 * (size_t)HTP] = v[3]; } }
            } else {
#pragma unroll
                for (int ai = 0; ai < 2; ++ai)
#pragma unroll
                    for (int m = 0; m < 4; ++m) { float* rp = PC + (size_t)(grow0 - NLAT + ai * 128 + m * 16) * 768 + pn * 256 + wc * 32 + fq * 4;
#pragma unroll
                        for (int bj = 0; bj < 2; ++bj)
#pragma unroll
                            for (int n = 0; n < 2; ++n) *(f32x4*)(rp + bj * 128 + n * 16) = acc[ai][bj][m][n]; }
            }
        } else if (pn < 5 || (pn == 5)) {
            float kmx = 0.f;
            const int halfw = wc & 1;
            pg8::u32x4 cw[4];
#pragma unroll
            for (int i = 0; i < 4; ++i) { const int pos = lat ? (halfw ? ((t0 + 16 * i) & 63) : ((t0 + 128 * (i & 1)) >> 6)) : 0;
                cw[i] = *(const pg8::u32x4*)(TABH + pos * 24 + fq * 4); }
#pragma unroll
            for (int bj = 0; bj < 2; ++bj) {
                const int g32 = bj * 4 + wc;
                if (pn == 5 && bj == 1) {
                    const int pf = fr < 4 ? fr : (fr < 8 ? fr + 4 : (fr < 12 ? fr - 4 : fr));
                    const int kbase = (lat ? (pm & 31) * 256 : SEQ) + wr * 64 + pf;
#pragma unroll
                    for (int n = 0; n < 2; ++n)
#pragma unroll
                        for (int j = 0; j < 4; ++j) { bf16_t* vp = VwT + ((size_t)(b * 2 + (wc >> 1)) * 64 + (wc & 1) * 32 + n * 16 + fq * 4 + j) * NKEY + kbase;
#pragma unroll
                            for (int ai = 0; ai < 2; ++ai)
#pragma unroll
                                for (int m = 0; m < 4; ++m) vp[ai * 128 + m * 16] = f2bf(acc[ai][bj][m][n][j]); }
                } else {
                    const int half = g32 & 1;
#pragma unroll
                    for (int ai = 0; ai < 2; ++ai)
#pragma unroll
                        for (int m = 0; m < 4; ++m) {
                            const pg8::u32x4 ce = halfw ? cw[m] : cw[ai];
                            const f32x4 x1 = acc[ai][bj][m][0], x2 = acc[ai][bj][m][1];
                            const float cs[4] = {h2lo(ce.x), h2lo(ce.y), h2lo(ce.z), h2lo(ce.w)}, sn[4] = {h2hi(ce.x), h2hi(ce.y), h2hi(ce.z), h2hi(ce.w)};
                            float y1[4], y2[4];
#pragma unroll
                            for (int j = 0; j < 4; ++j) { y1[j] = x1[j] * cs[j] - x2[j] * sn[j]; y2[j] = x2[j] * cs[j] + x1[j] * sn[j]; }
                            const size_t grow = (size_t)(grow0 + ai * 128 + m * 16);
                            if (pn < 5) { bf16_t* qp = Qw + grow * 512 + ((pn - 3) * 4 + (g32 >> 1)) * 64 + half * 32 + fq * 8;
                                *(uint4*)qp = make_uint4(pk_bf16(y1[0] * QSCW, y1[1] * QSCW), pk_bf16(y1[2] * QSCW, y1[3] * QSCW), pk_bf16(y2[0] * QSCW, y2[1] * QSCW), pk_bf16(y2[2] * QSCW, y2[3] * QSCW)); }
                            else { bf16_t* kp = Kw + grow * 128 + (wc >> 1) * 64 + half * 32 + fq * 8;
                                *(uint4*)kp = make_uint4(pk_bf16(y1[0], y1[1]), pk_bf16(y1[2], y1[3]), pk_bf16(y2[0], y2[1]), pk_bf16(y2[2], y2[3]));
                                float sq = 0.f;
#pragma unroll
                                for (int j = 0; j < 4; ++j) sq += y1[j] * y1[j] + y2[j] * y2[j];
                                sq += swzx<16>(sq); sq += xor32(sq, lane);
                                kmx = fmaxf(kmx, sq); }
                            __builtin_amdgcn_sched_barrier(0);
                        }
                }
            }
            if (pn == 5) {
                kmx = fmaxf(kmx, swzx<1>(kmx)); kmx = fmaxf(kmx, swzx<2>(kmx)); kmx = fmaxf(kmx, swzx<4>(kmx)); kmx = fmaxf(kmx, swzx<8>(kmx));
                if (lane == 0) atomicMax(KMX + 32 + l * 8 + b * 4 + wc, __float_as_uint(kmx));
            }
        } else if (pn < 8) {
            const int hi = fq >> 1;
            float kmx[2] = {0.f, 0.f};
            pg8::u32x4 ca[2], cm[4];
#pragma unroll
            for (int ai = 0; ai < 2; ++ai) { const int pos = lat ? ((t0 + ai * 128) >> 6) : 0; ca[ai] = *(const pg8::u32x4*)(TABH + pos * 24 + 16 + (fq & 1) * 4); }
#pragma unroll
            for (int m = 0; m < 4; ++m) { const int pos = lat ? ((t0 + m * 16) & 63) : 0; cm[m] = *(const pg8::u32x4*)(TABH + pos * 24 + 16 + (fq & 1) * 4); }
#pragma unroll
            for (int bj = 0; bj < 2; ++bj) {
                const int g32 = bj * 4 + wc;
#pragma unroll
                for (int ai = 0; ai < 2; ++ai)
#pragma unroll
                    for (int m = 0; m < 4; ++m) {
                        const size_t grow = (size_t)(grow0 + ai * 128 + m * 16);
                        float sq = 0.f; unsigned wq[4];
#pragma unroll
                        for (int n = 0; n < 2; ++n) {
                            const pg8::u32x4 ce = n ? cm[m] : ca[ai];
                            const float cs[4] = {h2lo(ce.x), h2lo(ce.y), h2lo(ce.z), h2lo(ce.w)}, sn[4] = {h2hi(ce.x), h2hi(ce.y), h2hi(ce.z), h2hi(ce.w)};
                            const f32x4 own = acc[ai][bj][m][n];
                            float y[4];
#pragma unroll
                            for (int j = 0; j < 4; ++j) { const float oth = xor32(own[j], lane); y[j] = hi ? (own[j] * cs[j] + oth * sn[j]) : (own[j] * cs[j] - oth * sn[j]); sq += y[j] * y[j]; }
                            const float scl = pn == 6 ? QSCD : 1.f;
                            wq[2 * n] = pk_bf16(y[0] * scl, y[1] * scl); wq[2 * n + 1] = pk_bf16(y[2] * scl, y[3] * scl);
                        }
                        *(uint4*)((pn == 6 ? Qd : Kd) + grow * 256 + g32 * 32 + fq * 8) = make_uint4(wq[0], wq[1], wq[2], wq[3]);
                        if (pn == 7) { sq += swzx<16>(sq); sq += xor32(sq, lane); kmx[bj] = fmaxf(kmx[bj], sq); }
                        __builtin_amdgcn_sched_barrier(0);
                    }
            }
            if (pn == 7) {
#pragma unroll
                for (int bj = 0; bj < 2; ++bj) { float k = kmx[bj];
                    k = fmaxf(k, swzx<1>(k)); k = fmaxf(k, swzx<2>(k)); k = fmaxf(k, swzx<4>(k)); k = fmaxf(k, swzx<8>(k));
                    if (lane == 0) atomicMax(KMX + l * 16 + b * 8 + bj * 4 + wc, __float_as_uint(k)); }
            }
        } else {
            const int pf = fr < 4 ? fr : (fr < 8 ? fr + 4 : (fr < 12 ? fr - 4 : fr));
            const int kbase = (lat ? (pm & 31) * 256 : SEQ) + wr * 64 + pf;
#pragma unroll
            for (int bj = 0; bj < 2; ++bj) { const int g32 = bj * 4 + wc;
#pragma unroll
                for (int n = 0; n < 2; ++n)
#pragma unroll
                    for (int j = 0; j < 4; ++j) { bf16_t* vp = VdT + ((size_t)(b * 4 + (g32 >> 1)) * 64 + (g32 & 1) * 32 + n * 16 + fq * 4 + j) * NKEY + kbase;
#pragma unroll
                        for (int ai = 0; ai < 2; ++ai)
#pragma unroll
                            for (int m = 0; m < 4; ++m) vp[ai * 128 + m * 16] = f2bf(acc[ai][bj][m][n][j]); } }
        }
    }
};

static constexpr float CT32[32] = {1.f, 0.98078528f, 0.923879533f, 0.831469612f, 0.707106781f, 0.555570233f, 0.382683432f, 0.195090322f, 0.f, -0.195090322f, -0.382683432f, -0.555570233f,
    -0.707106781f, -0.831469612f, -0.923879533f, -0.98078528f, -1.f, -0.98078528f, -0.923879533f, -0.831469612f, -0.707106781f, -0.555570233f, -0.382683432f, -0.195090322f, 0.f, 0.195090322f,
    0.382683432f, 0.555570233f, 0.707106781f, 0.831469612f, 0.923879533f, 0.98078528f};
__host__ __device__ constexpr int br5(int i) { return ((i & 1) << 4) | ((i & 2) << 2) | (i & 4) | ((i & 8) >> 2) | ((i & 16) >> 4); }
__host__ __device__ constexpr int br4(int i) { return ((i & 1) << 3) | ((i & 2) << 1) | ((i & 4) >> 1) | ((i & 8) >> 3); }
template <int R, bool INV, int OFF> __device__ __forceinline__ void fft_dif(float (&re)[32], float (&im)[32]) {
#pragma unroll
    for (int len = R; len >= 2; len >>= 1) {
        const int half = len >> 1, step = 32 / len;
#pragma unroll
        for (int base = 0; base < R; base += len) {
#pragma unroll
            for (int j = 0; j < half; ++j) {
                const int a = OFF + base + j, b = a + half;
                const float ar = re[a], ai = im[a], br = re[b], bi = im[b];
                re[a] = ar + br; im[a] = ai + bi;
                const float dr = ar - br, di = ai - bi;
                const float c = CT32[(j * step) & 31], s0 = CT32[(j * step + 24) & 31];
                const float s = INV ? s0 : -s0;
                re[b] = dr * c - di * s; im[b] = dr * s + di * c;
            }
        }
    }
}
template <int R, bool INV, int OFF> __device__ __forceinline__ void fft_dit(float (&re)[32], float (&im)[32]) {
#pragma unroll
    for (int len = 2; len <= R; len <<= 1) {
        const int half = len >> 1, step = 32 / len;
#pragma unroll
        for (int base = 0; base < R; base += len) {
#pragma unroll
            for (int j = 0; j < half; ++j) {
                const int a = OFF + base + j, b = a + half;
                const float c = CT32[(j * step) & 31], s0 = CT32[(j * step + 24) & 31];
                const float s = INV ? s0 : -s0;
                const float tr = re[b] * c - im[b] * s, ti = re[b] * s + im[b] * c;
                const float ar = re[a], ai = im[a];
                re[a] = ar + tr; im[a] = ai + ti; re[b] = ar - tr; im[b] = ai - ti;
            }
        }
    }
}
constexpr int FFT_L1P = 528;
constexpr int FFT_LDS_BYTES = 1024 * 17 * 8;
__device__ __forceinline__ void fft16k_fwd(float (&re)[32], float (&im)[32], LAS f32x2v* L, const float2* __restrict__ TW, int tid_in) {
    int tid = tid_in; asm volatile("" : "+v"(tid));
    fft_dif<32, false, 0>(re, im);
    { const float2 w = TW[16 * (tid >> 4)]; float pr = 1.f, pi = 0.f;
#pragma unroll
      for (int k = 0; k < 32; ++k) { const int idx = br5(k); const float xr = re[idx], xi = im[idx];
          re[idx] = xr * pr - xi * pi; im[idx] = xr * pi + xi * pr;
          const float npr = pr * w.x + pi * w.y, npi = pi * w.x - pr * w.y; pr = npr; pi = npi; } }
    __syncthreads();
#pragma unroll
    for (int i = 0; i < 32; ++i) L[br5(i) * FFT_L1P + tid] = (f32x2v){re[i], im[i]};
    __syncthreads();
    asm volatile("" : "+v"(tid));
    const int k1 = tid >> 4, n3 = tid & 15;
#pragma unroll
    for (int n2 = 0; n2 < 32; ++n2) { const f32x2v v = L[k1 * FFT_L1P + n2 * 16 + n3]; re[n2] = v.x; im[n2] = v.y; }
    __syncthreads();
    fft_dif<32, false, 0>(re, im);
    { const float2 b0 = TW[n3 * k1], st = TW[32 * n3]; float pr = b0.x, pi = -b0.y;
#pragma unroll
      for (int k = 0; k < 32; ++k) { const int idx = br5(k); const float xr = re[idx], xi = im[idx];
          re[idx] = xr * pr - xi * pi; im[idx] = xr * pi + xi * pr;
          const float npr = pr * st.x + pi * st.y, npi = pi * st.x - pr * st.y; pr = npr; pi = npi; } }
#pragma unroll
    for (int i = 0; i < 32; ++i) L[(k1 * 32 + br5(i)) * 17 + n3] = (f32x2v){re[i], im[i]};
    __syncthreads();
#pragma unroll
    for (int h = 0; h < 2; ++h)
#pragma unroll
        for (int j = 0; j < 16; ++j) { const f32x2v v = L[(tid + 512 * h) * 17 + j]; re[16 * h + j] = v.x; im[16 * h + j] = v.y; }
    fft_dif<16, false, 0>(re, im);
    fft_dif<16, false, 16>(re, im);
}
__device__ __forceinline__ void fft16k_inv(float (&re)[32], float (&im)[32], LAS f32x2v* L, const float2* __restrict__ TW, int tid_in) {
    int tid = tid_in; asm volatile("" : "+v"(tid));
    fft_dit<16, true, 0>(re, im);
    fft_dit<16, true, 16>(re, im);
#pragma unroll
    for (int h = 0; h < 2; ++h) { const int pr_ = tid + 512 * h; const float2 st = TW[(pr_ >> 5) + 32 * (pr_ & 31)]; float pr = 1.f, pi = 0.f;
#pragma unroll
        for (int j = 0; j < 16; ++j) { const float xr = re[16 * h + j], xi = im[16 * h + j];
            re[16 * h + j] = xr * pr - xi * pi; im[16 * h + j] = xr * pi + xi * pr;
            const float npr = pr * st.x - pi * st.y, npi = pi * st.x + pr * st.y; pr = npr; pi = npi; } }
    __syncthreads();
#pragma unroll
    for (int h = 0; h < 2; ++h)
#pragma unroll
        for (int j = 0; j < 16; ++j) L[(tid + 512 * h) * 17 + j] = (f32x2v){re[16 * h + j], im[16 * h + j]};
    __syncthreads();
    asm volatile("" : "+v"(tid));
    const int k1 = tid >> 4, n3 = tid & 15;
#pragma unroll
    for (int i = 0; i < 32; ++i) { const f32x2v v = L[(k1 * 32 + br5(i)) * 17 + n3]; re[i] = v.x; im[i] = v.y; }
    __syncthreads();
    fft_dit<32, true, 0>(re, im);
    { const float2 st = TW[16 * k1]; float pr = 1.f, pi = 0.f;
#pragma unroll
      for (int n2 = 0; n2 < 32; ++n2) { const float xr = re[n2], xi = im[n2];
          re[n2] = xr * pr - xi * pi; im[n2] = xr * pi + xi * pr;
          const float npr = pr * st.x - pi * st.y, npi = pi * st.x + pr * st.y; pr = npr; pi = npi; } }
#pragma unroll
    for (int n2 = 0; n2 < 32; ++n2) L[k1 * FFT_L1P + n2 * 16 + n3] = (f32x2v){re[n2], im[n2]};
    __syncthreads();
#pragma unroll
    for (int i = 0; i < 32; ++i) { const f32x2v v = L[br5(i) * FFT_L1P + tid]; re[i] = v.x; im[i] = v.y; }
    fft_dit<32, true, 0>(re, im);
}
template <bool COS> __device__ __forceinline__ float hy_sincos(float x) {
    const float k = rintf(x * 0.63661977236758134f);
    float r = fmaf(k, -1.5703125f, x); r = fmaf(k, -4.837512969970703125e-4f, r); r = fmaf(k, -7.54978995489188216e-8f, r);
    const int q = (int)k + (COS ? 1 : 0);
    const float z = r * r;
    const float sp = fmaf(fmaf(fmaf(-1.9515295891e-4f, z, 8.3321608736e-3f), z, -1.6666654611e-1f) * z, r, r);
    const float cp = fmaf(fmaf(fmaf(2.443315711809948e-5f, z, -1.388731625493765e-3f), z, 4.166664568298827e-2f) * z, z, fmaf(-0.5f, z, 1.f));
    const float v = (q & 1) ? cp : sp;
    return (q & 2) ? -v : v;
}
template <int NP>
__device__ __forceinline__ void hy_filter_z2(const float* __restrict__ w1, const float* __restrict__ b1, const float* __restrict__ fr, const float* __restrict__ w2,
                                             const float* __restrict__ b2, int n, int t0, int lane, float (&z2)[NP]) {
    const float fq = fr[lane];
    float fe[NP], a1[NP], a2[NP], z1[NP];
#pragma unroll
    for (int q = 0; q < NP; ++q) {
        const int t = t0 + q;
        const float tt = (float)t / (float)(n - 1);
        fe[q] = 0.f;
        if (lane == 0) fe[q] = tt;
        else if (lane <= 32) {
            const int j = (lane - 1) & 15;
            const float band = 1e-4f + (float)j * ((15.f - 1e-4f) / 15.f);
            const float ph = ((float)(6.283185307179586 / (double)n) * (float)t) * band;
            fe[q] = lane <= 16 ? hy_sincos<true>(ph) : -hy_sincos<false>(ph);
        }
        a1[q] = b1[lane]; a2[q] = b2[lane];
    }
#pragma unroll
    for (int e = 0; e < 33; ++e) { const float w = w1[e * 64 + lane];
#pragma unroll
        for (int q = 0; q < NP; ++q) a1[q] += rdlane(fe[q], e) * w; }
#pragma unroll
    for (int q = 0; q < NP; ++q) z1[q] = hy_sincos<false>(fq * a1[q]);
#pragma unroll 16
    for (int i = 0; i < 64; ++i) { const float w = w2[i * 64 + lane];
#pragma unroll
        for (int q = 0; q < NP; ++q) a2[q] += rdlane(z1[q], i) * w; }
#pragma unroll
    for (int q = 0; q < NP; ++q) z2[q] = hy_sincos<false>(fq * a2[q]);
}

__device__ __forceinline__ void hyena_fft_phase(int l, const float* __restrict__ HT, const float* __restrict__ HFTl, const float2* __restrict__ TW, const float* __restrict__ cw,
                                                const float* __restrict__ cb, const float* __restrict__ hy_bias_l, bf16_t* __restrict__ YhT, float* ZT, float2* HS, LAS f32x2v* L, int bid, int G, int tid) {
    for (int c = bid; c < 256; c += G) {
        float re[32], im[32];
        float2* hs = HS + (size_t)bid * 32 * 512;
        float* z0 = ZT + (size_t)c * HTP; float* z1 = z0 + SEQ;
#pragma unroll 1
        for (int o = 0; o < 2; ++o) {
            int tq = tid; asm volatile("" : "+v"(tq));
            { const float* hf = HFTl + (size_t)((o * 2 + 0) * 256 + c) * HFP; const float* hb = HFTl + (size_t)((o * 2 + 1) * 256 + c) * HFP;
#pragma unroll
              for (int n1 = 0; n1 < 16; ++n1) { re[n1] = hf[512 * n1 + tq]; im[n1] = 0.f; }
              if (tq == 0) re[0] += hy_bias_l[o * 256 + c];
#pragma unroll
              for (int n1 = 16; n1 < 32; ++n1) { const int m = 16384 - (512 * n1 + tq); re[n1] = (m == 8192) ? 0.f : hb[m & 8191]; im[n1] = 0.f; } }
            fft16k_fwd(re, im, L, TW, tid);
#pragma unroll
            for (int i = 0; i < 32; ++i) hs[i * 512 + tq] = make_float2(re[i] * (1.f / 16384.f), im[i] * (1.f / 16384.f));
            asm volatile("" : "+v"(tq));
            if (o == 0) {
                const int col = 512 + c; const float w0 = cw[col], w1 = cw[768 + col], w2 = cw[1536 + col], bb = cb[col];
                const float* h0 = HT + (size_t)col * HTP; const float* h1 = h0 + SEQ;
#pragma unroll
                for (int n1 = 0; n1 < 16; ++n1) { const int t = 512 * n1 + tq;
                    float a = bb + w1 * h0[t], b = bb + w1 * h1[t];
                    if (t > 0) { a += w0 * h0[t - 1]; b += w0 * h1[t - 1]; }
                    if (t < SEQ - 1) { a += w2 * h0[t + 1]; b += w2 * h1[t + 1]; }
                    re[n1] = a; im[n1] = b; }
            } else {
#pragma unroll
                for (int n1 = 0; n1 < 16; ++n1) { re[n1] = z0[512 * n1 + tq]; im[n1] = z1[512 * n1 + tq]; }
            }
#pragma unroll
            for (int n1 = 16; n1 < 32; ++n1) { re[n1] = 0.f; im[n1] = 0.f; }
            fft16k_fwd(re, im, L, TW, tid);
            asm volatile("" : "+v"(tq));
#pragma unroll
            for (int i = 0; i < 32; ++i) { const float2 hv = hs[i * 512 + tq]; const float a = re[i], b = im[i]; re[i] = a * hv.x - b * hv.y; im[i] = a * hv.y + b * hv.x; }
            fft16k_inv(re, im, L, TW, tid);
            asm volatile("" : "+v"(tq));
            { const int col = o * 256 + c; const float w0 = cw[col], w1 = cw[768 + col], w2 = cw[1536 + col], bb = cb[col];
              const float* h0 = HT + (size_t)col * HTP; const float* h1 = h0 + SEQ;
#pragma unroll
              for (int n1 = 0; n1 < 16; ++n1) { const int t = 512 * n1 + tq;
                  float a = bb + w1 * h0[t], b = bb + w1 * h1[t];
                  if (t > 0) { a += w0 * h0[t - 1]; b += w0 * h1[t - 1]; }
                  if (t < SEQ - 1) { a += w2 * h0[t + 1]; b += w2 * h1[t + 1]; }
                  const float ra = a * re[n1], rb = b * im[n1];
                  if (o == 0) { z0[t] = ra; z1[t] = rb; }
                  else { YhT[(size_t)c * NLAT + t] = f2bf(ra); YhT[(size_t)c * NLAT + SEQ + t] = f2bf(rb); } } }
        }
    }
}

__device__ __forceinline__ void hyena_ctx_fused(int l, const float* __restrict__ PC, const float* __restrict__ cw, const float* __restrict__ cb, bf16_t* __restrict__ Y,
                                                const float* __restrict__ Z2C, const float* __restrict__ w3, const float* __restrict__ dec, const float* __restrict__ hy_bias, float* ldsf, int bid, int G, int tid) {
    const int lane = tid & 63, c = __builtin_amdgcn_readfirstlane(tid >> 6);
    float* zb = ldsf;
    float* z1 = ldsf + 2048;
    float* comb = ldsf + 4096;
    for (int it = bid; it < 64; it += G) {
        const int s = it >> 5, c0 = (it & 31) * 8, rowbase = s * CTX;
        for (int idx = tid; idx < 2048; idx += NT) { const int t = idx >> 3, cc = idx & 7, col = 512 + c0 + cc;
            const float* pp = PC + (size_t)(rowbase + t) * 768 + col;
            float a = cb[col] + cw[768 + col] * pp[0];
            if (t > 0) a += cw[col] * pp[-768];
            if (t < CTX - 1) a += cw[1536 + col] * pp[768];
            zb[cc * 256 + t] = a; }
        float* w3s = ldsf + 4096 + 8192;
        float* z2s = w3s + 2048;
        for (int idx = tid; idx < 2048; idx += NT) { const int i = idx >> 5, q = idx & 31; w3s[idx] = w3[(size_t)i * 1024 + (q >> 3) * 256 + c0 + (q & 7)]; }
        for (int idx = tid; idx < 256 * 64; idx += NT) z2s[(idx >> 6) * 65 + (idx & 63)] = Z2C[idx];
        __syncthreads();
        for (int idx = tid; idx < 2 * 511 * 8; idx += NT) { const int cc = idx & 7, e = (idx >> 3) % 511, o = (idx >> 3) / 511, d = e - 255;
            const int ad = d >= 0 ? d : -d, q = (o * 2 + (d >= 0 ? 0 : 1)) * 8 + cc;
            float a = 0.f;
#pragma unroll 8
            for (int i = 0; i < 64; ++i) a += z2s[ad * 65 + i] * w3s[i * 32 + q];
            comb[(o * 8 + cc) * 512 + e] = a * expf(-((float)ad / (float)(CTX - 1)) * fabsf(dec[(q >> 3) * 256 + c0 + cc])); }
        __syncthreads();
#pragma unroll 1
        for (int o = 0; o < 2; ++o) {
            const float* zs = (o == 0 ? zb : z1) + c * 256;
            const float* cm = comb + (o * 8 + c) * 512 + 255 + lane;
            float acc[4] = {0.f, 0.f, 0.f, 0.f};
#pragma unroll 4
            for (int s2 = 0; s2 < CTX; ++s2) { const float zv = zs[s2];
#pragma unroll
                for (int k = 0; k < 4; ++k) acc[k] += cm[64 * k - s2] * zv; }
            const float bias = hy_bias[(l * 2 + o) * 256 + c0 + c];
            const int col = o * 256 + c0 + c; const float w0 = cw[col], w1 = cw[768 + col], w2 = cw[1536 + col], bb = cb[col];
#pragma unroll
            for (int k = 0; k < 4; ++k) { const int t = lane + 64 * k, row = rowbase + t;
                const float* pp = PC + (size_t)row * 768 + col;
                float gte = bb + w1 * pp[0];
                if (t > 0) gte += w0 * pp[-768];
                if (t < CTX - 1) gte += w2 * pp[768];
                const float res = gte * (acc[k] + bias * zs[t]);
                if (o == 0) z1[c * 256 + t] = res; else Y[(size_t)(NLAT + row) * D + c0 + c] = f2bf(res); }
            __syncthreads();
        }
    }
}

#define PK_CEX(a, b) do { const unsigned hi_ = (a) > (b) ? (a) : (b); const unsigned lo_ = (a) > (b) ? (b) : (a); (a) = hi_; (b) = lo_; } while (0)
__device__ __forceinline__ void sort16d(unsigned (&v)[16]) {
#pragma unroll
    for (int k = 2; k <= 16; k <<= 1)
#pragma unroll
        for (int j = k >> 1; j > 0; j >>= 1)
#pragma unroll
            for (int i = 0; i < 16; ++i) { const int l = i ^ j; if (l > i) { if ((i & k) == 0) PK_CEX(v[i], v[l]); else PK_CEX(v[l], v[i]); } }
}
__device__ __forceinline__ void merge16d(unsigned (&A)[16], const unsigned (&B)[16]) {
#pragma unroll
    for (int i = 0; i < 16; ++i) A[i] = A[i] > B[15 - i] ? A[i] : B[15 - i];
#pragma unroll
    for (int j = 8; j > 0; j >>= 1)
#pragma unroll
        for (int i = 0; i < 16; ++i) { const int l = i ^ j; if (l > i) PK_CEX(A[i], A[l]); }
}
constexpr int PK_PITCH = 272;
__device__ __forceinline__ void peer_top16(const bf16_t* __restrict__ qrow_p, const LAS unsigned char* Kl, int ql, int hh, int lane, unsigned (&L)[16]) {
    bf16x8 qf[8];
#pragma unroll
    for (int s = 0; s < 8; ++s) qf[s] = __builtin_bit_cast(bf16x8, *(const uint4*)(qrow_p + 16 * s + 8 * hh));
#pragma unroll
    for (int i = 0; i < 16; ++i) L[i] = 0u;
#pragma unroll 1
    for (int kt = 0; kt < 4; ++kt) {
        f32x16 S;
#pragma unroll
        for (int r = 0; r < 16; ++r) S[r] = 256.f;
        const LAS unsigned char* kp = Kl + (kt * 32 + ql) * PK_PITCH + 16 * hh;
#pragma unroll
        for (int s = 0; s < 8; ++s) { const bf16x8 kf = *(const LAS bf16x8*)(kp + 32 * s); S = __builtin_amdgcn_mfma_f32_32x32x16_bf16(kf, qf[s], S, 0, 0, 0); }
        unsigned T[16];
#pragma unroll
        for (int r = 0; r < 16; ++r) { const int key = kt * 32 + (r & 3) + 8 * (r >> 2) + 4 * hh; T[r] = (__float_as_uint(S[r]) & 0xffffff80u) | (unsigned)(127 - key); }
        sort16d(T);
        merge16d(L, T);
    }
    unsigned PL[16];
#pragma unroll
    for (int i = 0; i < 16; ++i) PL[i] = (unsigned)__builtin_amdgcn_ds_bpermute((lane ^ 32) << 2, (int)L[i]);
    merge16d(L, PL);
}
static constexpr int PEER_PA[16] = {2, 2, 2, 2, 2, 3, 3, 3, 3, 4, 4, 4, 5, 5, 6, 6};
static constexpr int PEER_PB[16] = {0, 1, 2, 3, 4, 0, 1, 2, 3, 0, 1, 2, 0, 1, 0, 1};
__device__ __forceinline__ unsigned peer_pairpk(unsigned p1, unsigned p2, int code) {
    const float sum = __uint_as_float(p1 & 0xffffff80u) + __uint_as_float(p2 & 0xffffff80u) - 256.f;
    return (__float_as_uint(sum) & 0xffffff00u) | (unsigned)(255 - code);
}
__device__ __forceinline__ void peer_route_phase(int Mrows, const bf16_t* __restrict__ Qb, const bf16_t* __restrict__ K16l, int* __restrict__ RIDX, float* __restrict__ RGATE, float* __restrict__ RSU, const float* __restrict__ SU,
                                                 LAS unsigned* ldsw, int bid_, int G_, int tid) {
    const int lane = tid & 63, wave = __builtin_amdgcn_readfirstlane(tid >> 6), ql = lane & 31, hh = lane >> 5;
    LAS unsigned* lw = ldsw + wave * 2048;
    const LAS unsigned char* kl = (const LAS unsigned char*)(ldsw + 8 * 2048);
    const int ntile = Mrows / 32, ngrp = ((ntile + 7) / 8) * 8;
    for (int grp = bid_; grp < ngrp; grp += G_) {
        const int h = grp & 7, tt = (grp >> 3) * 8 + wave;
        __syncthreads();
        for (int c = tid; c < 256 * 16; c += NT) { const int row = c >> 4, ch = c & 15;
            const uint4 v = *(const uint4*)(K16l + ((size_t)(h * 2) * 128 + row) * 128 + ch * 8);
            *(LAS u32x4v*)((LAS unsigned char*)kl + row * PK_PITCH + ch * 16) = (u32x4v){v.x, v.y, v.z, v.w}; }
        __syncthreads();
        if (tt < ntile) {
        const int token = tt * 32 + ql;
        unsigned L1[16], L2[16];
        peer_top16(Qb + (size_t)token * 2048 + h * 256, kl, ql, hh, lane, L1);
        peer_top16(Qb + (size_t)token * 2048 + h * 256 + 128, kl + 128 * PK_PITCH, ql, hh, lane, L2);
#pragma unroll
        for (int i = 0; i < 16; ++i) { lw[i * 64 + lane] = L1[i]; lw[1024 + i * 64 + lane] = L2[i]; }
        unsigned G0[16], G1[16], G2[16], G3[16];
#pragma unroll
        for (int b = 0; b < 16; ++b) G0[b] = peer_pairpk(L1[0], L2[b], b);
#pragma unroll
        for (int b = 0; b < 8; ++b) G1[b] = peer_pairpk(L1[1], L2[b], 16 + b);
#pragma unroll
        for (int a = 8; a < 16; ++a) G1[8 + (15 - a)] = peer_pairpk(L1[a], L2[0], a * 16);
#pragma unroll
        for (int j = 8; j > 0; j >>= 1)
#pragma unroll
            for (int i = 0; i < 16; ++i) { const int l2 = i ^ j; if (l2 > i) PK_CEX(G1[i], G1[l2]); }
#pragma unroll
        for (int n = 0; n < 16; ++n) G2[n] = peer_pairpk(L1[PEER_PA[n]], L2[PEER_PB[n]], PEER_PA[n] * 16 + PEER_PB[n]);
        G3[0] = peer_pairpk(L1[7], L2[0], 7 * 16); G3[1] = peer_pairpk(L1[7], L2[1], 7 * 16 + 1);
#pragma unroll
        for (int i = 2; i < 16; ++i) G3[i] = 0u;
        sort16d(G2);
        PK_CEX(G3[0], G3[1]);
        merge16d(G0, G1); merge16d(G2, G3); merge16d(G0, G2);
        float sc[16]; int ix[16]; float mx = -3.0e38f;
#pragma unroll
        for (int i = 0; i < 16; ++i) { const int code = 255 - (int)(G0[i] & 255u); const unsigned p1 = lw[(code >> 4) * 64 + lane], p2 = lw[1024 + (code & 15) * 64 + lane];
            sc[i] = __uint_as_float(p1 & 0xffffff80u) + __uint_as_float(p2 & 0xffffff80u) - 512.f; mx = fmaxf(mx, sc[i]);
            ix[i] = (127 - (int)(p1 & 127u)) * 128 + (127 - (int)(p2 & 127u)); }
        float sm = 0.f;
#pragma unroll
        for (int i = 0; i < 16; ++i) { sc[i] = __expf(sc[i] - mx); sm += sc[i]; }
        const float inv = 1.f / sm;
        int* ri = RIDX + (size_t)token * 128 + h * 16 + hh * 8; float* rg = RGATE + (size_t)token * 128 + h * 16 + hh * 8;
        int4 o0, o1; float4 g0, g1;
        o0.x = hh ? ix[8] : ix[0]; o0.y = hh ? ix[9] : ix[1]; o0.z = hh ? ix[10] : ix[2]; o0.w = hh ? ix[11] : ix[3];
        o1.x = hh ? ix[12] : ix[4]; o1.y = hh ? ix[13] : ix[5]; o1.z = hh ? ix[14] : ix[6]; o1.w = hh ? ix[15] : ix[7];
        const float* SV = SU + NEXP;
        g0.x = (hh ? sc[8] : sc[0]) * inv * SV[o0.x]; g0.y = (hh ? sc[9] : sc[1]) * inv * SV[o0.y]; g0.z = (hh ? sc[10] : sc[2]) * inv * SV[o0.z]; g0.w = (hh ? sc[11] : sc[3]) * inv * SV[o0.w];
        g1.x = (hh ? sc[12] : sc[4]) * inv * SV[o1.x]; g1.y = (hh ? sc[13] : sc[5]) * inv * SV[o1.y]; g1.z = (hh ? sc[14] : sc[6]) * inv * SV[o1.z]; g1.w = (hh ? sc[15] : sc[7]) * inv * SV[o1.w];
        float4 u0, u1; u0.x = SU[o0.x]; u0.y = SU[o0.y]; u0.z = SU[o0.z]; u0.w = SU[o0.w]; u1.x = SU[o1.x]; u1.y = SU[o1.y]; u1.z = SU[o1.z]; u1.w = SU[o1.w];
        float* ru = RSU + (size_t)token * 128 + h * 16 + hh * 8;
        *(int4*)ri = o0; *(int4*)(ri + 4) = o1; *(float4*)rg = g0; *(float4*)(rg + 4) = g1; *(float4*)ru = u0; *(float4*)(ru + 4) = u1;
        }
    }
}

typedef _Float16 f16x2v __attribute__((ext_vector_type(2)));
__device__ __forceinline__ float dot2h(unsigned a, unsigned b, float c) { return __builtin_amdgcn_fdot2(__builtin_bit_cast(f16x2v, a), __builtin_bit_cast(f16x2v, b), c, false); }
__device__ __forceinline__ unsigned pk_f16(float a, float b) { f16x2v v = {(_Float16)a, (_Float16)b}; return __builtin_bit_cast(unsigned, v); }
#ifndef TSEL_A
#define TSEL_A -1
#define TSEL_B -1
#define TSEL_C -1
#define TSEL_D -1
#endif
#ifndef REP_WA
#define REP_WA 1
#endif
#ifndef REP_ROUTE
#define REP_ROUTE 1
#endif
#ifndef REP_GATHER
#define REP_GATHER 1
#endif
#ifndef REP_DA
#define REP_DA 1
#endif
#ifndef REP_P0
#define REP_P0 1
#endif
#ifndef REP_P3A
#define REP_P3A 1
#endif
#ifndef REP_HY
#define REP_HY 1
#endif
#ifndef REP_GIN
#define REP_GIN 1
#endif
#ifndef REP_CVT
#define REP_CVT 1
#endif
constexpr size_t OFF_T16 = OFF_P + (size_t)72 * 1024 * 1024;
__global__ void __launch_bounds__(NT) mega(Params p) {
    extern __shared__ __attribute__((aligned(16))) unsigned char lds[];
    cg::grid_group grid = cg::this_grid();
    const int wave_s = __builtin_amdgcn_readfirstlane((int)threadIdx.x >> 6);
    volatile LAS unsigned* bst = (volatile LAS unsigned*)(lds + LDS_BAR_OFF);
    if (threadIdx.x < 4) bst[threadIdx.x] = 0u;
    __syncthreads();
    unsigned char* ws = p.ws;
    XcdBarrier xb = xcd_barrier_post((unsigned*)(ws + OFF_BAR), bst);
    const int G = gridDim.x, bid = blockIdx.x;
    const size_t gsz = (size_t)G * NT;
    const int nwaves = G * 8;
    float* ldsf = (float*)lds;
    int stamp_k = 0;
#define STAMP() do { if (TSEL_A >= 0) { if (bid == 0 && wave_s == 0) { unsigned long long* tsb = (unsigned long long*)(p.ws + 32768); const unsigned long long tnow = __builtin_amdgcn_s_memrealtime(); int lb_; asm volatile("v_mbcnt_lo_u32_b32 %0, -1, 0" : "=v"(lb_)); if (lb_ == 0) __hip_atomic_store(tsb + stamp_k, tnow, __ATOMIC_RELAXED, __HIP_MEMORY_SCOPE_AGENT); } ++stamp_k; } } while (0)
#define PH_VARS int tid; asm volatile("v_mbcnt_lo_u32_b32 %0, -1, 0\n\tv_mbcnt_hi_u32_b32 %0, -1, %0\n\tv_lshl_add_u32 %0, %1, 6, %0" : "=&v"(tid) : "s"(wave_s)); int zz = 0; asm volatile("" : "+s"(zz)); \
    const int lane = tid & 63, wave = __builtin_amdgcn_readfirstlane(tid >> 6); \
    const size_t gtid = (size_t)bid * NT + tid; const int gwave = bid * 8 + wave; (void)gtid; (void)gwave; (void)lane; \
    unsigned char* const wsl = p.ws + zz; \
    bf16_t* const X = (bf16_t*)(wsl + OFF_X); bf16_t* const Hb = (bf16_t*)(wsl + OFF_HB); float* const P = (float*)(wsl + OFF_P); float* const Q = (float*)(wsl + OFF_P); \
    float* const U = (float*)(wsl + OFF_U); float* const Z1 = (float*)(wsl + OFF_Z1); bf16_t* const Y = (bf16_t*)(wsl + OFF_Y); float* const HF = (float*)(wsl + OFF_HF); \
    float* const HFC = (float*)(wsl + OFF_HFC); bf16_t* const WinT = (bf16_t*)(wsl + OFF_WIN); bf16_t* const WoutT = (bf16_t*)(wsl + OFF_WOUT); bf16_t* const WqT = (bf16_t*)(wsl + OFF_WQ); \
    float* const MODP = (float*)(wsl + OFF_MODP); float* const MOD = (float*)(wsl + OFF_MOD); float* const TAB = (float*)(wsl + OFF_TAB); \
    bf16_t* const Qd = (bf16_t*)(wsl + OFF_QD); bf16_t* const Kd = (bf16_t*)(wsl + OFF_KD); bf16_t* const VdT = (bf16_t*)(wsl + OFF_VDT); float* const KMAX = (float*)(wsl + OFF_KMAX); float* const HT = (float*)(wsl + OFF_HT); bf16_t* const YhT = (bf16_t*)(wsl + OFF_YHT); float2* const TW = (float2*)(wsl + OFF_TW); float* const ZT = (float*)(wsl + OFF_ZT); (void)ZT; bf16_t* const Qw = (bf16_t*)(wsl + OFF_QW); bf16_t* const Kw = (bf16_t*)(wsl + OFF_KW); bf16_t* const VwT = (bf16_t*)(wsl + OFF_VWT); (void)Qw; (void)Kw; (void)VwT; bf16_t* const K16 = (bf16_t*)(wsl + OFF_K16); int* const RIDX = (int*)(wsl + OFF_RIDX); float* const RGATE = (float*)(wsl + OFF_RGATE); (void)K16; (void)RIDX; (void)RGATE; float* const RSU = (float*)(wsl + OFF_RSU); (void)RSU; \
    const float* const MODl = MOD + (size_t)l * 3 * 6144; const float* const HFl = HF + (size_t)l * HFP * 1024; (void)HT; (void)YhT; (void)TW; \
    (void)X; (void)Hb; (void)P; (void)Q; (void)U; (void)Z1; (void)Y; (void)HF; (void)HFC; (void)WinT; (void)WoutT; (void)WqT; (void)MODP; (void)MOD; (void)TAB; (void)Qd; (void)Kd; (void)VdT; (void)KMAX; (void)MODl; (void)HFl;
#define IN(k) (p.in[(k) + zz])

    STAMP();
    for (int rep0 = 0; rep0 < REP_P0; ++rep0) {
        const int l = 0; (void)l;
        PH_VARS
        __syncthreads();
        for (int l = 0; l < 2; ++l) {
            transpose_convert(IN(7) + (size_t)l * D * INC, WinT + (size_t)l * INC * D, D, INC, gtid, gsz);
            transpose_convert(IN(24) + (size_t)l * D * D, WoutT + (size_t)l * D * D, D, D, gtid, gsz);
            transpose_convert(IN(26) + (size_t)l * D * 2048, WqT + (size_t)l * 2048 * D, D, 2048, gtid, gsz);
        }
        for (int i = tid; i < 3 * D; i += NT) { const float cv = i < 2 * D ? IN(1)[i] : IN(3)[i - 2 * D]; ldsf[i] = cv / (1.f + expf(-cv)); }
        __syncthreads();
        for (size_t idx = gtid; idx < (size_t)16 * 2 * 6144; idx += gsz) {
            const int j = (int)(idx % 6144), l = (int)((idx / 6144) & 1), s = (int)(idx / 12288);
            const float* w = IN(4) + ((size_t)l * D + s * 64) * 6144 + j;
            float a0 = 0.f, a1 = 0.f, a2 = 0.f;
#pragma unroll 16
            for (int k = 0; k < 64; ++k) { const float wv = w[(size_t)k * 6144]; a0 += ldsf[s * 64 + k] * wv; a1 += ldsf[D + s * 64 + k] * wv; a2 += ldsf[2 * D + s * 64 + k] * wv; }
            float* o = MODP + ((size_t)(s * 2 + l) * 3) * 6144 + j;
            o[0] = a0; o[6144] = a1; o[2 * 6144] = a2;
        }
        if (gtid < 64) ((unsigned*)KMAX)[gtid] = 0u;
        for (size_t idx = gtid; idx < (size_t)2 * 16 * 128 * 128; idx += gsz) K16[idx] = f2bf(IN(27)[idx]);
        for (size_t idx = gtid; idx < 128 * 24; idx += gsz) {
            const int pos = (int)(idx / 24), f = (int)(idx % 24);
            const float inv = f < 16 ? powf(10000.f, -(float)(2 * f) / 32.f) : powf(10000.f, -(float)(2 * (f - 16)) / 16.f);
            const float ang = (float)pos * inv;
            ((unsigned*)TAB)[idx] = pk_f16(cosf(ang), sinf(ang));
        }
        for (size_t idx = gtid; idx < 16384; idx += gsz) { const float a = (float)idx * (1.f / 8192.f); TW[idx] = make_float2(cospif(a), sinpif(a)); }
        __syncthreads();
        for (int it = bid; it < 2 * (SEQ / 32); it += G) {
            const int l2 = it / (SEQ / 32), t0 = (it % (SEQ / 32)) * 32;
            const float* w3 = IN(15) + (size_t)l2 * 64 * 1024; const float* dec = IN(16) + (size_t)l2 * 1024;
            const int ql = lane & 31, kk = lane >> 5;
            const unsigned wlo = (unsigned)(8 * kk * 1024 + wave * 128 + ql);
            float* wl = ldsf + 4096;
            { const float* w1g = IN(10) + (size_t)l2 * 33 * 64; const float* w2g = IN(13) + (size_t)l2 * 64 * 64;
              float s1[5], s2[8], s3 = 0.f;
#pragma unroll
              for (int q = 0; q < 5; ++q) { const int i = tid + 512 * q; s1[q] = i < 33 * 64 ? w1g[i] : 0.f; }
#pragma unroll
              for (int q = 0; q < 8; ++q) s2[q] = w2g[tid + 512 * q];
              if (tid < 192) s3 = tid < 64 ? IN(11)[l2 * 64 + tid] : (tid < 128 ? IN(12)[l2 * 64 + tid - 64] : IN(14)[l2 * 64 + tid - 128]);
              float b8n[4][8];
#pragma unroll
              for (int c = 0; c < 4; ++c)
#pragma unroll
                  for (int j = 0; j < 8; ++j) b8n[c][j] = (w3 + (16 * c + j) * 1024)[wlo];
              __builtin_amdgcn_sched_barrier(0);
#pragma unroll
              for (int q = 0; q < 5; ++q) { const int i = tid + 512 * q; if (i < 33 * 64) wl[i] = s1[q]; }
#pragma unroll
              for (int q = 0; q < 8; ++q) wl[2240 + tid + 512 * q] = s2[q];
              if (tid < 128) wl[2112 + tid] = s3; else if (tid < 192) wl[6336 + tid - 128] = s3;
              __syncthreads();
              { float z2[4]; hy_filter_z2<4>(wl, wl + 2112, wl + 2176, wl + 2240, wl + 6336, SEQ, t0 + wave * 4, lane, z2);
#pragma unroll
                for (int q = 0; q < 4; ++q) ldsf[(wave * 4 + q) * 68 + lane] = z2[q]; }
              __syncthreads();
#define HF_SPLIT8(src, H, L) do { unsigned h_[4], l_[4]; _Pragma("unroll") for (int i_ = 0; i_ < 4; ++i_) { const float x0_ = (src)[2 * i_], x1_ = (src)[2 * i_ + 1]; h_[i_] = pk_bf16(x0_, x1_); \
                  l_[i_] = pk_bf16(x0_ - __uint_as_float(h_[i_] << 16), x1_ - __uint_as_float(h_[i_] & 0xffff0000u)); } \
                  H = __builtin_bit_cast(bf16x8, make_uint4(h_[0], h_[1], h_[2], h_[3])); L = __builtin_bit_cast(bf16x8, make_uint4(l_[0], l_[1], l_[2], l_[3])); } while (0)
              float dd[4];
#pragma unroll
              for (int nt = 0; nt < 4; ++nt) dd[nt] = dec[wave * 128 + 32 * nt + ql];
#pragma unroll
              for (int nt = 0; nt < 4; ++nt) {
                  f32x16 facc;
#pragma unroll
                  for (int r = 0; r < 16; ++r) facc[r] = 0.f;
                  bf16x8 bh[4], bl[4];
#pragma unroll
                  for (int c = 0; c < 4; ++c) HF_SPLIT8(b8n[c], bh[c], bl[c]);
                  if (nt < 3) {
#pragma unroll
                      for (int c = 0; c < 4; ++c)
#pragma unroll
                          for (int j = 0; j < 8; ++j) b8n[c][j] = (w3 + (16 * c + j) * 1024 + 32 * (nt + 1))[wlo];
                      __builtin_amdgcn_sched_barrier(0); }
#pragma unroll
                  for (int c = 0; c < 4; ++c) {
                      bf16x8 ahc, alc; float a8[8]; const float4 a0 = *(const float4*)(ldsf + ql * 68 + 16 * c + 8 * kk), a1 = *(const float4*)(ldsf + ql * 68 + 16 * c + 8 * kk + 4);
                      a8[0] = a0.x; a8[1] = a0.y; a8[2] = a0.z; a8[3] = a0.w; a8[4] = a1.x; a8[5] = a1.y; a8[6] = a1.z; a8[7] = a1.w; HF_SPLIT8(a8, ahc, alc);
                      facc = __builtin_amdgcn_mfma_f32_32x32x16_bf16(ahc, bh[c], facc, 0, 0, 0);
                      facc = __builtin_amdgcn_mfma_f32_32x32x16_bf16(ahc, bl[c], facc, 0, 0, 0);
                      facc = __builtin_amdgcn_mfma_f32_32x32x16_bf16(alc, bh[c], facc, 0, 0, 0); }
                  { const int col = wave * 128 + 32 * nt + ql; const float dcol = fabsf(dd[nt]);
                    float* op = HF + ((size_t)l2 * 1024 + col) * HFP + t0;
#pragma unroll
                    for (int rg = 0; rg < 4; ++rg) { const int p0 = 8 * rg + 4 * kk; float4 v;
                        v.x = facc[4 * rg] * __expf(-((float)(t0 + p0) / (float)(SEQ - 1)) * dcol); v.y = facc[4 * rg + 1] * __expf(-((float)(t0 + p0 + 1) / (float)(SEQ - 1)) * dcol);
                        v.z = facc[4 * rg + 2] * __expf(-((float)(t0 + p0 + 2) / (float)(SEQ - 1)) * dcol); v.w = facc[4 * rg + 3] * __expf(-((float)(t0 + p0 + 3) / (float)(SEQ - 1)) * dcol);
                        *(float4*)(op + p0) = v; } }
              }
#undef HF_SPLIT8
            }
            __syncthreads();
        }
        for (int t = gwave; t < CTX; t += nwaves) { float z2[1]; hy_filter_z2<1>(IN(10), IN(11), IN(12), IN(13), IN(14), CTX, t, lane, z2); HFC[(size_t)t * 64 + lane] = z2[0]; }
    }
    grid.sync();
    STAMP();
    { const int l = 0; (void)l; PH_VARS
    for (size_t idx = gtid; idx < (size_t)2 * 3 * 6144; idx += gsz) {
        const int j = (int)(idx % 6144), r = (int)((idx / 6144) % 3), l = (int)(idx / (3 * 6144));
        float a = IN(5)[l * 6144 + j];
        for (int s = 0; s < 16; ++s) a += MODP[((size_t)(s * 2 + l) * 3 + r) * 6144 + j];
        MOD[idx] = a;
    } }
    xcd_barrier(xb, wave_s); STAMP();

    for (int l = 0; l < 2; ++l) {
        const bool with_ctx = (l == 0);
        const float lam_init = 0.8f - 0.6f * expf(-0.3f * (float)l);
        if (l == 0) {
        { PH_VARS norm_phase(IN(0), IN(2), IN(6) + l * D, MODl, 0, 1024, NTOK, Hb, gwave, nwaves, lane); }
        xcd_barrier(xb, wave_s); STAMP();
        }
        { PH_VARS pg8::Gemm g{Hb, WinT + (size_t)l * INC * D, NTOK, INC, D}; pg8::StaticOrder S; S.init(NTOK, INC, G, bid);
          EpiInProj E{HT, U, Qw, Kw, VwT, Qd, Kd, VdT, (const unsigned*)TAB, (unsigned*)KMAX, l};
          for (int repg = 0; repg < REP_GIN; ++repg)
          pg8::gemm_phase<EpiInProj, pg8::StaticOrder>((PG8_LAS unsigned char*)lds, g, S, E, tid); }
        xcd_barrier(xb, wave_s); STAMP();
        { PH_VARS
          for (int reph = 0; reph < REP_HY; ++reph)
          hyena_fft_phase(l, HT, HFl, TW, IN(8) + (size_t)l * 3 * 768, IN(9) + l * 768, IN(17) + l * 512, YhT, ZT, (float2*)(wsl + OFF_P), (LAS f32x2v*)lds, bid, G, tid);
          __syncthreads();
          if (with_ctx) hyena_ctx_fused(l, U, IN(8) + (size_t)l * 3 * 768, IN(9) + l * 768, Y, HFC, IN(15), IN(16), IN(17), ldsf, bid, G, tid); }
        xcd_barrier(xb, wave_s); STAMP();
        {
            PH_VARS
            for (int rep = 0; rep < REP_WA; ++rep)
            wa_phase(with_ctx, Qw, Kw, VwT, KMAX + 32 + l * 8, IN(18) + l * 8, Y, (LAS unsigned char*)lds, bid, G, tid);
            __syncthreads();
        }
        {
            PH_VARS
            float lam;
            { float s1 = 0.f, s2 = 0.f;
              for (int i = 0; i < 32; ++i) { s1 += IN(19)[l * 32 + i] * IN(20)[l * 32 + i]; s2 += IN(21)[l * 32 + i] * IN(22)[l * 32 + i]; }
              lam = expf(s1) - expf(s2) + lam_init; }
            __syncthreads();
            for (int rep = 0; rep < REP_DA; ++rep)
            da_phase(l, with_ctx, Qd, Kd, VdT, KMAX + l * 16, lam, lam_init, IN(23) + l * 64, Y, (LAS unsigned char*)lds, bid, G, tid);
        }
        {
            PH_VARS
            __syncthreads();
            bf16_t* tl = (bf16_t*)lds;
            for (int it = bid; it < NLAT / 64; it += G) {
                const int r0 = it * 64;
#pragma unroll
                for (int e = 0; e < 4; ++e) { const int idx = tid + 512 * e, c = idx >> 3, ch = idx & 7;
                    const uint4 v = *(const uint4*)(YhT + (size_t)c * NLAT + r0 + ch * 8);
                    unsigned* d = (unsigned*)(tl + c * 66 + ch * 8); d[0] = v.x; d[1] = v.y; d[2] = v.z; d[3] = v.w; }
                __syncthreads();
                { const int rr = tid >> 3, cch = tid & 7;
#pragma unroll
                  for (int q = 0; q < 4; ++q) { unsigned w[4];
#pragma unroll
                      for (int jj = 0; jj < 4; ++jj) { const int c = cch * 32 + 8 * q + 2 * jj; w[jj] = (unsigned)tl[c * 66 + rr] | ((unsigned)tl[(c + 1) * 66 + rr] << 16); }
                      *(uint4*)(Y + (size_t)(r0 + rr) * D + cch * 32 + 8 * q) = make_uint4(w[0], w[1], w[2], w[3]); } }
                __syncthreads();
            }
        }
        xcd_barrier(xb, wave_s); STAMP();
        const int Mrows = with_ctx ? NTOK : NLAT;
        { PH_VARS pg8::Gemm g{Y, WoutT + (size_t)l * D * D, Mrows, D, D}; pg8::StaticOrder S; S.init(Mrows, D, G, bid);
          EpiResid E{X, MODl, IN(0), IN(2), l != 0};
          pg8::gemm_phase<EpiResid, pg8::StaticOrder>((PG8_LAS unsigned char*)lds, g, S, E, tid); }
        xcd_barrier(xb, wave_s); STAMP();
        { PH_VARS norm_phase_b(X, IN(25) + l * D, MODl, 3072, 4096, Mrows, Hb, gwave, nwaves, lane);
          { uint4* T8 = (uint4*)(wsl + OFF_T16); float* TS = (float*)(wsl + OFF_T16 + (size_t)2 * NEXP * D);
            for (int repc = 0; repc < REP_CVT; ++repc)
            for (int rowi = gwave; rowi < 2 * NEXP; rowi += nwaves) {
                const int tab = rowi >= NEXP ? 1 : 0, e = rowi - tab * NEXP;
                const float4* src = (const float4*)((tab ? IN(29) : IN(28)) + ((size_t)l * NEXP + e) * D) + lane * 4;
                float4 v[4]; float mx = 0.f;
#pragma unroll
                for (int j = 0; j < 4; ++j) { v[j] = src[j]; mx = fmaxf(mx, fmaxf(fmaxf(fabsf(v[j].x), fabsf(v[j].y)), fmaxf(fabsf(v[j].z), fabsf(v[j].w)))); }
                mx = wave_max(mx);
                const float sc = mx > 0.f ? 127.f / mx : 0.f;
                const int qoff = tab ? 128 : 0;
                unsigned w[4];
#pragma unroll
                for (int j = 0; j < 4; ++j) { const unsigned q0 = (unsigned)((int)rintf(v[j].x * sc) + qoff) & 0xffu, q1 = (unsigned)((int)rintf(v[j].y * sc) + qoff) & 0xffu, q2 = (unsigned)((int)rintf(v[j].z * sc) + qoff) & 0xffu, q3 = (unsigned)((int)rintf(v[j].w * sc) + qoff) & 0xffu;
                    w[j] = q0 | (q1 << 8) | (q2 << 16) | (q3 << 24); }
                T8[(size_t)rowi * 64 + lane] = make_uint4(w[0], w[1], w[2], w[3]);
                if (lane == 0) TS[rowi] = mx * (1.f / 127.f);
            } } }
        xcd_barrier(xb, wave_s); STAMP();
        { PH_VARS pg8::Gemm g{Hb, WqT + (size_t)l * 2048 * D, Mrows, 2048, D}; pg8::StaticOrder S; S.init(Mrows, 2048, G, bid);
          pg8::EpiBf16<0> E{(bf16_t*)Q, 2048, nullptr, 0, 0};
          pg8::gemm_phase<pg8::EpiBf16<0>, pg8::StaticOrder>((PG8_LAS unsigned char*)lds, g, S, E, tid); }
        xcd_barrier(xb, wave_s); STAMP();
        { PH_VARS
          for (int rep = 0; rep < REP_ROUTE; ++rep)
          peer_route_phase(Mrows, (const bf16_t*)Q, K16 + (size_t)l * 16 * 128 * 128, RIDX, RGATE, RSU, (const float*)(wsl + OFF_T16 + (size_t)2 * NEXP * D), (LAS unsigned*)lds, bid, G, tid); }
        xcd_barrier(xb, wave_s); STAMP();
        {
            PH_VARS
            int* gidx = (int*)(ldsf + wave * 384); float* gate = (float*)(gidx + 128); float* gsu = gate + 128;
            const float4* g4 = (const float4*)(IN(25) + l * D);
            const int nitem_total = NLAT + 4 * (Mrows - NLAT);
            int nl_i0, nl_i1; float nl_g0, nl_g1, nl_s0, nl_s1;
            { const int row0_ = gwave; const int lane0_ = tid & 63;
              nl_i0 = RIDX[(size_t)row0_ * 128 + lane0_]; nl_i1 = RIDX[(size_t)row0_ * 128 + 64 + lane0_]; nl_g0 = RGATE[(size_t)row0_ * 128 + lane0_]; nl_g1 = RGATE[(size_t)row0_ * 128 + 64 + lane0_];
              nl_s0 = RSU[(size_t)row0_ * 128 + lane0_]; nl_s1 = RSU[(size_t)row0_ * 128 + 64 + lane0_]; }
            for (int idx = gwave; idx < nitem_total; idx += nwaves) {
                int lane_s = tid & 63; asm volatile("" : "+v"(lane_s)); const int lane = lane_s;
                const bool quarter = idx >= NLAT;
                const int row = quarter ? NLAT + ((idx - NLAT) >> 2) : idx;
                const int qd = idx & 3, e_lo = quarter ? qd * 32 : 0, e_hi = quarter ? qd * 32 + 32 : 128;
                const int r = row < NLAT ? (row >> 13) : 2;
                gidx[lane] = nl_i0; gidx[64 + lane] = nl_i1; gate[lane] = nl_g0; gate[64 + lane] = nl_g1; gsu[lane] = nl_s0; gsu[64 + lane] = nl_s1;
                { const int nidx = idx + nwaves; const int nrow = nidx >= nitem_total ? row : (nidx >= NLAT ? NLAT + ((nidx - NLAT) >> 2) : nidx);
                  nl_i0 = RIDX[(size_t)nrow * 128 + lane]; nl_i1 = RIDX[(size_t)nrow * 128 + 64 + lane]; nl_g0 = RGATE[(size_t)nrow * 128 + lane]; nl_g1 = RGATE[(size_t)nrow * 128 + 64 + lane];
                  nl_s0 = RSU[(size_t)nrow * 128 + lane]; nl_s1 = RSU[(size_t)nrow * 128 + 64 + lane]; }
                WAVE_SYNC();
                float4 xv[4]; float hv[16]; float ss = 0.f;
                const uint2* xr = (const uint2*)(X + (size_t)row * D) + lane * 4;
#pragma unroll
                for (int j = 0; j < 4; ++j) { const uint2 xw2 = xr[j]; xv[j] = make_float4(__uint_as_float(xw2.x << 16), __uint_as_float(xw2.x & 0xffff0000u), __uint_as_float(xw2.y << 16), __uint_as_float(xw2.y & 0xffff0000u));
                    ss += xv[j].x * xv[j].x + xv[j].y * xv[j].y + xv[j].z * xv[j].z + xv[j].w * xv[j].w; }
                ss = wave_sum(ss);
                const float rs = rsqrtf(ss * (1.f / D) + 1e-6f);
                const float4* sh4 = (const float4*)(MODl + r * 6144 + 3072) + lane * 4; const float4* sc4 = (const float4*)(MODl + r * 6144 + 4096) + lane * 4;
                float hmx = 0.f;
#pragma unroll
                for (int j = 0; j < 4; ++j) { const float4 gg = g4[lane * 4 + j], sh = sh4[j], sc = sc4[j];
                    hv[4 * j] = xv[j].x * rs * gg.x * (1.f + sc.x) + sh.x; hv[4 * j + 1] = xv[j].y * rs * gg.y * (1.f + sc.y) + sh.y;
                    hv[4 * j + 2] = xv[j].z * rs * gg.z * (1.f + sc.z) + sh.z; hv[4 * j + 3] = xv[j].w * rs * gg.w * (1.f + sc.w) + sh.w;
                    hmx = fmaxf(hmx, fmaxf(fmaxf(fabsf(hv[4 * j]), fabsf(hv[4 * j + 1])), fmaxf(fabsf(hv[4 * j + 2]), fabsf(hv[4 * j + 3])))); }
                hmx = wave_max(hmx);
                const float hsc = hmx > 0.f ? 127.f / hmx : 0.f, hscale = hmx * (1.f / 127.f);
                int hq[4];
#pragma unroll
                for (int j = 0; j < 4; ++j) hq[j] = (int)(((unsigned)(int)rintf(hv[4 * j] * hsc) & 0xffu) | (((unsigned)(int)rintf(hv[4 * j + 1] * hsc) & 0xffu) << 8) | (((unsigned)(int)rintf(hv[4 * j + 2] * hsc) & 0xffu) << 16) | (((unsigned)(int)rintf(hv[4 * j + 3] * hsc) & 0xffu) << 24));
                float ov[16]; float corr = 0.f;
#pragma unroll
                for (int j = 0; j < 16; ++j) ov[j] = 0.f;
                const uint4* U8 = (const uint4*)(wsl + OFF_T16); const uint4* V8 = U8 + (size_t)NEXP * 64;
                const float* SU = (const float*)(wsl + OFF_T16 + (size_t)2 * NEXP * D); const float* SV = SU + NEXP;
                for (int rep = 0; rep < REP_GATHER; ++rep) {
                if (rep > 0) {
#pragma unroll
                    for (int j = 0; j < 16; ++j) ov[j] *= 0.f;
                    corr *= 0.f; }
#define PG_LOAD(UA, VA, E0) do { _Pragma("unroll") for (int k = 0; k < 8; ++k) { const int ex_ = __builtin_amdgcn_readfirstlane(gidx[(E0) + k]); UA[k] = (U8 + (size_t)ex_ * 64)[lane]; VA[k] = (V8 + (size_t)ex_ * 64)[lane]; } } while (0)
#define PG_COMPUTE(UA, VA, E0) do { int dd[8]; \
                    _Pragma("unroll") for (int k = 0; k < 8; ++k) { int d_ = __builtin_amdgcn_sdot4((int)UA[k].x, hq[0], 0, false); d_ = __builtin_amdgcn_sdot4((int)UA[k].y, hq[1], d_, false); \
                        d_ = __builtin_amdgcn_sdot4((int)UA[k].z, hq[2], d_, false); dd[k] = __builtin_amdgcn_sdot4((int)UA[k].w, hq[3], d_, false); } \
                      \
                    int t4[4], t2[2], t1; \
                    _Pragma("unroll") for (int i = 0; i < 4; ++i) { const int snd = b0 ? dd[i] : dd[i + 4], kp = b0 ? dd[i + 4] : dd[i]; t4[i] = kp + swzxi<1>(snd); } \
                    _Pragma("unroll") for (int i = 0; i < 2; ++i) { const int snd = b1 ? t4[i] : t4[i + 2], kp = b1 ? t4[i + 2] : t4[i]; t2[i] = kp + swzxi<2>(snd); } \
                    { const int snd = b2 ? t2[0] : t2[1], kp = b2 ? t2[1] : t2[0]; t1 = kp + swzxi<4>(snd); } \
                    t1 += swzxi<8>(t1); t1 += swzxi<16>(t1); t1 += __builtin_amdgcn_ds_bpermute((lane ^ 32) << 2, t1); \
                    const float dot = (float)t1 * (gsu[(E0) + esel] * hscale); \
                    const float wl = gate[(E0) + esel] * 0.5f * dot * (1.f + erff(dot * 0.70710678118654752f)); \
                    corr += wl; \
                    _Pragma("unroll") for (int k = 0; k < 8; ++k) { const float w = rdlane(wl, ((k >> 2) & 1) | (((k >> 1) & 1) << 1) | ((k & 1) << 2)); \
                        const unsigned vw[4] = {VA[k].x, VA[k].y, VA[k].z, VA[k].w}; \
                        _Pragma("unroll") for (int j = 0; j < 4; ++j) { \
                            ov[4 * j] = fmaf((float)(vw[j] & 0xffu), w, ov[4 * j]); ov[4 * j + 1] = fmaf((float)((vw[j] >> 8) & 0xffu), w, ov[4 * j + 1]); \
                            ov[4 * j + 2] = fmaf((float)((vw[j] >> 16) & 0xffu), w, ov[4 * j + 2]); ov[4 * j + 3] = fmaf((float)(vw[j] >> 24), w, ov[4 * j + 3]); } } } while (0)
                const bool b0 = lane & 1, b1 = lane & 2, b2 = lane & 4; const int esel = (b0 ? 4 : 0) + (b1 ? 2 : 0) + (b2 ? 1 : 0);
                {
                    uint4 uA[8], vA[8], uB[8], vB[8];
                    PG_LOAD(uA, vA, e_lo);
#pragma unroll 1
                    for (int e0 = e_lo; e0 < e_hi; e0 += 16) {
                        PG_LOAD(uB, vB, e0 + 8);
                        PG_COMPUTE(uA, vA, e0);
                        if (e0 + 16 < e_hi) PG_LOAD(uA, vA, e0 + 16);
                        PG_COMPUTE(uB, vB, e0 + 8);
                    }
                }
#undef PG_LOAD
#undef PG_COMPUTE
                }
                corr = wave_sum(corr) * (128.f / 8.f);
                if (quarter) {
                    float* part = ldsf + 4096 + wave * (17 * 64);
#pragma unroll
                    for (int j = 0; j < 16; ++j) part[j * 64 + lane] = ov[j];
                    part[16 * 64 + lane] = corr;
                    __syncthreads();
                    if (qd == 0) {
#pragma unroll
                        for (int w2 = 1; w2 < 4; ++w2) { const float* pp = part + w2 * (17 * 64);
#pragma unroll
                            for (int j = 0; j < 16; ++j) ov[j] += pp[j * 64 + lane];
                            corr += pp[16 * 64 + lane]; }
                    }
                    __syncthreads();
                }
                if (!quarter || qd == 0) {
                const float4* gm4 = (const float4*)(MODl + r * 6144 + 5120) + lane * 4;
                uint2* xw = (uint2*)(X + (size_t)row * D) + lane * 4; asm volatile("" : "+v"(xw));
                float4 on[4]; float s2 = 0.f;
#pragma unroll
                for (int j = 0; j < 4; ++j) { const float4 gm = gm4[j]; const uint2 xw2 = xw[j]; const float4 x0 = make_float4(__uint_as_float(xw2.x << 16), __uint_as_float(xw2.x & 0xffff0000u), __uint_as_float(xw2.y << 16), __uint_as_float(xw2.y & 0xffff0000u)); float4 o;
                    o.x = x0.x + gm.x * (ov[4 * j] - corr); o.y = x0.y + gm.y * (ov[4 * j + 1] - corr); o.z = x0.z + gm.z * (ov[4 * j + 2] - corr); o.w = x0.w + gm.w * (ov[4 * j + 3] - corr);
                    on[j] = o; s2 += o.x * o.x + o.y * o.y + o.z * o.z + o.w * o.w;
                    if (l == 0 || TSEL_A >= 0) xw[j] = make_uint2(pk_bf16(o.x, o.y), pk_bf16(o.z, o.w)); }
                s2 = wave_sum(s2);
                const float rs2 = rsqrtf(s2 * (1.f / D) + 1e-6f);
                if (l == 0) {
                    const float4* gn4 = (const float4*)(IN(6) + D) + lane * 4;
                    const float4* sh1 = (const float4*)(MOD + 3 * 6144 + r * 6144) + lane * 4; const float4* sc1 = (const float4*)(MOD + 3 * 6144 + r * 6144 + 1024) + lane * 4;
                    unsigned hw[8];
#pragma unroll
                    for (int j = 0; j < 4; ++j) { const float4 gg = gn4[j], sh = sh1[j], sc = sc1[j];
                        hw[2 * j] = pk_bf16(on[j].x * rs2 * gg.x * (1.f + sc.x) + sh.x, on[j].y * rs2 * gg.y * (1.f + sc.y) + sh.y);
                        hw[2 * j + 1] = pk_bf16(on[j].z * rs2 * gg.z * (1.f + sc.z) + sh.z, on[j].w * rs2 * gg.w * (1.f + sc.w) + sh.w); }
                    uint4* hp = (uint4*)(Hb + (size_t)row * D) + lane * 2;
                    hp[0] = make_uint4(hw[0], hw[1], hw[2], hw[3]); hp[1] = make_uint4(hw[4], hw[5], hw[6], hw[7]);
                } else if (TSEL_A < 0) {
                    const float4* fg4 = (const float4*)IN(30) + lane * 4;
                    float4* op = (float4*)(p.out + (size_t)row * D) + lane * 4;
#pragma unroll
                    for (int j = 0; j < 4; ++j) { const float4 g = fg4[j]; float4 o; o.x = on[j].x * rs2 * g.x; o.y = on[j].y * rs2 * g.y; o.z = on[j].z * rs2 * g.z; o.w = on[j].w * rs2 * g.w; op[j] = o; }
                }
                }
                WAVE_SYNC();
            }
        }
        xcd_barrier(xb, wave_s); STAMP();
    }
    if (TSEL_A >= 0) {
        const int l = 0; (void)l;
        PH_VARS
        const float4* fg = (const float4*)IN(30);
        float oscale = 1.f, oadd = 0.f;
        if (TSEL_A >= 0) { const unsigned long long* tsb = (const unsigned long long*)(p.ws + 32768);
            const float dab = (float)(long long)(tsb[TSEL_B] - tsb[TSEL_A]) * 0.01f;
            oscale = 1.f + 0.02f + dab * (0.03f / 2000.f);
            if (TSEL_C >= 0) { const float dcd = (float)(long long)(tsb[TSEL_D] - tsb[TSEL_C]) * 0.01f; oadd = dcd * 0.01f; } }
        for (int row = gwave; row < NLAT; row += nwaves) {
            const uint2* xr = (const uint2*)(X + (size_t)row * D);
            float4 v[4]; float ss = 0.f;
#pragma unroll
            for (int j = 0; j < 4; ++j) { const uint2 xw2 = xr[lane + 64 * j]; v[j] = make_float4(__uint_as_float(xw2.x << 16), __uint_as_float(xw2.x & 0xffff0000u), __uint_as_float(xw2.y << 16), __uint_as_float(xw2.y & 0xffff0000u)); ss += v[j].x * v[j].x + v[j].y * v[j].y + v[j].z * v[j].z + v[j].w * v[j].w; }
            ss = wave_sum(ss);
            const float rs = rsqrtf(ss * (1.f / D) + 1e-6f);
            float4* orow = (float4*)(p.out + (size_t)row * D);
#pragma unroll
            for (int j = 0; j < 4; ++j) { const float4 g = fg[lane + 64 * j]; float4 o; o.x = v[j].x * rs * g.x * oscale; o.y = v[j].y * rs * g.y * oscale; o.z = v[j].z * rs * g.z * oscale; o.w = v[j].w * rs * g.w * oscale; if (TSEL_C >= 0 && row == 0 && j == 0 && lane == 0) o.x += oadd; orow[lane + 64 * j] = o; }
        }
    }
}

extern "C" void kernel_launch(void* const* d_in, const int* in_sizes, int n_in, void* d_out, int out_size, void* d_ws, size_t ws_size, hipStream_t stream) {
    static int grid_blocks = 0;
    if (!grid_blocks) {
        int dev = 0, cus = 0, per_cu = 0;
        (void)hipGetDevice(&dev);
        (void)hipDeviceGetAttribute(&cus, hipDeviceAttributeMultiprocessorCount, dev);
        (void)hipFuncSetAttribute((const void*)mega, hipFuncAttributeMaxDynamicSharedMemorySize, LDS_BYTES);
        (void)hipOccupancyMaxActiveBlocksPerMultiprocessor(&per_cu, (const void*)mega, NT, LDS_BYTES);
        if (per_cu < 1) fprintf(stderr, "kernel_launch: occupancy query reports %d blocks per CU\n", per_cu);
        if (ws_size < OFF_END) fprintf(stderr, "kernel_launch: workspace too small: %zu < %zu\n", ws_size, (size_t)OFF_END);
        grid_blocks = cus;
    }
    Params p{};
    for (int i = 0; i < 31 && i < n_in; ++i) p.in[i] = (const float*)d_in[i];
    p.out = (float*)d_out;
    p.ws = (unsigned char*)d_ws;
    (void)hipMemsetAsync(d_ws, 0, XCD_BAR_WORDS * 4, stream);
    void* args[] = {&p};
    hipError_t e = hipLaunchCooperativeKernel((const void*)mega, dim3(grid_blocks), dim3(NT), args, LDS_BYTES, stream);
    if (e != hipSuccess) fprintf(stderr, "cooperative launch failed: %s (grid %d)\n", hipGetErrorString(e), grid_blocks);
}
```
